# Optimizing an MI355X kernel written in HIP

```python
import jax, jax.numpy as jnp
from jax import lax
import numpy as np

D_MODEL = 1024
BATCH = 2
SEQ = 16384
DEPTH = 4

GRID_W = 64
CTX_LEN = 256
N_MIXERS = 4
QBLK = 128
EPS = 1e-6
ROPE_THETA = 10000.0
NEG_INF = -1e30

MLA_HEADS = 8
MLA_Q_RANK = 512
MLA_KV_RANK = 256
MLA_NOPE = 128
MLA_ROPE = 64
MLA_V = 128
FNET_GROUPS = 4
FNET_GC = D_MODEL // FNET_GROUPS
NA_HEADS = 16
NA_HD = D_MODEL // NA_HEADS
NA_KR_MAX = 8
NA_KC = 16
SW_HEADS = 16
SW_KV_HEADS = 4
SW_HD = 64
SW_WINDOW = 128
MOE_GROUPS = 4
MOE_PER_GROUP = 8
MOE_EXPERTS = MOE_GROUPS * MOE_PER_GROUP
MOE_TOPK = 2
MOE_FF = 512
MOE_BLK = 128

kernel_name = 'hybrid_mla_fnet_na_swa_hmoe'


def _n_uses(m):
    return len(range(m, DEPTH, N_MIXERS))


def rmsnorm(x, g):
    xf = x.astype(jnp.float32)
    y = xf * lax.rsqrt(jnp.mean(xf * xf, axis=-1, keepdims=True) + EPS)
    return (y * g.astype(jnp.float32)).astype(x.dtype)


def softmax_f32(s, dtype):
    return jax.nn.softmax(s.astype(jnp.float32), axis=-1).astype(dtype)


def axial_rope_angles(row, col, d_rot):
    n = d_rot // 4
    inv = ROPE_THETA ** (-jnp.arange(n, dtype=jnp.float32) / n)
    return jnp.concatenate([row.astype(jnp.float32)[:, None] * inv,
                            col.astype(jnp.float32)[:, None] * inv], axis=-1)


def apply_rope(x, ang):
    cos = jnp.cos(ang)[None, :, None, :]
    sin = jnp.sin(ang)[None, :, None, :]
    x1, x2 = jnp.split(x.astype(jnp.float32), 2, axis=-1)
    return jnp.concatenate([x1 * cos - x2 * sin, x1 * sin + x2 * cos], axis=-1).astype(x.dtype)


def mla_project(h, w_dq, g_q, w_uq, w_dkv, g_kv, w_ukv, ang):
    B, L, _ = h.shape
    q = (rmsnorm(h @ w_dq, g_q) @ w_uq).reshape(B, L, MLA_HEADS, MLA_NOPE + MLA_ROPE)
    q_nope, q_rope = q[..., :MLA_NOPE], q[..., MLA_NOPE:]
    kv_a = h @ w_dkv
    c_kv = rmsnorm(kv_a[..., :MLA_KV_RANK], g_kv)
    k_rope = kv_a[..., None, MLA_KV_RANK:]
    kv = (c_kv @ w_ukv).reshape(B, L, MLA_HEADS, MLA_NOPE + MLA_V)
    k_nope, v = kv[..., :MLA_NOPE], kv[..., MLA_NOPE:]
    if ang is not None:
        q_rope = apply_rope(q_rope, ang)
        k_rope = apply_rope(k_rope, ang)
    return q_nope, q_rope, k_nope, k_rope[:, :, 0], v


def mla_mixer(h_c, h_l, ang, w_dq, g_q, w_uq, w_dkv, g_kv, w_ukv, w_o, with_ctx):
    B, S, _ = h_l.shape
    qn_c, qr_c, kn_c, kr_c, v_c = mla_project(h_c, w_dq, g_q, w_uq, w_dkv, g_kv, w_ukv, None)
    qn_l, qr_l, kn_l, kr_l, v_l = mla_project(h_l, w_dq, g_q, w_uq, w_dkv, g_kv, w_ukv, ang)
    kn = jnp.concatenate([kn_c, kn_l], axis=1)
    kr = jnp.concatenate([kr_c, kr_l], axis=1)
    v = jnp.concatenate([v_c, v_l], axis=1)
    scale = (MLA_NOPE + MLA_ROPE) ** -0.5

    def attend(qn, qr, kn_, kr_, v_):
        s = (jnp.einsum('bqhd,bkhd->bhqk', qn, kn_) + jnp.einsum('bqhd,bkd->bhqk', qr, kr_)) * scale
        return jnp.einsum('bhqk,bkhd->bqhd', softmax_f32(s, v_.dtype), v_)

    def block(i):
        sl = lambda a: lax.dynamic_slice_in_dim(a, i * QBLK, QBLK, 1)
        return attend(sl(qn_l), sl(qr_l), kn, kr, v)

    o = lax.map(block, jnp.arange(S // QBLK))
    y_l = o.transpose(1, 0, 2, 3, 4).reshape(B, S, MLA_HEADS * MLA_V) @ w_o
    y_c = None
    if with_ctx:
        y_c = attend(qn_c, qr_c, kn_c, kr_c, v_c).reshape(B, h_c.shape[1], MLA_HEADS * MLA_V) @ w_o
    return y_c, y_l


def grouped_fourier(h):
    B, L, D = h.shape
    hg = h.astype(jnp.float32).reshape(B, L, FNET_GROUPS, FNET_GC)
    f = jnp.fft.fft2(hg, axes=(1, 3), norm='ortho').real
    return f.reshape(B, L, D).astype(h.dtype)


def fnet_mixer(h_c, h_l, w_o, b_o, with_ctx):
    y_l = grouped_fourier(h_l) @ w_o + b_o
    y_c = grouped_fourier(h_c) @ w_o + b_o if with_ctx else None
    return y_c, y_l


def na_mixer(h_c, h_l, w_qkv, rpb, w_o, with_ctx):
    B, S, D = h_l.shape
    C = h_c.shape[1]
    rows = S // GRID_W
    kr = min(NA_KR_MAX, rows)
    nloc = kr * NA_KC
    scale = NA_HD ** -0.5
    qkv_l = (h_l @ w_qkv).reshape(B, S, 3, NA_HEADS, NA_HD)
    qkv_c = (h_c @ w_qkv).reshape(B, C, 3, NA_HEADS, NA_HD)
    q_c, k_c, v_c = qkv_c[:, :, 0], qkv_c[:, :, 1], qkv_c[:, :, 2]
    qg = qkv_l[:, :, 0].reshape(B, rows, GRID_W, NA_HEADS, NA_HD)
    kg = qkv_l[:, :, 1].reshape(B, rows, GRID_W, NA_HEADS, NA_HD)
    vg = qkv_l[:, :, 2].reshape(B, rows, GRID_W, NA_HEADS, NA_HD)
    colq = jnp.arange(GRID_W)
    cidx = jnp.clip(colq - NA_KC // 2, 0, GRID_W - NA_KC)[:, None] + jnp.arange(NA_KC)
    dc = cidx - colq[:, None]

    def row_block(r):
        rs = jnp.clip(r - kr // 2, 0, rows - kr)
        kb = lax.dynamic_slice_in_dim(kg, rs, kr, 1)[:, :, cidx]
        vb = lax.dynamic_slice_in_dim(vg, rs, kr, 1)[:, :, cidx]
        qb = lax.dynamic_index_in_dim(qg, r, 1, keepdims=False)
        dr = rs + jnp.arange(kr) - r
        bias = rpb[:, dr[None, :, None] + NA_KR_MAX - 1, dc[:, None, :] + NA_KC - 1]
        s_loc = jnp.einsum('bqhd,brqchd->bhqrc', qb, kb) * scale + bias[None]
        s_ctx = jnp.einsum('bqhd,bkhd->bhqk', qb, k_c) * scale
        p = softmax_f32(jnp.concatenate([s_loc.reshape(B, NA_HEADS, GRID_W, nloc), s_ctx], -1), vb.dtype)
        p_loc = p[..., :nloc].reshape(B, NA_HEADS, GRID_W, kr, NA_KC)
        return (jnp.einsum('bhqrc,brqchd->bqhd', p_loc, vb)
                + jnp.einsum('bhqk,bkhd->bqhd', p[..., nloc:], v_c))

    o = lax.map(row_block, jnp.arange(rows))
    y_l = o.transpose(1, 0, 2, 3, 4).reshape(B, S, NA_HEADS * NA_HD) @ w_o
    y_c = None
    if with_ctx:
        s = jnp.einsum('bqhd,bkhd->bhqk', q_c, k_c) * scale
        o_c = jnp.einsum('bhqk,bkhd->bqhd', softmax_f32(s, v_c.dtype), v_c)
        y_c = o_c.reshape(B, C, NA_HEADS * NA_HD) @ w_o
    return y_c, y_l


def swa_mixer(h_c, h_l, ang, w_qkv, sinks, w_o, with_ctx):
    B, S, _ = h_l.shape
    G = SW_HEADS // SW_KV_HEADS
    nq, nk = SW_HEADS * SW_HD, SW_KV_HEADS * SW_HD
    scale = SW_HD ** -0.5
    sink = sinks.reshape(SW_KV_HEADS, G).astype(jnp.float32)

    def proj(h):
        L = h.shape[1]
        qkv = h @ w_qkv
        q = qkv[..., :nq].reshape(B, L, SW_HEADS, SW_HD)
        k = qkv[..., nq:nq + nk].reshape(B, L, SW_KV_HEADS, SW_HD)
        v = qkv[..., nq + nk:].reshape(B, L, SW_KV_HEADS, SW_HD)
        return q, k, v

    def scores(q, k):
        qg = q.reshape(q.shape[0], q.shape[1], SW_KV_HEADS, G, SW_HD)
        return (jnp.einsum('bqkgd,bnkd->bkgqn', qg, k) * scale).astype(jnp.float32)

    def out(p, v):
        o = jnp.einsum('bkgqn,bnkd->bqkgd', p, v)
        return o.reshape(o.shape[0], o.shape[1], nq)

    def with_sink(s):
        return jnp.concatenate([s, jnp.broadcast_to(sink[None, :, :, None, None], s.shape[:-1] + (1,))], -1)

    q_l, k_l, v_l = proj(h_l)
    q_l, k_l = apply_rope(q_l, ang), apply_rope(k_l, ang)
    q_c, k_c, v_c = proj(h_c)
    band = QBLK + 2 * SW_WINDOW
    pad = ((0, 0), (SW_WINDOW, SW_WINDOW), (0, 0), (0, 0))
    kp, vp = jnp.pad(k_l, pad), jnp.pad(v_l, pad)
    rel = (jnp.arange(band) - SW_WINDOW)[None, :] - jnp.arange(QBLK)[:, None]

    def block(i):
        qb = lax.dynamic_slice_in_dim(q_l, i * QBLK, QBLK, 1)
        kb = lax.dynamic_slice_in_dim(kp, i * QBLK, band, 1)
        vb = lax.dynamic_slice_in_dim(vp, i * QBLK, band, 1)
        kpos = i * QBLK - SW_WINDOW + jnp.arange(band)
        ok = (jnp.abs(rel) <= SW_WINDOW) & (kpos >= 0)[None, :] & (kpos < S)[None, :]
        s_loc = jnp.where(ok, scores(qb, kb), NEG_INF)
        s = with_sink(jnp.concatenate([s_loc, scores(qb, k_c)], -1))
        p = jax.nn.softmax(s, axis=-1)[..., :-1].astype(vb.dtype)
        return out(p[..., :band], vb) + out(p[..., band:], v_c)

    o = lax.map(block, jnp.arange(S // QBLK))
    y_l = o.transpose(1, 0, 2, 3).reshape(B, S, nq) @ w_o
    y_c = None
    if with_ctx:
        p = jax.nn.softmax(with_sink(scores(q_c, k_c)), axis=-1)[..., :-1].astype(v_c.dtype)
        y_c = out(p, v_c) @ w_o
    return y_c, y_l


def hier_moe(h, w_grp, b_grp, w_rt, b_rt, w_gate, w_up, w_down):
    N, D = h.shape
    hf = h.astype(jnp.float32)
    p_grp = jax.nn.softmax(hf @ w_grp.astype(jnp.float32) + b_grp.astype(jnp.float32), axis=-1)
    w_g, g_idx = lax.top_k(p_grp, 1)
    logit_e = (hf @ w_rt.astype(jnp.float32) + b_rt.astype(jnp.float32)).reshape(N, MOE_GROUPS, MOE_PER_GROUP)
    logit_e = jnp.take_along_axis(logit_e, g_idx[:, :, None], axis=1)[:, 0]
    w_e, e_idx = lax.top_k(jax.nn.softmax(logit_e, axis=-1), MOE_TOPK)
    gate = (w_g * w_e / jnp.sum(w_e, axis=-1, keepdims=True)).reshape(-1)
    eid = (g_idx * MOE_PER_GROUP + e_idx).reshape(-1)
    tok = jnp.repeat(jnp.arange(N, dtype=jnp.int32), MOE_TOPK)
    T = N * MOE_TOPK
    order = jnp.argsort(eid)
    se = eid[order]
    counts = jnp.bincount(eid, length=MOE_EXPERTS)
    start = jnp.cumsum(counts) - counts
    pcounts = (counts + MOE_BLK - 1) // MOE_BLK * MOE_BLK
    pend = jnp.cumsum(pcounts)
    dest = pend[se] - pcounts[se] + jnp.arange(T) - start[se]
    cap = -(-T // MOE_BLK) * MOE_BLK + MOE_EXPERTS * MOE_BLK
    nblk = cap // MOE_BLK
    buf_tok = jnp.zeros((cap,), jnp.int32).at[dest].set(tok[order])
    buf_gate = jnp.zeros((cap,), jnp.float32).at[dest].set(gate[order])
    blk_e = jnp.minimum(jnp.searchsorted(pend, jnp.arange(nblk) * MOE_BLK, side='right'), MOE_EXPERTS - 1)
    xb = h[buf_tok].reshape(nblk, MOE_BLK, D)

    def expert_block(args):
        xe, e = args
        return (jax.nn.silu(xe @ w_gate[e]) * (xe @ w_up[e])) @ w_down[e]

    yb = lax.map(expert_block, (xb, blk_e)).reshape(cap, D)
    return jnp.zeros_like(h).at[buf_tok].add(yb * buf_gate[:, None].astype(h.dtype))


def setup_inputs(seed: int = 0) -> dict:
    key = jax.random.key(seed)
    keys = iter(jax.random.split(key, 40))
    D = D_MODEL

    def nrm(shape, scale):
        return jax.random.normal(next(keys), shape, jnp.float32) * scale

    def gain(shape):
        return 1.0 + nrm(shape, 0.05)

    nA, nB, nC, nD = (_n_uses(m) for m in range(N_MIXERS))
    mla_qk = MLA_NOPE + MLA_ROPE
    sw_qkv = (SW_HEADS + 2 * SW_KV_HEADS) * SW_HD
    return {
        'x': nrm((BATCH, SEQ, D), 1.0),
        'c': nrm((BATCH, D), 1.0),
        'ctx': nrm((BATCH, CTX_LEN, D), 1.0),
        'c_ctx': nrm((D,), 1.0),
        'mod_w': nrm((DEPTH, D, 6 * D), 0.5 * D ** -0.5),
        'mod_b': nrm((DEPTH, 6 * D), 0.02),
        'norm1_g': gain((DEPTH, D)),
        'norm2_g': gain((DEPTH, D)),
        'mla_w_dq': nrm((nA, D, MLA_Q_RANK), D ** -0.5),
        'mla_g_q': gain((nA, MLA_Q_RANK)),
        'mla_w_uq': nrm((nA, MLA_Q_RANK, MLA_HEADS * mla_qk), MLA_Q_RANK ** -0.5),
        'mla_w_dkv': nrm((nA, D, MLA_KV_RANK + MLA_ROPE), D ** -0.5),
        'mla_g_kv': gain((nA, MLA_KV_RANK)),
        'mla_w_ukv': nrm((nA, MLA_KV_RANK, MLA_HEADS * (MLA_NOPE + MLA_V)), MLA_KV_RANK ** -0.5),
        'mla_w_o': nrm((nA, MLA_HEADS * MLA_V, D), (MLA_HEADS * MLA_V) ** -0.5),
        'fnet_w_o': nrm((nB, D, D), D ** -0.5),
        'fnet_b_o': nrm((nB, D), 0.02),
        'na_w_qkv': nrm((nC, D, 3 * NA_HEADS * NA_HD), D ** -0.5),
        'na_rpb': nrm((nC, NA_HEADS, 2 * NA_KR_MAX - 1, 2 * NA_KC - 1), 0.5),
        'na_w_o': nrm((nC, NA_HEADS * NA_HD, D), (NA_HEADS * NA_HD) ** -0.5),
        'swa_w_qkv': nrm((nD, D, sw_qkv), D ** -0.5),
        'swa_sinks': nrm((nD, SW_HEADS), 0.5),
        'swa_w_o': nrm((nD, SW_HEADS * SW_HD, D), (SW_HEADS * SW_HD) ** -0.5),
        'moe_w_grp': nrm((DEPTH, D, MOE_GROUPS), D ** -0.5),
        'moe_b_grp': nrm((DEPTH, MOE_GROUPS), 0.01),
        'moe_w_rt': nrm((DEPTH, D, MOE_EXPERTS), D ** -0.5),
        'moe_b_rt': nrm((DEPTH, MOE_EXPERTS), 0.01),
        'moe_w_gate': nrm((DEPTH, MOE_EXPERTS, D, MOE_FF), D ** -0.5),
        'moe_w_up': nrm((DEPTH, MOE_EXPERTS, D, MOE_FF), D ** -0.5),
        'moe_w_down': nrm((DEPTH, MOE_EXPERTS, MOE_FF, D), MOE_FF ** -0.5),
        'final_g': gain((D,)),
    }


def reference(x, c, ctx, c_ctx, mod_w, mod_b, norm1_g, norm2_g,
              mla_w_dq, mla_g_q, mla_w_uq, mla_w_dkv, mla_g_kv, mla_w_ukv, mla_w_o,
              fnet_w_o, fnet_b_o,
              na_w_qkv, na_rpb, na_w_o,
              swa_w_qkv, swa_sinks, swa_w_o,
              moe_w_grp, moe_b_grp, moe_w_rt, moe_b_rt, moe_w_gate, moe_w_up, moe_w_down,
              final_g):
    B, S, D = x.shape
    t = jnp.arange(S)
    ang = axial_rope_angles(t // GRID_W, t % GRID_W, MLA_ROPE)
    c_act = jax.nn.silu(c)
    cc_act = jax.nn.silu(c_ctx)
    x_lat, x_ctx = x, ctx
    for i in range(DEPTH):
        m, j = i % N_MIXERS, i // N_MIXERS
        with_ctx = i < DEPTH - 1
        mod_l = (c_act @ mod_w[i] + mod_b[i])[:, None, :]
        mod_c = cc_act @ mod_w[i] + mod_b[i]
        sh1_l, sc1_l, g1_l, sh2_l, sc2_l, g2_l = jnp.split(mod_l, 6, axis=-1)
        sh1_c, sc1_c, g1_c, sh2_c, sc2_c, g2_c = jnp.split(mod_c, 6, axis=-1)
        h_l = rmsnorm(x_lat, norm1_g[i]) * (1 + sc1_l) + sh1_l
        h_c = rmsnorm(x_ctx, norm1_g[i]) * (1 + sc1_c) + sh1_c
        if m == 0:
            y_c, y_l = mla_mixer(h_c, h_l, ang, mla_w_dq[j], mla_g_q[j], mla_w_uq[j], mla_w_dkv[j],
                                 mla_g_kv[j], mla_w_ukv[j], mla_w_o[j], with_ctx)
        elif m == 1:
            y_c, y_l = fnet_mixer(h_c, h_l, fnet_w_o[j], fnet_b_o[j], with_ctx)
        elif m == 2:
            y_c, y_l = na_mixer(h_c, h_l, na_w_qkv[j], na_rpb[j], na_w_o[j], with_ctx)
        else:
            y_c, y_l = swa_mixer(h_c, h_l, ang, swa_w_qkv[j], swa_sinks[j], swa_w_o[j], with_ctx)
        x_lat = x_lat + g1_l * y_l
        h2_l = rmsnorm(x_lat, norm2_g[i]) * (1 + sc2_l) + sh2_l
        moe_args = (moe_w_grp[i], moe_b_grp[i], moe_w_rt[i], moe_b_rt[i],
                    moe_w_gate[i], moe_w_up[i], moe_w_down[i])
        if with_ctx:
            x_ctx = x_ctx + g1_c * y_c
            h2_c = rmsnorm(x_ctx, norm2_g[i]) * (1 + sc2_c) + sh2_c
            n_c = h2_c.shape[0] * h2_c.shape[1]
            f = hier_moe(jnp.concatenate([h2_c.reshape(-1, D), h2_l.reshape(-1, D)], axis=0), *moe_args)
            x_ctx = x_ctx + g2_c * f[:n_c].reshape(h2_c.shape)
            x_lat = x_lat + g2_l * f[n_c:].reshape(h2_l.shape)
        else:
            x_lat = x_lat + g2_l * hier_moe(h2_l.reshape(-1, D), *moe_args).reshape(h2_l.shape)
    return rmsnorm(x_lat, final_g)
```

```cpp
#include <hip/hip_runtime.h>
#include <stdint.h>
#include <stdio.h>
#include <string.h>

#define DI __device__ __forceinline__
#define LAS __attribute__((address_space(3)))
typedef unsigned short bf16_t;
typedef short bf16x8 __attribute__((ext_vector_type(8)));
typedef short s16x4 __attribute__((ext_vector_type(4)));
typedef float f32x4 __attribute__((ext_vector_type(4)));
typedef float f32x16 __attribute__((ext_vector_type(16)));
typedef unsigned u32x4 __attribute__((ext_vector_type(4)));
typedef unsigned u32x2 __attribute__((ext_vector_type(2)));

#ifndef MLA_FP8
#define MLA_FP8 1
#endif
#if defined(MLA_CHECK) || !MLA_FP8
#define MLA_KEEP_BF16 1
#else
#define MLA_KEEP_BF16 0
#endif
#ifndef GEMM_FP8
#if defined(MLA_CHECK)
#define GEMM_FP8 0
#else
#define GEMM_FP8 1
#endif
#endif
#ifndef WO_FP8
#define WO_FP8 GEMM_FP8
#endif
#ifndef MK_ONE_LAUNCH
#define MK_ONE_LAUNCH 1
#endif

constexpr int D = 1024, SEQ = 16384, NCTX = 256, TB = SEQ + NCTX  , T = 2 * TB  ;
constexpr int NTHR = 512;
constexpr int MOE_MAXT = 292;
constexpr int MOE_SLOTS = MOE_MAXT * 256;
constexpr float EPS = 1e-6f;

constexpr size_t al256(size_t x) { return (x + 255) / 256 * 256; }
constexpr size_t WS_CTL = 0;
constexpr size_t CTL_BYTES = 65536;
constexpr size_t CTL_COUNTS = 16384;
constexpr size_t WS_MODP = WS_CTL + CTL_BYTES;
constexpr size_t WS_MODV = WS_MODP + (size_t)16 * 4 * 3 * 6144 * 4;
constexpr size_t WS_MODA = WS_MODV + (size_t)4 * 3 * 6144 * 4;
constexpr size_t WS_ROPE = WS_MODA + (size_t)4 * 3 * 2 * 1024 * 4;
constexpr size_t WS_EID = WS_ROPE + 256 * 16 * 2 * 4;
constexpr size_t WS_GW = WS_EID + (size_t)T * 8;
constexpr size_t WS_POS = WS_GW + (size_t)T * 8;
constexpr size_t WS_SLOT = WS_POS + (size_t)T * 8;
constexpr size_t WS_BTOK = WS_SLOT + (size_t)T * 8;
constexpr size_t WS_SQQ = al256(WS_BTOK + (size_t)MOE_SLOTS * 4);
constexpr size_t WS_SQKV = WS_SQQ + (size_t)T * 8;
constexpr size_t WS_SQX = WS_SQKV + (size_t)T * 4;
constexpr int RW_PITCH = 2064, RW_HALF = 36 * RW_PITCH;
constexpr size_t WS_RW = al256(WS_SQX + (size_t)T * 16);
constexpr size_t WS_WT = al256(WS_RW + (size_t)4 * 2 * RW_HALF);
constexpr size_t WT_P1 = 0;
constexpr size_t WT_UQ = WT_P1 + (size_t)1024 * 1024;
constexpr size_t WT_UKV = WT_UQ + (size_t)1536 * 512;
constexpr size_t WT_WO0 = WT_UKV + (size_t)2048 * 256;
constexpr size_t WT_WO1 = WT_WO0 + (size_t)1024 * 1024;
constexpr size_t WT_NAQKV = WT_WO1 + (size_t)1024 * 1024;
constexpr size_t WT_WO2 = WT_NAQKV + (size_t)3072 * 1024;
constexpr size_t WT_SWQKV = WT_WO2 + (size_t)1024 * 1024;
constexpr size_t WT_WO3 = WT_SWQKV + (size_t)1536 * 1024;
constexpr size_t WT_DFTA = WT_WO3 + (size_t)1024 * 1024;
constexpr size_t WT_DFT1 = WT_DFTA + (size_t)512 * 256;
constexpr size_t WT_DFT2 = WT_DFT1 + (size_t)256 * 256;
constexpr size_t WT_DFTC = WT_DFT2 + (size_t)256 * 256;
constexpr size_t WT_END = WT_DFTC + (size_t)256 * 512;
constexpr size_t WS_MOEW = al256(WS_WT + WT_END * 2);
constexpr size_t MOEW_G = 0, MOEW_U = (size_t)32 * 512 * 1024, MOEW_D = (size_t)2 * 32 * 512 * 1024, MOEW_EL = (size_t)3 * 32 * 512 * 1024;
constexpr size_t WS_XRES = al256(WS_MOEW + MOEW_EL * 2);
constexpr size_t WS_H = WS_XRES + (size_t)T * D * 4;
constexpr size_t WS_SCR = WS_H + (size_t)T * D * 2;
constexpr size_t SC_CQ = 0;
constexpr size_t SC_CKV = SC_CQ + (size_t)T * 512 * 2;
constexpr size_t SC_Q = SC_CKV + (size_t)T * 256 * 2;
constexpr size_t SC_K = SC_Q + (size_t)T * 1536 * 2;
constexpr size_t SC_V = SC_K + (size_t)T * 1536 * 2;
constexpr size_t SC_O = SC_V + (size_t)T * 1024 * 2;
constexpr size_t SC_Q8 = SC_O + (size_t)T * 1024 * 2;
constexpr size_t SC_K8 = SC_Q8 + (size_t)T * 1536;
constexpr size_t SC_V8T = SC_K8 + (size_t)T * 1536;
constexpr size_t SC_END_MLA = SC_V8T + (size_t)T * 1024;
constexpr size_t SF_Z = 0;
constexpr size_t SF_ZC = SF_Z + (size_t)2048 * 128 * 256 * 2;
constexpr size_t SF_A1 = SF_ZC + (size_t)2048 * 512 * 2;
constexpr size_t SF_YF = SF_A1 + (size_t)2048 * 128 * 256 * 2;
constexpr size_t SN_Q = 0, SN_K = (size_t)T * 2048, SN_V = (size_t)T * 4096, SN_O = (size_t)T * 6144;
constexpr size_t SS_Q = 0, SS_K = (size_t)T * 2048, SS_V = SS_K + (size_t)T * 512, SS_O = SS_V + (size_t)T * 512;
constexpr size_t SM_ACT = 0;
constexpr size_t SM_Y = (size_t)MOE_SLOTS * 1024;
constexpr size_t SM_END = SM_Y + (size_t)MOE_SLOTS * 2048;
constexpr size_t SCR_BYTES = SC_END_MLA > SM_END ? SC_END_MLA : SM_END;
constexpr size_t WS_END = WS_SCR + SCR_BYTES;

constexpr int LDS_MISC = 152 * 1024;
constexpr int LDS_BYTES = 156 * 1024;

DI unsigned cvt_pk(float lo, float hi) { unsigned r; asm volatile("v_cvt_pk_bf16_f32 %0, %1, %2" : "=v"(r) : "v"(lo), "v"(hi)); return r; }
DI float bf2f(bf16_t x) { return __uint_as_float((unsigned)x << 16); }
DI float bflo(unsigned w) { return __uint_as_float(w << 16); }
DI float bfhi(unsigned w) { return __uint_as_float(w & 0xffff0000u); }
DI float silu_f(float x) { return x / (1.0f + __expf(-x)); }
DI float wave_sum(float v) {
#pragma unroll
    for (int o = 32; o >= 1; o >>= 1) v += __shfl_xor(v, o);
    return v;
}

#define XB_TMO      128
#define XB_XCNT(j)  (256  + 64 * (j))
#define XB_XSUB(j)  (1280 + 64 * (j))
#define XB_XGEN(j)  (2304 + 64 * (j))
#define XB_TOP      3328
#define XB_TOPGEN   3392
#define XCD_BAR_WORDS 3456
#define XB_SPIN_CAP (1u << 18)

__device__ __forceinline__ unsigned xb_ld(unsigned* p)              { return __hip_atomic_load(p, __ATOMIC_RELAXED, __HIP_MEMORY_SCOPE_AGENT); }
__device__ __forceinline__ unsigned xb_add(unsigned* p, unsigned v) { return __hip_atomic_fetch_add(p, v, __ATOMIC_RELAXED, __HIP_MEMORY_SCOPE_AGENT); }
__device__ __forceinline__ unsigned xb_xcc_id() { return (unsigned)__builtin_amdgcn_s_getreg((3 << 11) | 20) & 0xFu; }
#define XB_SPIN(cond, bar) do { unsigned _sp = 0; while (cond) { __builtin_amdgcn_s_sleep(1); \
    if ((++_sp & 255u) == 0u) { if (xb_ld(&(bar)[XB_TMO])) break; if (_sp > XB_SPIN_CAP) { atomicAdd(&(bar)[XB_TMO], 1u); break; } } } } while (0)

struct XcdBarrier {
    unsigned* bar; unsigned x;
    volatile LAS unsigned* st;
};
__device__ __forceinline__ XcdBarrier xcd_barrier_post(unsigned* bar, volatile LAS unsigned* st) {
    XcdBarrier b; b.bar = bar; b.x = xb_xcc_id(); b.st = st;
    if (threadIdx.x == 0) (void)xb_add(&bar[XB_XCNT(b.x)], 1u);
    return b;
}
__device__ __forceinline__ void xcd_barrier_complete(unsigned* bar, unsigned x, unsigned& nloc, unsigned& nx) {
    const unsigned G = gridDim.x * gridDim.y * gridDim.z;
    unsigned sum, cnt, mine, sp = 0u;
    for (;;) {
        sum = 0u; cnt = 0u; mine = 0u;
#pragma unroll
        for (unsigned j = 0; j < 16; ++j) { const unsigned c = xb_ld(&bar[XB_XCNT(j)]); sum += c; cnt += (c > 0u) ? 1u : 0u; mine = (j == x) ? c : mine; }
        if (sum == G) break;
        __builtin_amdgcn_s_sleep(1);
        if ((++sp & 255u) == 0u) { if (xb_ld(&bar[XB_TMO])) break; if (sp > XB_SPIN_CAP) { atomicAdd(&bar[XB_TMO], 1u); break; } }
    }
    nloc = mine > 0u ? mine : 1u; nx = cnt > 0u ? cnt : 1u;
}
__device__ __forceinline__ void xcd_barrier(const XcdBarrier& b) {
    asm volatile("s_waitcnt vmcnt(0)" ::: "memory");
    __syncthreads();
    if (threadIdx.x == 0) {
        unsigned* bar = b.bar;
        __builtin_amdgcn_s_waitcnt(0);
        unsigned nloc = b.st[0], nx = b.st[1];
        if (nloc == 0u) { xcd_barrier_complete(bar, b.x, nloc, nx); b.st[0] = nloc; b.st[1] = nx; }
        const unsigned old = xb_add(&bar[XB_XSUB(b.x)], 1u);
        const unsigned gen = old / nloc;
        if (old + 1u == (gen + 1u) * nloc) {
            __builtin_amdgcn_fence(__ATOMIC_RELEASE, "agent");
            asm volatile("s_waitcnt vmcnt(0)" ::: "memory");
            const unsigned og = xb_add(&bar[XB_TOP], 1u);
            const unsigned tg = og / nx;
            if (og + 1u == (tg + 1u) * nx) xb_add(&bar[XB_TOPGEN], 1u);
            else XB_SPIN(xb_ld(&bar[XB_TOPGEN]) == tg, bar);
            __builtin_amdgcn_fence(__ATOMIC_ACQUIRE, "agent");
            xb_add(&bar[XB_XGEN(b.x)], 1u);
            asm volatile("s_waitcnt vmcnt(0)" ::: "memory");
        } else {
            XB_SPIN(xb_ld(&bar[XB_XGEN(b.x)]) == gen, bar);
            __builtin_amdgcn_fence(__ATOMIC_ACQUIRE, "agent");
            asm volatile("s_waitcnt vmcnt(0)" ::: "memory");
        }
    }
    __syncthreads();
}

namespace g8 {
#ifndef PIN8
#define PIN8 1
#endif
#ifndef G8_MERGE
#define G8_MERGE 0
#endif
constexpr int HTB = 128 * 64 * 2;
constexpr int STAGE_BYTES = 8 * HTB;
DI int lds_byte(int r, int c) { const int st = (r >> 4) * 2 + (c >> 5), rr = r & 15, cc = c & 31, ob = rr * 64 + cc * 2; return st * 1024 + (ob ^ (((ob >> 9) & 1) << 5)); }
DI void stage_rc(int b, int& R, int& C) { const int st = b / 1024, sb = b % 1024, swz = sb ^ (((sb >> 9) & 1) << 5); R = (st >> 1) * 16 + swz / 64; C = (st & 1) * 32 + (swz % 64) / 2; }

typedef f32x4 Acc[2][2][4][2];
typedef int v8i_t __attribute__((ext_vector_type(8)));
DI v8i_t ld8_2x16(const char* p) { const u32x4 a = *reinterpret_cast<const u32x4*>(p), b = *reinterpret_cast<const u32x4*>(p + 16); return (v8i_t){(int)a.x, (int)a.y, (int)a.z, (int)a.w, (int)b.x, (int)b.y, (int)b.z, (int)b.w}; }

struct Opnd { const bf16_t* b0; const bf16_t* b1; int ld; const int* idx; };
DI Opnd opnd(const bf16_t* b0, const bf16_t* b1, int ld) { return Opnd{b0, b1, ld, nullptr}; }
DI Opnd opnd(const bf16_t* b0, int ld) { return Opnd{b0, b0 + (size_t)128 * ld, ld, nullptr}; }
template <bool GATHER, bool HALFX = false, bool FP8 = false, int YSCALE = 127, bool LD16 = true, bool MERGE = (G8_MERGE != 0)>
DI void gemm_unit(const Opnd X, const Opnd Y, const int K, char* lds, Acc& acc) {
    int tid = threadIdx.x; asm volatile("" : "+v"(tid));
    int r0, c0; stage_rc(tid * 16, r0, c0);
    unsigned vx0, vx1, vx2, vx3;
    if (GATHER) { vx0 = (unsigned)(X.idx[r0] * X.ld + c0) * 2u; vx1 = (unsigned)(X.idx[r0 + 64] * X.ld + c0) * 2u;
                  if (HALFX) { vx2 = vx0; vx3 = vx1; } else { vx2 = (unsigned)(X.idx[128 + r0] * X.ld + c0) * 2u; vx3 = (unsigned)(X.idx[192 + r0] * X.ld + c0) * 2u; } }
    else { vx0 = (unsigned)(r0 * X.ld + c0) * 2u; vx1 = vx0; vx2 = vx0; vx3 = vx0; }
    const unsigned vy0 = (unsigned)(r0 * Y.ld + c0) * 2u;
    const size_t xd64 = GATHER ? 0 : (size_t)128 * X.ld, yd64 = (size_t)128 * Y.ld;
    const char* const XB0 = (const char*)X.b0; const char* const XB1 = GATHER ? (const char*)X.b0 : (const char*)X.b1;
    const char* const YB0 = (const char*)Y.b0; const char* const YB1 = (const char*)Y.b1;
    const int wid = tid >> 6, lane = tid & 63, wr = wid >> 2, wc = wid & 3, fr = lane & 15, fq = lane >> 4;
    const int wbase = __builtin_amdgcn_readfirstlane(tid >> 6) * 1024;
    const int swz_ = (fr * 64 + fq * 16) ^ ((((fr * 64 + fq * 16) >> 9) & 1) << 5);
    const char* const abase = lds + wr * 8192 + swz_;
    const char* const bbase = lds + 4 * HTB + wc * 4096 + swz_;
    const int swz8_ = (fr * 64 + (fq & 1) * 32) ^ ((((fr * 64 + (fq & 1) * 32) >> 9) & 1) << 5);
    const char* const abase8 = lds + wr * 8192 + (fq >> 1) * 1024 + swz8_;
    const char* const bbase8 = lds + 4 * HTB + wc * 4096 + (fq >> 1) * 1024 + swz8_;
#define SA(b, h) (lds + ((b) * 2 + (h)) * HTB)
#define SB(b, h) (lds + (4 + (b) * 2 + (h)) * HTB)
#define STG(P, BASE, DELTA, o0, o1, kt) do { const char* _s = (BASE) + (size_t)(kt) * 128; unsigned o0_ = (o0), o1_ = (o1); \
    if (FP8) asm volatile("" : "+v"(o0_), "+v"(o1_));     \
    __builtin_amdgcn_global_load_lds((const unsigned*)(_s + o0_), (unsigned*)((P) + wbase), 16, 0, 0); \
    __builtin_amdgcn_global_load_lds((const unsigned*)(_s + (DELTA) + o1_), (unsigned*)((P) + wbase + 8192), 16, 0, 0); } while (0)
#define STGA(b, h, kt) do { if ((h) == 0) STG(SA(b, 0), XB0, xd64, vx0, vx1, kt); else STG(SA(b, 1), XB1, xd64, vx2, vx3, kt); } while (0)
#define STGB(b, h, kt) do { if ((h) == 0) STG(SB(b, 0), YB0, yd64, vy0, vy0, kt); else STG(SB(b, 1), YB1, yd64, vy0, vy0, kt); } while (0)
#define LD8(P) (LD16 ? ld8_2x16(P) : *reinterpret_cast<const v8i_t*>(P))
#define LDA(dst, b, h) do { if (FP8) { _Pragma("unroll") for (int m = 0; m < 4; ++m) dst##8[m] = LD8(abase8 + (((b) * 2 + (h)) * HTB + m * 2048)); } \
    else { _Pragma("unroll") for (int m = 0; m < 4; ++m) _Pragma("unroll") for (int k = 0; k < 2; ++k) dst[m][k] = *reinterpret_cast<const bf16x8*>(abase + (((b) * 2 + (h)) * HTB + m * 2048 + k * 1024)); } } while (0)
#define LDB(dst, b, h) do { if (FP8) { _Pragma("unroll") for (int n = 0; n < 2; ++n) dst##8[n] = LD8(bbase8 + (((b) * 2 + (h)) * HTB + n * 2048)); } \
    else { _Pragma("unroll") for (int n = 0; n < 2; ++n) _Pragma("unroll") for (int k = 0; k < 2; ++k) dst[n][k] = *reinterpret_cast<const bf16x8*>(bbase + (((b) * 2 + (h)) * HTB + n * 2048 + k * 1024)); } } while (0)
#define MMA(ai, bj, At, Bt) do { if (FP8 && HALFX && (ai) == 1) break; if (FP8) __builtin_amdgcn_sched_barrier(0); __builtin_amdgcn_s_setprio(1); \
    if (FP8) { _Pragma("unroll") for (int m = 0; m < 4; ++m) _Pragma("unroll") for (int n = 0; n < 2; ++n) \
      acc[ai][bj][m][n] = __builtin_amdgcn_mfma_scale_f32_16x16x128_f8f6f4(Bt##8[n], At##8[m], acc[ai][bj][m][n], 0, 0, 0, sc_y, 0, sc_x); } \
    else { _Pragma("unroll") for (int m = 0; m < 4; ++m) _Pragma("unroll") for (int n = 0; n < 2; ++n) _Pragma("unroll") for (int k = 0; k < 2; ++k) \
      acc[ai][bj][m][n] = __builtin_amdgcn_mfma_f32_16x16x32_bf16(Bt[n][k], At[m][k], acc[ai][bj][m][n], 0, 0, 0); } \
    __builtin_amdgcn_s_setprio(0); \
    if (FP8 && PIN8) { asm volatile("" :: "v"(acc[ai][bj][0][0]), "v"(acc[ai][bj][0][1]), "v"(acc[ai][bj][1][0]), "v"(acc[ai][bj][1][1]), "v"(acc[ai][bj][2][0]), "v"(acc[ai][bj][2][1]), "v"(acc[ai][bj][3][0]), "v"(acc[ai][bj][3][1])); \
               __builtin_amdgcn_sched_barrier(0); } } while (0)
#define WAIT_V(n) asm volatile("s_waitcnt vmcnt(" #n ")" ::: "memory")
#define WAIT_L(n) asm volatile("s_waitcnt lgkmcnt(" #n ")" ::: "memory")
#define BAR __builtin_amdgcn_s_barrier()
#define SCHED __builtin_amdgcn_sched_barrier(0)
#pragma unroll
    for (int a = 0; a < 2; ++a)
#pragma unroll
        for (int b = 0; b < 2; ++b)
#pragma unroll
            for (int m = 0; m < 4; ++m)
#pragma unroll
                for (int n = 0; n < 2; ++n) acc[a][b][m][n] = (f32x4){0.f, 0.f, 0.f, 0.f};
    bf16x8 At[4][2], B0[2][2], B1[2][2];
    v8i_t At8[4], B08[2], B18[2];
    int sc_y = YSCALE * 0x01010101; if (FP8) asm volatile("" : "+v"(sc_y));
    const int sc_x = sc_y;
    int nt = K / 64; if (FP8) asm volatile("" : "+s"(nt));
    STGB(0, 0, 0); STGA(0, 0, 0); STGB(0, 1, 0); STGA(0, 1, 0);
    if constexpr (FP8 && MERGE) { STGB(1, 0, 1); STGA(1, 0, 1); STGB(1, 1, 1); WAIT_V(6); BAR; if (wr == 1) BAR; }
    else {
    if (wr == 1) BAR;
    WAIT_V(4); BAR;
    STGB(1, 0, 1); STGA(1, 0, 1); STGB(1, 1, 1);
    WAIT_V(6); BAR;
    }
    if constexpr (FP8 && MERGE) {
#pragma unroll 1
    for (int t = 0; t < nt - 2; t += 2) {
        LDB(B0, 0, 0); LDB(B1, 0, 1); SCHED; LDA(At, 0, 0); SCHED; STGA(1, 1, t + 1);
        WAIT_L(0); BAR; MMA(0, 0, At, B0); MMA(0, 1, At, B1); BAR; SCHED;
        LDA(At, 0, 1); SCHED; STGB(0, 0, t + 2); STGA(0, 0, t + 2); STGB(0, 1, t + 2);
        WAIT_V(6); WAIT_L(0); BAR; MMA(1, 0, At, B0); MMA(1, 1, At, B1); BAR; SCHED;
        LDB(B0, 1, 0); LDB(B1, 1, 1); SCHED; LDA(At, 1, 0); SCHED; STGA(0, 1, t + 2);
        WAIT_L(0); BAR; MMA(0, 0, At, B0); MMA(0, 1, At, B1); BAR; SCHED;
        LDA(At, 1, 1); SCHED; STGB(1, 0, t + 3); STGA(1, 0, t + 3); STGB(1, 1, t + 3);
        WAIT_V(6); WAIT_L(0); BAR; MMA(1, 0, At, B0); MMA(1, 1, At, B1); BAR; SCHED;
    }
    { LDB(B0, 0, 0); LDB(B1, 0, 1); SCHED; LDA(At, 0, 0); SCHED; STGA(1, 1, nt - 1);
      WAIT_L(0); BAR; MMA(0, 0, At, B0); MMA(0, 1, At, B1); BAR; SCHED;
      LDA(At, 0, 1); WAIT_V(0); WAIT_L(0); BAR; MMA(1, 0, At, B0); MMA(1, 1, At, B1); BAR; SCHED; }
    { LDB(B0, 1, 0); LDB(B1, 1, 1); SCHED; LDA(At, 1, 0);
      WAIT_L(0); BAR; MMA(0, 0, At, B0); MMA(0, 1, At, B1); BAR; SCHED;
      LDA(At, 1, 1); WAIT_L(0); BAR; MMA(1, 0, At, B0); MMA(1, 1, At, B1); BAR; }
    } else {
#pragma unroll 1
    for (int t = 0; t < nt - 2; t += 2) {
        LDB(B0, 0, 0); SCHED; LDA(At, 0, 0); STGA(1, 1, t + 1);
        WAIT_L(8); BAR; WAIT_L(0); MMA(0, 0, At, B0); BAR; SCHED;
        LDB(B1, 0, 1); STGB(0, 0, t + 2);
        BAR; WAIT_L(0); MMA(0, 1, At, B1); BAR;
        LDA(At, 0, 1); STGA(0, 0, t + 2);
        BAR; WAIT_L(0); MMA(1, 0, At, B0); BAR; SCHED;
        STGB(0, 1, t + 2);
        WAIT_V(6); BAR; MMA(1, 1, At, B1); BAR;
        LDB(B0, 1, 0); SCHED; LDA(At, 1, 0); STGA(0, 1, t + 2);
        WAIT_L(8); BAR; WAIT_L(0); MMA(0, 0, At, B0); BAR; SCHED;
        LDB(B1, 1, 1); STGB(1, 0, t + 3);
        BAR; WAIT_L(0); MMA(0, 1, At, B1); BAR;
        LDA(At, 1, 1); STGA(1, 0, t + 3);
        BAR; WAIT_L(0); MMA(1, 0, At, B0); BAR; SCHED;
        STGB(1, 1, t + 3);
        WAIT_V(6); BAR; MMA(1, 1, At, B1); BAR;
    }
    { LDB(B0, 0, 0); WAIT_V(0); LDA(At, 0, 0); STGA(1, 1, nt - 1);
      BAR; WAIT_L(0); MMA(0, 0, At, B0); BAR;
      LDB(B1, 0, 1); BAR; WAIT_L(0); MMA(0, 1, At, B1); BAR;
      LDA(At, 0, 1); WAIT_V(4); BAR; WAIT_L(0); MMA(1, 0, At, B0); MMA(1, 1, At, B1); BAR; }
    { LDB(B0, 1, 0); LDA(At, 1, 0); WAIT_V(2); BAR; WAIT_L(0); MMA(0, 0, At, B0); BAR;
      LDB(B1, 1, 1); WAIT_V(0); BAR; WAIT_L(0); MMA(0, 1, At, B1); BAR;
      LDA(At, 1, 1); BAR; WAIT_L(0); MMA(1, 0, At, B0); MMA(1, 1, At, B1); BAR; }
    }
    if (wr == 0) BAR;
#undef SA
#undef SB
#undef STG
#undef STGA
#undef STGB
#undef LDA
#undef LDB
#undef MMA
#undef LD8
}
}

struct LaneC { int wr, wc, fr, fq; };
DI LaneC lane_coords() { int tid = threadIdx.x; asm volatile("" : "+v"(tid)); const int wid = tid >> 6, lane = tid & 63; return LaneC{wid >> 2, wid & 3, lane & 15, lane >> 4}; }
#define EPI_R(ai, m) ((ai) * 128 + L.wr * 64 + (m) * 16 + L.fr)
#define EPI_S(bj, n) ((bj) * 128 + L.wc * 32 + (n) * 16 + 4 * L.fq)
DI void st_bf4(bf16_t* p, f32x4 v) { u32x2 w; w.x = cvt_pk(v[0], v[1]); w.y = cvt_pk(v[2], v[3]); *(u32x2*)p = w; }
DI unsigned pk4_fp8(float a, float b, float c, float d) { int w = __builtin_amdgcn_cvt_pk_fp8_f32(a, b, 0, false); w = __builtin_amdgcn_cvt_pk_fp8_f32(c, d, w, true); return (unsigned)w; }
DI unsigned pk4_fp8o(float a, float b, float c, float d) { int w = __builtin_amdgcn_cvt_pk_fp8_f32(a, b, (int)__float_as_uint(a), false); w = __builtin_amdgcn_cvt_pk_fp8_f32(c, d, w, true); return (unsigned)w; }
DI void st_fp8x4(unsigned char* p, f32x4 v) { *(unsigned*)p = pk4_fp8(v[0], v[1], v[2], v[3]); }
DI unsigned char fp8_1(float x) { return (unsigned char)(__builtin_amdgcn_cvt_pk_fp8_f32(x, 0.f, 0, false) & 0xff); }
DI const bf16_t* as_h(const unsigned char* p) { return (const bf16_t*)p; }
namespace at {
DI int crow(int r, int hi) { return (r & 3) + 8 * (r >> 2) + 4 * hi; }
template <int OFF> DI s16x4 tr_read(unsigned a) { s16x4 r; asm volatile("ds_read_b64_tr_b16 %0, %1 offset:%2" : "=&v"(r) : "v"(a), "i"(OFF) : "memory"); return r; }
#define AT_PK4(P, BASE, OUT) do { unsigned a0 = cvt_pk(P[BASE + 0], P[BASE + 1]), a1 = cvt_pk(P[BASE + 2], P[BASE + 3]); \
    unsigned b0 = cvt_pk(P[BASE + 4], P[BASE + 5]), b1 = cvt_pk(P[BASE + 6], P[BASE + 7]); \
    auto r0 = __builtin_amdgcn_permlane32_swap(a0, b0, false, false); auto r1 = __builtin_amdgcn_permlane32_swap(a1, b1, false, false); \
    u32x4 w = {r0[0], r1[0], r0[1], r1[1]}; OUT = __builtin_bit_cast(bf16x8, w); } while (0)

template <int DV, int VROW, int D0> DI void pv_one(f32x16& od, unsigned vb, bf16x8 pa0, bf16x8 pa1, bf16x8 pa2, bf16x8 pa3) {
    const s16x4 l0 = tr_read<(0 * 16) * VROW + 64 * D0>(vb), h0 = tr_read<(0 * 16 + 4) * VROW + 64 * D0>(vb);
    const s16x4 l1 = tr_read<(1 * 16) * VROW + 64 * D0>(vb), h1 = tr_read<(1 * 16 + 4) * VROW + 64 * D0>(vb);
    const s16x4 l2 = tr_read<(2 * 16) * VROW + 64 * D0>(vb), h2 = tr_read<(2 * 16 + 4) * VROW + 64 * D0>(vb);
    const s16x4 l3 = tr_read<(3 * 16) * VROW + 64 * D0>(vb), h3 = tr_read<(3 * 16 + 4) * VROW + 64 * D0>(vb);
    asm volatile("s_waitcnt lgkmcnt(0)" ::: "memory"); __builtin_amdgcn_sched_barrier(0);
#define AT_PK(Lo, Hi) (bf16x8){Lo[0], Lo[1], Lo[2], Lo[3], Hi[0], Hi[1], Hi[2], Hi[3]}
    od = __builtin_amdgcn_mfma_f32_32x32x16_bf16(pa0, AT_PK(l0, h0), od, 0, 0, 0);
    od = __builtin_amdgcn_mfma_f32_32x32x16_bf16(pa1, AT_PK(l1, h1), od, 0, 0, 0);
    od = __builtin_amdgcn_mfma_f32_32x32x16_bf16(pa2, AT_PK(l2, h2), od, 0, 0, 0);
    od = __builtin_amdgcn_mfma_f32_32x32x16_bf16(pa3, AT_PK(l3, h3), od, 0, 0, 0);
#undef AT_PK
}

template <int DQK, int DV, class Cfg>
DI void attn_unit(const Cfg& cfg, char* lds, const float* tbl) {
    constexpr int KROW = DQK * 2 + 16, VROW = DV * 2 + 16, KCH = DQK / 8, VCH = DV / 8, NKL = 64 * KCH / NTHR, NVL = 64 * VCH / NTHR, ND = DQK / 16, NO = DV / 32;
    static_assert(64 * KCH % NTHR == 0 && 64 * VCH % NTHR == 0, "staging split");
    const int tid = threadIdx.x, lane = tid & 63, r32 = lane & 31, hi = lane >> 5;
    const int wave = __builtin_amdgcn_readfirstlane(tid >> 6);
    char* Ks = lds; char* Vs = lds + 64 * KROW; float* al = (float*)(lds + 64 * KROW + 64 * VROW) + wave * 64;
    bf16x8 qr[ND];
    { const bf16_t* qp = cfg.qrow(wave, r32) + hi * 8;
#pragma unroll
      for (int d0 = 0; d0 < ND; ++d0) qr[d0] = *reinterpret_cast<const bf16x8*>(qp + d0 * 16); }
    f32x16 o[NO];
#pragma unroll
    for (int d = 0; d < NO; ++d)
#pragma unroll
        for (int r = 0; r < 16; ++r) o[d][r] = 0.f;
    float m_reg = cfg.m0(), l_reg = cfg.l0();
    const float C = cfg.cexp();
    const int NT = cfg.ntiles(), ldk = cfg.ldk(), ldv = cfg.ldv();
    bf16x8 kreg[NKL], vreg[NVL];
    const unsigned vb = (unsigned)(uintptr_t)Vs + (unsigned)((8 * hi + ((lane & 15) >> 2)) * VROW + (16 * ((lane >> 4) & 1) + 4 * (lane & 3)) * 2);
#define AT_LOAD(t) do { const bf16_t* kp = cfg.ktile(t); const bf16_t* vp = cfg.vtile(t); \
    _Pragma("unroll") for (int i = 0; i < NKL; ++i) { const int c = tid + NTHR * i, row = c / KCH, cc = c % KCH; kreg[i] = *reinterpret_cast<const bf16x8*>(kp + (long)row * ldk + cc * 8); } \
    _Pragma("unroll") for (int i = 0; i < NVL; ++i) { const int c = tid + NTHR * i, row = c / VCH, cc = c % VCH; vreg[i] = *reinterpret_cast<const bf16x8*>(vp + (long)row * ldv + cc * 8); } } while (0)
    AT_LOAD(0);
    for (int t = 0; t < NT; ++t) {
        __syncthreads();
#pragma unroll
        for (int i = 0; i < NKL; ++i) { const int c = tid + NTHR * i, row = c / KCH, cc = c % KCH; *reinterpret_cast<bf16x8*>(Ks + row * KROW + cc * 16) = kreg[i]; }
#pragma unroll
        for (int i = 0; i < NVL; ++i) { const int c = tid + NTHR * i, row = c / VCH, cc = c % VCH; *reinterpret_cast<bf16x8*>(Vs + row * VROW + cc * 16) = vreg[i]; }
        __syncthreads();
        if (t + 1 < NT) AT_LOAD(t + 1);
        if (cfg.active(t, wave)) {
            f32x16 p0, p1;
            cfg.init(p0, p1, t, wave, r32, hi, tbl);
#pragma unroll
            for (int d0 = 0; d0 < ND; ++d0) {
                const int cb = (d0 * 16 + hi * 8) * 2;
                const bf16x8 b0 = *reinterpret_cast<const bf16x8*>(Ks + r32 * KROW + cb);
                const bf16x8 b1 = *reinterpret_cast<const bf16x8*>(Ks + (32 + r32) * KROW + cb);
                p0 = __builtin_amdgcn_mfma_f32_32x32x16_bf16(b0, qr[d0], p0, 0, 0, 0);
                p1 = __builtin_amdgcn_mfma_f32_32x32x16_bf16(b1, qr[d0], p1, 0, 0, 0);
            }
            cfg.mask(p0, p1, t, wave, r32, hi, tbl);
            float pmax = p0[0];
#pragma unroll
            for (int r = 1; r < 16; ++r) pmax = fmaxf(pmax, p0[r]);
#pragma unroll
            for (int r = 0; r < 16; ++r) pmax = fmaxf(pmax, p1[r]);
            { auto rr = __builtin_amdgcn_permlane32_swap(__float_as_uint(pmax), __float_as_uint(pmax), false, false);
              pmax = fmaxf(__uint_as_float(rr[0]), __uint_as_float(rr[1])); }
            const float mn = fmaxf(m_reg, pmax);
            const float alpha = __builtin_amdgcn_exp2f((m_reg - mn) * C);
            m_reg = mn;
            const float mnC = -mn * C;
            float ps = 0.f;
#pragma unroll
            for (int r = 0; r < 16; ++r) { p0[r] = __builtin_amdgcn_exp2f(fmaf(p0[r], C, mnC)); ps += p0[r]; }
#pragma unroll
            for (int r = 0; r < 16; ++r) { p1[r] = __builtin_amdgcn_exp2f(fmaf(p1[r], C, mnC)); ps += p1[r]; }
            { auto rr = __builtin_amdgcn_permlane32_swap(__float_as_uint(ps), __float_as_uint(ps), false, false);
              ps = __uint_as_float(rr[0]) + __uint_as_float(rr[1]); }
            l_reg = l_reg * alpha + ps;
            if (__any(alpha < 1.f)) {
                if (hi == 0) al[r32] = alpha;
                asm volatile("s_waitcnt lgkmcnt(0)" ::: "memory");
#pragma unroll
                for (int r = 0; r < 16; ++r) { const float a = al[crow(r, hi)];
#pragma unroll
                    for (int d = 0; d < NO; ++d) o[d][r] *= a; }
            }
            bf16x8 pa0, pa1, pa2, pa3;
            AT_PK4(p0, 0, pa0); AT_PK4(p0, 8, pa1); AT_PK4(p1, 0, pa2); AT_PK4(p1, 8, pa3);
            pv_one<DV, VROW, 0>(o[0], vb, pa0, pa1, pa2, pa3);
            pv_one<DV, VROW, 1>(o[1], vb, pa0, pa1, pa2, pa3);
            if constexpr (NO > 2) { pv_one<DV, VROW, 2>(o[2], vb, pa0, pa1, pa2, pa3); pv_one<DV, VROW, 3>(o[3], vb, pa0, pa1, pa2, pa3); }
        }
    }
#undef AT_LOAD
    if (hi == 0) al[32 + r32] = l_reg;
    asm volatile("s_waitcnt lgkmcnt(0)" ::: "memory");
#pragma unroll
    for (int r = 0; r < 16; ++r) {
        const int orow_ = crow(r, hi);
        const float li = 1.0f / al[32 + orow_];
        bf16_t* op = cfg.orow(wave, orow_);
#pragma unroll
        for (int d = 0; d < NO; ++d) { if (WO_FP8) ((unsigned char*)cfg.O + (op - cfg.O))[d * 32 + r32] = fp8_1(o[d][r] * li * 64.f);
            else op[d * 32 + r32] = (bf16_t)(cvt_pk(o[d][r] * li, 0.f) & 0xffffu); }
    }
    __syncthreads();
}
constexpr int attn_lds_bytes(int dqk, int dv) { return 64 * (dqk * 2 + 16) + 64 * (dv * 2 + 16) + 8 * 64 * 4; }
}
namespace at {
struct MlaGeo { static constexpr int KROW = 384, VROW = 256, KB = 64 * KROW, VB = 64 * VROW; };
template <int D0> DI void mla_pv_issue(unsigned vb, s16x4 (&t)[8]) {
    t[0] = tr_read<(0 * 16) * MlaGeo::VROW>(vb); t[1] = tr_read<(0 * 16 + 4) * MlaGeo::VROW>(vb);
    t[2] = tr_read<(1 * 16) * MlaGeo::VROW>(vb); t[3] = tr_read<(1 * 16 + 4) * MlaGeo::VROW>(vb);
    t[4] = tr_read<(2 * 16) * MlaGeo::VROW>(vb); t[5] = tr_read<(2 * 16 + 4) * MlaGeo::VROW>(vb);
    t[6] = tr_read<(3 * 16) * MlaGeo::VROW>(vb); t[7] = tr_read<(3 * 16 + 4) * MlaGeo::VROW>(vb);
}
DI void mla_pv_mma(f32x16& od, const s16x4 (&t)[8], bf16x8 pa0, bf16x8 pa1, bf16x8 pa2, bf16x8 pa3) {
#define AT_PK(Lo, Hi) (bf16x8){Lo[0], Lo[1], Lo[2], Lo[3], Hi[0], Hi[1], Hi[2], Hi[3]}
    od = __builtin_amdgcn_mfma_f32_32x32x16_bf16(pa0, AT_PK(t[0], t[1]), od, 0, 0, 0);
    od = __builtin_amdgcn_mfma_f32_32x32x16_bf16(pa1, AT_PK(t[2], t[3]), od, 0, 0, 0);
    od = __builtin_amdgcn_mfma_f32_32x32x16_bf16(pa2, AT_PK(t[4], t[5]), od, 0, 0, 0);
    od = __builtin_amdgcn_mfma_f32_32x32x16_bf16(pa3, AT_PK(t[6], t[7]), od, 0, 0, 0);
#undef AT_PK
}
template <int PRB>
DI void mla_attn_unit(const bf16_t* __restrict__ qp0, const bf16_t* __restrict__ kp0, const bf16_t* __restrict__ vp0, bf16_t* __restrict__ op0, const int NT, char* lds) {
    constexpr int KROW = MlaGeo::KROW, VROW = MlaGeo::VROW, KB = MlaGeo::KB, VB = MlaGeo::VB, LDK = 1536, LDV = 1024, LDQ = 1536, LDO = 1024;
    const int tid = threadIdx.x, lane = tid & 63, r32 = lane & 31, hi = lane >> 5;
    const int wave = __builtin_amdgcn_readfirstlane(tid >> 6);
    const bool grpB = wave >= 4;
    char* const Kb = lds; char* const Vb = lds + 3 * KB;
    float* al = (float*)(lds + 3 * KB + 3 * VB) + wave * 64;
    const float C = 0.07216878364870322f * 1.4426950408889634f;
    bf16x8 qr[12];
    { const bf16_t* qp = qp0 + (size_t)(32 * wave + r32) * LDQ + hi * 8;
#pragma unroll
      for (int d0 = 0; d0 < 12; ++d0) qr[d0] = *reinterpret_cast<const bf16x8*>(qp + d0 * 16); }
    f32x16 o[4];
#pragma unroll
    for (int d = 0; d < 4; ++d)
#pragma unroll
        for (int r = 0; r < 16; ++r) o[d][r] = 0.f;
    float m_reg = -1e28f, l_reg = 0.f;
    unsigned kg0, kg1, kg2, vg0, vg1;
    { const int pa_ = wave * 64 + lane, pb_ = pa_ + 512, pc_ = pa_ + 1024;
      const int ra = pa_ / 24, sa = pa_ % 24, rb = pb_ / 24, sb = pb_ % 24, rc = pc_ / 24, sc_ = pc_ % 24;
      kg0 = (unsigned)(ra * LDK * 2 + ((sa & ~7) | ((sa & 7) ^ ((ra >> 1) & 7))) * 16);
      kg1 = (unsigned)(rb * LDK * 2 + ((sb & ~7) | ((sb & 7) ^ ((rb >> 1) & 7))) * 16);
      kg2 = (unsigned)(rc * LDK * 2 + ((sc_ & ~7) | ((sc_ & 7) ^ ((rc >> 1) & 7))) * 16);
      const int va = pa_ / 16, wa = pa_ % 16, vb2 = pb_ / 16, wb = pb_ % 16;
      vg0 = (unsigned)(va * LDV * 2 + (wa ^ ((va & 3) << 2)) * 16);
      vg1 = (unsigned)(vb2 * LDV * 2 + (wb ^ ((vb2 & 3) << 2)) * 16); }
    const int wdst = wave * 1024;
    int kx[4];
#pragma unroll
    for (int d = 0; d < 4; ++d) kx[d] = r32 * KROW + (((2 * d + hi) ^ ((r32 >> 1) & 7)) * 16);
    unsigned vx[4];
    { const int q = (lane & 15) >> 2;
#pragma unroll
      for (int d = 0; d < 4; ++d) vx[d] = (unsigned)((8 * hi + q) * VROW + 64 * (d ^ q) + 32 * ((lane >> 4) & 1) + 8 * (lane & 3)); }
#define MLA_STAGE(t) do { const int t_ = (t); if (PRB == 2) break; \
    if (t_ < NT) { const char* kb_ = (const char*)kp0 + (size_t)t_ * (64 * LDK * 2); char* kd_ = Kb + (t_ % 3) * KB + wdst; \
        __builtin_amdgcn_global_load_lds((const unsigned*)(kb_ + kg0), (unsigned*)(kd_), 16, 0, 0); \
        __builtin_amdgcn_global_load_lds((const unsigned*)(kb_ + kg1), (unsigned*)(kd_ + 8192), 16, 0, 0); \
        __builtin_amdgcn_global_load_lds((const unsigned*)(kb_ + kg2), (unsigned*)(kd_ + 16384), 16, 0, 0); } \
    if (t_ >= 1) { const char* vb_ = (const char*)vp0 + (size_t)(t_ - 1) * (64 * LDV * 2); char* vd_ = Vb + ((t_ - 1) % 3) * VB + wdst; \
        __builtin_amdgcn_global_load_lds((const unsigned*)(vb_ + vg0), (unsigned*)(vd_), 16, 0, 0); \
        __builtin_amdgcn_global_load_lds((const unsigned*)(vb_ + vg1), (unsigned*)(vd_ + 8192), 16, 0, 0); } } while (0)
#define MLA_BAR(nyoung) do { const int ny_ = (nyoung); if (ny_ >= 5) asm volatile("s_waitcnt vmcnt(5)" ::: "memory"); else if (ny_ >= 2) asm volatile("s_waitcnt vmcnt(2)" ::: "memory"); \
    else asm volatile("s_waitcnt vmcnt(0)" ::: "memory"); \
    asm volatile("s_waitcnt lgkmcnt(0)" ::: "memory"); __builtin_amdgcn_s_barrier(); asm volatile("" ::: "memory"); } while (0)
#define MLA_NY(j_) ((j_) + 2 < NT ? 5 : ((j_) + 2 == NT ? 2 : 0))
#define MLA_PVALL(VBUF) do { const unsigned v0_ = (unsigned)(uintptr_t)(VBUF); s16x4 ta[8], tb[8]; \
    mla_pv_issue<0>(v0_ + vx[0], ta); mla_pv_issue<1>(v0_ + vx[1], tb); \
    asm volatile("s_waitcnt lgkmcnt(8)" ::: "memory"); __builtin_amdgcn_sched_barrier(0); \
    mla_pv_mma(o[0], ta, pa0, pa1, pa2, pa3); __builtin_amdgcn_sched_barrier(0); \
    mla_pv_issue<2>(v0_ + vx[2], ta); \
    asm volatile("s_waitcnt lgkmcnt(8)" ::: "memory"); __builtin_amdgcn_sched_barrier(0); \
    mla_pv_mma(o[1], tb, pa0, pa1, pa2, pa3); __builtin_amdgcn_sched_barrier(0); \
    mla_pv_issue<3>(v0_ + vx[3], tb); \
    asm volatile("s_waitcnt lgkmcnt(8)" ::: "memory"); __builtin_amdgcn_sched_barrier(0); \
    mla_pv_mma(o[2], ta, pa0, pa1, pa2, pa3); \
    asm volatile("s_waitcnt lgkmcnt(0)" ::: "memory"); __builtin_amdgcn_sched_barrier(0); \
    mla_pv_mma(o[3], tb, pa0, pa1, pa2, pa3); } while (0)
    f32x16 p0, p1; bf16x8 pa0, pa1, pa2, pa3;
    MLA_STAGE(0); MLA_STAGE(1);
    MLA_BAR(0);
    if (grpB) { MLA_STAGE(2); MLA_BAR(NT > 2 ? 5 : 2); }
    for (int j = 0; j < NT; ++j) {
        {
            const char* Ks = Kb + (j % 3) * KB;
            const unsigned v0_ = (unsigned)(uintptr_t)(Vb + ((j + 2) % 3) * VB);
            s16x4 ta[8], tb[8];
#pragma unroll
            for (int r = 0; r < 16; ++r) { p0[r] = 0.f; p1[r] = 0.f; }
            bf16x8 f0[12], f1[12];
#pragma unroll
            for (int d = 0; d < 3; ++d) { f0[d] = *reinterpret_cast<const bf16x8*>(Ks + kx[d & 3] + 128 * (d >> 2)); f1[d] = *reinterpret_cast<const bf16x8*>(Ks + kx[d & 3] + 128 * (d >> 2) + 32 * KROW); }
            __builtin_amdgcn_sched_barrier(0);
            if (!grpB && j + 2 <= NT) MLA_STAGE(j + 2);
            __builtin_amdgcn_sched_barrier(0);
#pragma unroll
            for (int d0 = 0; d0 < 12; ++d0) {
                if (d0 + 3 < 12) { f0[d0 + 3] = *reinterpret_cast<const bf16x8*>(Ks + kx[(d0 + 3) & 3] + 128 * ((d0 + 3) >> 2)); f1[d0 + 3] = *reinterpret_cast<const bf16x8*>(Ks + kx[(d0 + 3) & 3] + 128 * ((d0 + 3) >> 2) + 32 * KROW); }
                if (d0 == 9 && j > 0 && PRB != 4) { mla_pv_issue<0>(v0_ + vx[0], ta); mla_pv_issue<1>(v0_ + vx[1], tb); }
                if (PRB != 3 || d0 == 0) { p0 = __builtin_amdgcn_mfma_f32_32x32x16_bf16(f0[d0], qr[d0], p0, 0, 0, 0);
                p1 = __builtin_amdgcn_mfma_f32_32x32x16_bf16(f1[d0], qr[d0], p1, 0, 0, 0); }
                __builtin_amdgcn_sched_barrier(0);
            }
            if (j > 0 && PRB != 4) {
                asm volatile("s_waitcnt lgkmcnt(8)" ::: "memory"); __builtin_amdgcn_sched_barrier(0);
                mla_pv_mma(o[0], ta, pa0, pa1, pa2, pa3); __builtin_amdgcn_sched_barrier(0);
                mla_pv_issue<2>(v0_ + vx[2], ta);
                asm volatile("s_waitcnt lgkmcnt(8)" ::: "memory"); __builtin_amdgcn_sched_barrier(0);
                mla_pv_mma(o[1], tb, pa0, pa1, pa2, pa3); __builtin_amdgcn_sched_barrier(0);
                mla_pv_issue<3>(v0_ + vx[3], tb);
                asm volatile("s_waitcnt lgkmcnt(8)" ::: "memory"); __builtin_amdgcn_sched_barrier(0);
                mla_pv_mma(o[2], ta, pa0, pa1, pa2, pa3);
                asm volatile("s_waitcnt lgkmcnt(0)" ::: "memory"); __builtin_amdgcn_sched_barrier(0);
                mla_pv_mma(o[3], tb, pa0, pa1, pa2, pa3);
            }
        }
        MLA_BAR(MLA_NY(j));
        if (grpB && j + 3 <= NT) MLA_STAGE(j + 3);
        {
            float pmax = p0[0];
#pragma unroll
            for (int r = 1; r < 16; ++r) pmax = fmaxf(pmax, p0[r]);
#pragma unroll
            for (int r = 0; r < 16; ++r) pmax = fmaxf(pmax, p1[r]);
            { auto rr = __builtin_amdgcn_permlane32_swap(__float_as_uint(pmax), __float_as_uint(pmax), false, false);
              pmax = fmaxf(__uint_as_float(rr[0]), __uint_as_float(rr[1])); }
            const float mn = fmaxf(m_reg, pmax);
            const float alpha = __builtin_amdgcn_exp2f((m_reg - mn) * C);
            m_reg = mn;
            const float mnC = -mn * C;
            float ps = 0.f;
#pragma unroll
            for (int r = 0; r < 16; ++r) { p0[r] = PRB == 1 ? fmaf(p0[r], C, mnC) : __builtin_amdgcn_exp2f(fmaf(p0[r], C, mnC)); ps += p0[r]; }
#pragma unroll
            for (int r = 0; r < 16; ++r) { p1[r] = PRB == 1 ? fmaf(p1[r], C, mnC) : __builtin_amdgcn_exp2f(fmaf(p1[r], C, mnC)); ps += p1[r]; }
            { auto rr = __builtin_amdgcn_permlane32_swap(__float_as_uint(ps), __float_as_uint(ps), false, false);
              ps = __uint_as_float(rr[0]) + __uint_as_float(rr[1]); }
            l_reg = l_reg * alpha + ps;
            if (__any(alpha < 1.f)) {
                if (hi == 0) al[r32] = alpha;
                asm volatile("s_waitcnt lgkmcnt(0)" ::: "memory");
#pragma unroll
                for (int r = 0; r < 16; ++r) { const float a_ = al[crow(r, hi)];
#pragma unroll
                    for (int d = 0; d < 4; ++d) o[d][r] *= a_; }
            }
            AT_PK4(p0, 0, pa0); AT_PK4(p0, 8, pa1); AT_PK4(p1, 0, pa2); AT_PK4(p1, 8, pa3);
        }
        MLA_BAR(MLA_NY(j));
    }
    MLA_PVALL(Vb + ((NT - 1) % 3) * VB);
    if (!grpB) MLA_BAR(0);
    if (hi == 0) al[32 + r32] = l_reg;
    asm volatile("s_waitcnt lgkmcnt(0)" ::: "memory");
#pragma unroll
    for (int r = 0; r < 16; ++r) {
        const int orow_ = crow(r, hi);
        const float li = 1.0f / al[32 + orow_];
        bf16_t* op = op0 + (size_t)(32 * wave + orow_) * LDO;
#pragma unroll
        for (int d = 0; d < 4; ++d) op[d * 32 + r32] = (bf16_t)(cvt_pk(o[d][r] * li, 0.f) & 0xffffu);
    }
    __syncthreads();
#undef MLA_STAGE
#undef MLA_BAR
#undef MLA_NY
#undef MLA_PVALL
}
}
namespace at {
typedef int v8i __attribute__((ext_vector_type(8)));
DI f32x16 mfma8(v8i a, v8i b, f32x16 c, int sa, int sb) { return __builtin_amdgcn_mfma_scale_f32_32x32x64_f8f6f4(a, b, c, 0, 0, 0, sa, 0, sb); }
DI v8i ld_frag(const char* p0, const char* p1) { const u32x4 a = *(const u32x4*)p0, b = *(const u32x4*)p1; return (v8i){(int)a.x, (int)a.y, (int)a.z, (int)a.w, (int)b.x, (int)b.y, (int)b.z, (int)b.w}; }
template <int PRB>
DI void mla_attn_unit_fp8(const unsigned char* __restrict__ qp0, const unsigned char* __restrict__ kp0, const unsigned char* __restrict__ vp0, bf16_t* __restrict__ op0, const int NT, char* lds) {
    constexpr int KB8 = 64 * 256, VB8 = 128 * 64, LDK = 1536, LDO = 1024;
    int tid = threadIdx.x; asm volatile("" : "+v"(tid));
    const int lane = tid & 63, r32 = lane & 31, hi = lane >> 5;
    const int wave = __builtin_amdgcn_readfirstlane(tid >> 6);
    const bool grpB = wave >= 4;
    char* const Kb = lds; char* const Vb = lds + 3 * KB8;
    float* al = (float*)(lds + 3 * KB8 + 3 * VB8) + wave * 64;
    const float C = 0.07216878364870322f * 1.4426950408889634f;
    v8i qf[3];
    { const unsigned char* qp = qp0 + (size_t)(32 * wave + r32) * LDK + 32 * hi;
#pragma unroll
      for (int c = 0; c < 3; ++c) qf[c] = ld_frag((const char*)qp + 64 * c, (const char*)qp + 64 * c + 16); }
    f32x16 o[4];
#pragma unroll
    for (int d = 0; d < 4; ++d)
#pragma unroll
        for (int r = 0; r < 16; ++r) o[d][r] = 0.f;
    float m_reg = -1e28f, l_reg = 0.f;
    int s1 = 0x7f7f7f7f; asm volatile("" : "+v"(s1)); const int sp = s1 & 0x7b7b7b7b;
    unsigned kg0, kg1, vg0;
    { const int pa_ = wave * 64 + lane, pb_ = pa_ + 512;
      const int ra = pa_ >> 4, qa = (pa_ & 15) ^ (2 * (ra & 7) + ((ra >> 3) & 1)), rb = pb_ >> 4, qb = (pb_ & 15) ^ (2 * (rb & 7) + ((rb >> 3) & 1));
      kg0 = (unsigned)(ra * LDK + (qa < 12 ? qa * 16 : 0)); kg1 = (unsigned)(rb * LDK + (qb < 12 ? qb * 16 : 0));
      const int vr = pa_ >> 2, vq = (pa_ & 3) ^ (2 * ((vr >> 2) & 1) + ((vr >> 3) & 1));
      vg0 = (unsigned)((size_t)vr * T + vq * 16); }
    const int wdst = wave * 1024;
    const int hs = (r32 >> 3) & 1, hdl = 16 - 32 * hs;
    int kxa[3];
#pragma unroll
    for (int c = 0; c < 3; ++c) kxa[c] = r32 * 256 + (((2 * c + hi) ^ (r32 & 7)) * 32) + 16 * hs;
    const int vxa = r32 * 64 + ((hi ^ ((r32 >> 2) & 1)) * 32) + 16 * hs;
#define M8_STAGE(t) do { const int t_ = (t); \
    if (t_ < NT) { const char* kb_ = (const char*)kp0 + (size_t)t_ * (64 * LDK); char* kd_ = Kb + (t_ % 3) * KB8 + wdst; \
        __builtin_amdgcn_global_load_lds((const unsigned*)(kb_ + kg0), (unsigned*)(kd_), 16, 0, 0); \
        __builtin_amdgcn_global_load_lds((const unsigned*)(kb_ + kg1), (unsigned*)(kd_ + 8192), 16, 0, 0); } \
    if (t_ >= 1) { const char* vb_ = (const char*)vp0 + (size_t)(t_ - 1) * 64; \
        __builtin_amdgcn_global_load_lds((const unsigned*)(vb_ + vg0), (unsigned*)(Vb + ((t_ - 1) % 3) * VB8 + wdst), 16, 0, 0); } } while (0)
#define M8_BAR(ny) do { const int ny_ = (ny); if (ny_ >= 3) asm volatile("s_waitcnt vmcnt(3)" ::: "memory"); else if (ny_ >= 1) asm volatile("s_waitcnt vmcnt(1)" ::: "memory"); \
    else asm volatile("s_waitcnt vmcnt(0)" ::: "memory"); \
    asm volatile("s_waitcnt lgkmcnt(0)" ::: "memory"); __builtin_amdgcn_s_barrier(); asm volatile("" ::: "memory"); } while (0)
#define M8_NY(j_) ((j_) + 2 < NT ? 3 : ((j_) + 2 == NT ? 1 : 0))
    f32x16 p0, p1; v8i pf;
#define M8_MMA(acc, a, b, sa, sb) do { if constexpr ((PRB & 2) != 0) asm volatile("" :: "v"(a), "v"(b)); else acc = mfma8(a, b, acc, sa, sb); } while (0)
#define M8_SB() __builtin_amdgcn_sched_barrier(0)
#define M8_KF(c, kb) ((PRB & 4) ? qf[c] : ld_frag(Ks + kxa[c] + (kb) * 32 * 256, Ks + kxa[c] + hdl + (kb) * 32 * 256))
#define M8_VF(d) ((PRB & 4) ? qf[(d) % 3] : ld_frag(Vs + vxa + (d) * 2048, Vs + vxa + hdl + (d) * 2048))
#define M8_X(jj, QK, PV) do { const int j_ = (jj); const char* Ks = Kb + (j_ % 3) * KB8; const char* Vs = Vb + ((j_ + 2) % 3) * VB8; \
        v8i fa, fb, fc, fd; \
        if (QK) { fa = M8_KF(0, 0); fb = M8_KF(0, 1); fc = M8_KF(1, 0); fd = M8_KF(1, 1); } \
        M8_SB(); if (!grpB && j_ + 2 <= NT) M8_STAGE(j_ + 2); M8_SB(); \
        if (QK) { \
            _Pragma("unroll") for (int r = 0; r < 16; ++r) { p0[r] = 0.f; p1[r] = 0.f; } \
            M8_MMA(p0, fa, qf[0], s1, s1); M8_MMA(p1, fb, qf[0], s1, s1); M8_SB(); \
            fa = M8_KF(2, 0); fb = M8_KF(2, 1); M8_SB(); \
            M8_MMA(p0, fc, qf[1], s1, s1); M8_MMA(p1, fd, qf[1], s1, s1); M8_SB(); \
            if (PV) { fc = M8_VF(0); fd = M8_VF(1); } M8_SB(); \
            M8_MMA(p0, fa, qf[2], s1, s1); M8_MMA(p1, fb, qf[2], s1, s1); M8_SB(); \
        } else { fc = M8_VF(0); fd = M8_VF(1); } \
        if (PV) { fa = M8_VF(2); fb = M8_VF(3); M8_SB(); \
            M8_MMA(o[0], pf, fc, sp, s1); M8_MMA(o[1], pf, fd, sp, s1); M8_SB();     \
            M8_MMA(o[2], pf, fa, sp, s1); M8_MMA(o[3], pf, fb, sp, s1); } } while (0)
    bool pend = false;
#define M8_Y(jj) do { const int j_ = (jj); if (grpB && j_ + 3 <= NT) M8_STAGE(j_ + 3); \
        if constexpr ((PRB & 8) == 0) { \
            float pmax = p0[0]; \
            _Pragma("unroll") for (int r = 1; r < 16; ++r) pmax = fmaxf(pmax, p0[r]); \
            _Pragma("unroll") for (int r = 0; r < 16; ++r) pmax = fmaxf(pmax, p1[r]); \
            { auto rr = __builtin_amdgcn_permlane32_swap(__float_as_uint(pmax), __float_as_uint(pmax), false, false); \
              pmax = fmaxf(__uint_as_float(rr[0]), __uint_as_float(rr[1])); } \
            if (__any(pmax - m_reg > 3.0f / 0.07216878364870322f)) { \
                const float mn = fmaxf(m_reg, pmax); \
                const float alpha = __builtin_amdgcn_exp2f((m_reg - mn) * C); \
                m_reg = mn; l_reg *= alpha; \
                if (hi == 0) al[r32] = alpha; \
                pend = true; \
            } \
            const float mnC = 4.0f - m_reg * C;                     \
            float ps = 0.f; \
            _Pragma("unroll") for (int r = 0; r < 16; ++r) { p0[r] = (PRB & 1) ? fmaf(p0[r], C, mnC) : __builtin_amdgcn_exp2f((PRB & 32) ? p0[r] : fmaf(p0[r], C, mnC)); if (!(PRB & 16)) ps += p0[r]; } \
            _Pragma("unroll") for (int r = 0; r < 16; ++r) { p1[r] = (PRB & 1) ? fmaf(p1[r], C, mnC) : __builtin_amdgcn_exp2f((PRB & 32) ? p1[r] : fmaf(p1[r], C, mnC)); if (!(PRB & 16)) ps += p1[r]; } \
            { auto rr = __builtin_amdgcn_permlane32_swap(__float_as_uint(ps), __float_as_uint(ps), false, false); \
              ps = __uint_as_float(rr[0]) + __uint_as_float(rr[1]); } \
            l_reg += ps * (1.0f / 16.0f); \
              \
            _Pragma("unroll") for (int a = 0; a < 4; ++a) { \
                const unsigned w0 = pk4_fp8o(p0[4 * a], p0[4 * a + 1], p0[4 * a + 2], p0[4 * a + 3]), w1 = pk4_fp8o(p1[4 * a], p1[4 * a + 1], p1[4 * a + 2], p1[4 * a + 3]); \
                auto rr = __builtin_amdgcn_permlane32_swap(w0, w1, false, false); \
                pf[2 * a] = (int)rr[0]; pf[2 * a + 1] = (int)rr[1]; \
            } \
        } } while (0)
    M8_STAGE(0); M8_STAGE(1);
    M8_BAR(0);
    if (grpB) { M8_STAGE(2); M8_BAR(NT > 2 ? 3 : 1); }
    M8_X(0, true, false); M8_BAR(M8_NY(0)); M8_Y(0); M8_BAR(M8_NY(0));
    int j = 1;
    for (;;) {
        if (pend) {
            pend = false;
#pragma unroll
            for (int r = 0; r < 16; ++r) { const float a_ = al[crow(r, hi)];
#pragma unroll
                for (int d = 0; d < 4; ++d) o[d][r] *= a_; }
        }
#pragma unroll 1
        for (; j < NT; ++j) {
            M8_X(j, true, true); M8_BAR(M8_NY(j)); M8_Y(j); M8_BAR(M8_NY(j));
            if (pend) { ++j; break; }
        }
        if (!pend) break;
    }
    M8_X(NT, false, true);
#undef M8_KF
#undef M8_VF
#undef M8_X
#undef M8_Y
#undef M8_SB
    if (!grpB) M8_BAR(0);
    if (hi == 0) al[32 + r32] = l_reg;
    asm volatile("s_waitcnt lgkmcnt(0)" ::: "memory");
#pragma unroll
    for (int r = 0; r < 16; ++r) {
        const int orow_ = crow(r, hi);
        const float li = 1.0f / al[32 + orow_];
        bf16_t* op = op0 + (size_t)(32 * wave + orow_) * LDO;
#pragma unroll
        for (int d = 0; d < 4; ++d) { if (WO_FP8) ((unsigned char*)op0)[(size_t)(32 * wave + orow_) * LDO + d * 32 + r32] = fp8_1(o[d][r] * li * 64.f); else op[d * 32 + r32] = (bf16_t)(cvt_pk(o[d][r] * li, 0.f) & 0xffffu); }
    }
    __syncthreads();
#undef M8_STAGE
#undef M8_BAR
#undef M8_NY
#undef M8_MMA
}
}
struct Params { const float* in[31]; float* out; unsigned char* ws; int ph_lo, ph_hi; };
enum { I_X = 0, I_C, I_CTX, I_CCTX, I_MODW, I_MODB, I_N1G, I_N2G, I_DQ, I_GQ, I_UQ, I_DKV, I_GKV, I_UKV, I_MWO, I_FWO, I_FBO, I_NQKV, I_RPB, I_NWO,
       I_SQKV, I_SINK, I_SWO, I_WGRP, I_BGRP, I_WRT, I_BRT, I_WGATE, I_WUP, I_WDOWN, I_FG };
struct Frame {
    const float* const __attribute__((address_space(4)))* in;
    float* out; unsigned char* ws; char* lds;
    int tid, lane, wave, G, vcu;
    DI bf16_t* wt(size_t el) const { return (bf16_t*)(ws + WS_WT) + el; }
    DI bf16_t* scr(size_t byte) const { return (bf16_t*)(ws + WS_SCR + byte); }
    DI float* moda(int layer, int v, int which) const { return (float*)(ws + WS_MODA) + ((size_t)(layer * 3 + v) * 2 + which) * 1024; }
    DI float* modv(int layer, int v, int part) const { return (float*)(ws + WS_MODV) + ((size_t)(layer * 3 + v) * 6 + part) * 1024; }
};
DI int row_batch(int row) { return row >= TB ? 1 : 0; }
DI int row_modv(int row) { const int b = row_batch(row), rr = row - b * TB; return rr < NCTX ? 0 : 1 + b; }
DI int tile_modv(int pm) { const int b = pm / 65; return (pm % 65 == 0) ? 0 : 1 + b; }
DI int swap45(int c) { return ((c & 16) << 1) | ((c & 32) >> 1) | (c & 15); }

DI int dst_row(int kind, int n) {
    if (kind == 1) return n < 256 ? n : 256 + swap45(n - 256);
    if (kind == 2) { const int h = n / 192, c = n - h * 192; return c < 128 ? n : h * 192 + 128 + swap45(c - 128); }
    if (kind == 3) return n < 1280 ? (n & ~63) + swap45(n & 63) : n;
    return n;
}
DI void cvt_tile(const Frame& F, const float* __restrict__ src, int N, bf16_t* __restrict__ dst, int ldd, int k0, int n0, int kind, const float* __restrict__ kscale, bool f8) {
    float* tl = (float*)F.lds;
    const int tid = F.tid;
    { const int kr = tid >> 3, c8 = (tid & 7) * 8;
      const float sc = kscale ? kscale[k0 + kr] : 1.0f;
      const f32x4 a = *(const f32x4*)(src + (size_t)(k0 + kr) * N + n0 + c8), b = *(const f32x4*)(src + (size_t)(k0 + kr) * N + n0 + c8 + 4);
#pragma unroll
      for (int j = 0; j < 4; ++j) { tl[kr * 65 + c8 + j] = a[j] * sc; tl[kr * 65 + c8 + 4 + j] = b[j] * sc; } }
    __syncthreads();
    { const int nr = tid >> 3, k8 = (tid & 7) * 8;
      float v[8];
#pragma unroll
      for (int j = 0; j < 8; ++j) v[j] = tl[(k8 + j) * 65 + nr];
      if (f8) { u32x2 w; w.x = pk4_fp8(v[0] * 64.f, v[1] * 64.f, v[2] * 64.f, v[3] * 64.f); w.y = pk4_fp8(v[4] * 64.f, v[5] * 64.f, v[6] * 64.f, v[7] * 64.f);
          *(u32x2*)((unsigned char*)dst + (size_t)dst_row(kind, n0 + nr) * ldd + k0 + k8) = w; }
      else { u32x4 w; w.x = cvt_pk(v[0], v[1]); w.y = cvt_pk(v[2], v[3]); w.z = cvt_pk(v[4], v[5]); w.w = cvt_pk(v[6], v[7]);
          *(u32x4*)(dst + (size_t)dst_row(kind, n0 + nr) * ldd + k0 + k8) = w; } }
    __syncthreads();
}
DI void cvt_tile4(const Frame& F, const float* __restrict__ src, int N, unsigned char* __restrict__ dst, int ldd, int k0, int n0) {
    float* tl = (float*)F.lds;
    int tid = threadIdx.x; asm volatile("" : "+v"(tid));
    { const int kr = tid >> 3, c8 = (tid & 7) * 8;
      f32x4 a[4], b[4];
#pragma unroll
      for (int q = 0; q < 4; ++q) { a[q] = __builtin_nontemporal_load((const f32x4*)(src + (size_t)(k0 + kr) * N + n0 + 64 * q + c8)); b[q] = __builtin_nontemporal_load((const f32x4*)(src + (size_t)(k0 + kr) * N + n0 + 64 * q + c8 + 4)); }
#pragma unroll
      for (int q = 0; q < 4; ++q)
#pragma unroll
          for (int j = 0; j < 4; ++j) { tl[q * 4160 + kr * 65 + c8 + j] = a[q][j]; tl[q * 4160 + kr * 65 + c8 + 4 + j] = b[q][j]; } }
    __syncthreads();
    { const int nr = tid >> 3, k8 = (tid & 7) * 8;
#pragma unroll
      for (int q = 0; q < 4; ++q) {
          float v[8];
#pragma unroll
          for (int j = 0; j < 8; ++j) v[j] = tl[q * 4160 + (k8 + j) * 65 + nr] * 64.0f;
          u32x2 w; w.x = pk4_fp8(v[0], v[1], v[2], v[3]); w.y = pk4_fp8(v[4], v[5], v[6], v[7]);
          *(u32x2*)(dst + (size_t)(n0 + 64 * q + nr) * ldd + k0 + k8) = w; } }
    __syncthreads();
}
DI void cvt_moe_range(const Frame& F, int layer, int b0, int b1, int rank, int nr) {
    unsigned char* mw = F.ws + WS_MOEW;
    const float* wg = F.in[I_WGATE] + (size_t)layer * 32 * 1024 * 512;
    const float* wu = F.in[I_WUP] + (size_t)layer * 32 * 1024 * 512;
    const float* wd = F.in[I_WDOWN] + (size_t)layer * 32 * 512 * 1024;
    for (int u = b0 + rank; u < b1; u += nr) {
        const int mat = u / 32, tl = u % 32, which = mat / 32, e = mat % 32;
        if (which < 2) { const int kt = tl / 2, nq = tl % 2;
            cvt_tile4(F, (which ? wu : wg) + (size_t)e * 1024 * 512, 512, mw + (which ? MOEW_U : MOEW_G) + (size_t)e * 512 * 1024, 1024, kt * 64, nq * 256);
        } else { const int kt = tl / 4, nq = tl % 4;
            cvt_tile4(F, wd + (size_t)e * 512 * 1024, 1024, mw + MOEW_D + (size_t)e * 1024 * 512, 512, kt * 64, nq * 256);
        }
    }
}
DI void tail_cvt(const Frame& F, int NU, int layer, int b0, int b1) {
    const int rem = NU % F.G;
    if (rem == 0) { cvt_moe_range(F, layer, b0, b1, F.vcu, F.G); return; }
    if (F.vcu < rem) return;
    cvt_moe_range(F, layer, b0, b1, F.vcu - rem, F.G - rem);
}
struct CvtJob { const float* src; const float* ks; bf16_t* dst; int K, N, ldd, kind; bool f8; };
DI CvtJob cvt_job(const Frame& F, int j) {
    CvtJob J; J.ks = nullptr; J.kind = 0; J.f8 = false;
    switch (j) {
        case 0: J.src = F.in[I_DQ]; J.K = 1024; J.N = 512; J.dst = F.wt(WT_P1); J.ldd = 1024; J.f8 = GEMM_FP8; break;
        case 1: J.src = F.in[I_DKV]; J.K = 1024; J.N = 320; J.dst = GEMM_FP8 ? (bf16_t*)((unsigned char*)F.wt(WT_P1) + (size_t)512 * 1024) : F.wt(WT_P1 + (size_t)512 * 1024); J.ldd = 1024; J.kind = 1; J.f8 = GEMM_FP8; break;
        case 2: J.src = F.in[I_UQ]; J.K = 512; J.N = 1536; J.dst = F.wt(WT_UQ); J.ldd = 512; J.kind = 2; J.ks = F.in[I_GQ]; break;
        case 3: J.src = F.in[I_UKV]; J.K = 256; J.N = 2048; J.dst = F.wt(WT_UKV); J.ldd = 256; J.ks = F.in[I_GKV]; break;
        case 4: J.src = F.in[I_MWO]; J.K = 1024; J.N = 1024; J.dst = F.wt(WT_WO0); J.ldd = 1024; J.f8 = WO_FP8; break;
        case 5: J.src = F.in[I_FWO]; J.K = 1024; J.N = 1024; J.dst = F.wt(WT_WO1); J.ldd = 1024; break;
        case 6: J.src = F.in[I_NQKV]; J.K = 1024; J.N = 3072; J.dst = F.wt(WT_NAQKV); J.ldd = 1024; J.f8 = GEMM_FP8; break;
        case 7: J.src = F.in[I_NWO]; J.K = 1024; J.N = 1024; J.dst = F.wt(WT_WO2); J.ldd = 1024; J.f8 = WO_FP8; break;
        case 8: J.src = F.in[I_SQKV]; J.K = 1024; J.N = 1536; J.dst = F.wt(WT_SWQKV); J.ldd = 1024; J.kind = 3; J.f8 = GEMM_FP8; break;
        default: J.src = F.in[I_SWO]; J.K = 1024; J.N = 1024; J.dst = F.wt(WT_WO3); J.ldd = 1024; J.f8 = WO_FP8; break;
    }
    return J;
}

DI void ph_prologue(const Frame& F) {
    for (int u = F.vcu; u < 256; u += F.G) {
        const int layer = u >> 6, kc = (u >> 2) & 15, nq = u & 3;
        const float* mw = F.in[I_MODW] + ((size_t)layer * 1024 + kc * 64) * 6144 + nq * 1536 + F.tid;
        float acc[3][3];
#pragma unroll
        for (int j = 0; j < 3; ++j) { acc[j][0] = 0.f; acc[j][1] = 0.f; acc[j][2] = 0.f; }
#pragma unroll 8
        for (int k = 0; k < 64; ++k) {
            const int kk = kc * 64 + k;
            const float a0 = silu_f(F.in[I_CCTX][kk]), a1 = silu_f(F.in[I_C][kk]), a2 = silu_f(F.in[I_C][1024 + kk]);
#pragma unroll
            for (int j = 0; j < 3; ++j) { const float w = mw[(size_t)k * 6144 + j * 512]; acc[j][0] += a0 * w; acc[j][1] += a1 * w; acc[j][2] += a2 * w; }
        }
        float* mp = (float*)(F.ws + WS_MODP) + ((size_t)(kc * 4 + layer) * 3) * 6144 + nq * 1536 + F.tid;
#pragma unroll
        for (int j = 0; j < 3; ++j) { mp[j * 512] = acc[j][0]; mp[6144 + j * 512] = acc[j][1]; mp[2 * 6144 + j * 512] = acc[j][2]; }
    }
    {
        const int ntile[10] = {128, 80, 192, 128, 256, 256, 768, 256, 384, 256};
        int total = 0;
#pragma unroll
        for (int j = 0; j < 10; ++j) total += ntile[j];
        for (int u = F.vcu; u < total; u += F.G) {
            int j = 0, rem = u;
#pragma unroll
            for (int q = 0; q < 9; ++q) { if (j == q && rem >= ntile[q]) { rem -= ntile[q]; j = q + 1; } }
            const CvtJob J = cvt_job(F, j);
            const int nn = J.N / 64, kt = rem / nn, nt = rem % nn;
            cvt_tile(F, J.src, J.N, J.dst, J.ldd, kt * 64, nt * 64, J.kind, J.ks, J.f8);
        }
    }
    {
        const int gt = F.vcu * NTHR + F.tid, gs = F.G * NTHR;
        bf16_t* A = F.wt(WT_DFTA); bf16_t* D1 = F.wt(WT_DFT1); bf16_t* D2 = F.wt(WT_DFT2); bf16_t* DC = F.wt(WT_DFTC);
        for (int i = gt; i < 512 * 256; i += gs) {
            const int r = i >> 8, c = i & 255, kc = r & 255, ph = (c * kc) & 255; const float x = (float)ph * (1.0f / 128.0f);
            const float v = (r < 256 ? cospif(x) : -sinpif(x)) * 0.0625f;
            A[i] = (bf16_t)(cvt_pk(v, 0.f) & 0xffffu);
        }
        const float s128 = 0.08838834764831845f;
        for (int i = gt; i < 256 * 256; i += gs) {
            const int r = i >> 8, c = i & 255, kb = r & 127, n1 = c & 127, ph = (kb * n1) & 127; const float x = (float)ph * (1.0f / 64.0f);
            const float cs = cospif(x) * s128, sn = sinpif(x) * s128;
            const float v1 = (r < 128) ? (c < 128 ? cs : sn) : (c < 128 ? -sn : cs);
            D1[i] = (bf16_t)(cvt_pk(v1, 0.f) & 0xffffu);
            const float v2 = (r < 128) ? (c < 128 ? cs : sn) : 0.f;
            D2[i] = (bf16_t)(cvt_pk(v2, 0.f) & 0xffffu);
        }
        for (int i = gt; i < 256 * 512; i += gs) {
            const int r = i >> 9, c = i & 511, n = c & 255, ph = (r * n) & 255; const float x = (float)ph * (1.0f / 128.0f);
            const float v = (c < 256 ? cospif(x) : sinpif(x)) * 0.0625f;
            DC[i] = (bf16_t)(cvt_pk(v, 0.f) & 0xffffu);
        }
        float* rope = (float*)(F.ws + WS_ROPE);
        for (int i = gt; i < 256 * 16; i += gs) {
            const int v = i >> 4, m = i & 15;
            const float inv = powf(10000.0f, -(float)m / 16.0f);
            const float ang = (float)v * inv;
            rope[2 * i] = cosf(ang); rope[2 * i + 1] = sinf(ang);
        }
    }
    {
        for (int i = F.vcu * NTHR + F.tid; i < 4 * 36 * 1024; i += F.G * NTHR) {
            const int layer = i / (36 * 1024), r = i % (36 * 1024), n = r >> 10, k = r & 1023;
            const float w = n < 32 ? F.in[I_WRT][((size_t)layer * 1024 + k) * 32 + n] : F.in[I_WGRP][((size_t)layer * 1024 + k) * 4 + (n - 32)];
            const unsigned hi = cvt_pk(w, 0.f) & 0xffffu; const float lo = w - bflo(hi);
            unsigned char* img = F.ws + WS_RW + (size_t)layer * 2 * RW_HALF + (size_t)n * RW_PITCH + 2 * k;
            *(bf16_t*)img = (bf16_t)hi; *(bf16_t*)(img + RW_HALF) = (bf16_t)(cvt_pk(lo, 0.f) & 0xffffu);
        }
    }
}
DI void ph_modreduce(const Frame& F) {
    for (int i = F.vcu * NTHR + F.tid; i < 4 * 3 * 6144; i += F.G * NTHR) {
        const int layer = i / (3 * 6144), r = i % (3 * 6144), v = r / 6144, n = r % 6144;
        const float* mp = (const float*)(F.ws + WS_MODP) + (size_t)layer * 3 * 6144 + r;
        float s = F.in[I_MODB][layer * 6144 + n];
#pragma unroll
        for (int kc = 0; kc < 16; ++kc) s += mp[(size_t)kc * 4 * 3 * 6144];
        ((float*)(F.ws + WS_MODV))[i] = s;
        const int part = n >> 10, col = n & 1023;
        if (part == 1) F.moda(layer, v, 0)[col] = F.in[I_N1G][layer * D + col] * (1.0f + s);
        if (part == 4) F.moda(layer, v, 1)[col] = F.in[I_N2G][layer * D + col] * (1.0f + s);
    }
}

template <int LAYER>
DI void ph_norm1(const Frame& F, bool dry = false) {
    bf16_t* xres = (bf16_t*)(F.ws + WS_XRES);
    bf16_t* xdst = dry ? (bf16_t*)(F.ws + WS_END) : xres;
    bf16_t* hb = dry ? (bf16_t*)(F.ws + WS_END + (size_t)T * D * 4) : (bf16_t*)(F.ws + WS_H);
    const int* slot = (const int*)(F.ws + WS_SLOT);
    const float* gw = (const float*)(F.ws + WS_GW);
    const bf16_t* yb = F.scr(SM_Y);
    const int c0 = 4 * F.lane;
    const int step = F.G * 8;
    u32x2 nxa[4], nya[4], nyc[4]; float ng0 = 0.f, ng1 = 0.f;
    int ps0 = 0, ps1 = 0; float pg0 = 0.f, pg1 = 0.f;
    auto valid = [&](int r) { return r < T && !(LAYER == 4 && (r - row_batch(r) * TB) < NCTX); };
    auto fetch_sg = [&](int r) { if (LAYER != 0 && valid(r)) { ps0 = slot[2 * r]; ps1 = slot[2 * r + 1]; pg0 = gw[2 * r]; pg1 = gw[2 * r + 1]; } };
    auto issue = [&](int r) { if (LAYER != 0 && valid(r)) { const bf16_t* src = xres + (size_t)r * D; ng0 = pg0; ng1 = pg1;
#pragma unroll
            for (int i = 0; i < 4; ++i) { nxa[i] = *(const u32x2*)(src + c0 + 256 * i); nya[i] = __builtin_nontemporal_load((const u32x2*)(yb + (size_t)ps0 * D + c0 + 256 * i)); nyc[i] = __builtin_nontemporal_load((const u32x2*)(yb + (size_t)ps1 * D + c0 + 256 * i)); } } };
    { const int r0 = F.vcu * 8 + F.wave; fetch_sg(r0); issue(r0); fetch_sg(r0 + step); }
    for (int row = F.vcu * 8 + F.wave; row < T; row += step) {
        const int b = row_batch(row), rr = row - b * TB, v = rr < NCTX ? 0 : 1 + b;
        u32x2 xa[4], ya[4], yc[4]; const float g0 = ng0, g1 = ng1;
        if (LAYER != 0) {
#pragma unroll
            for (int i = 0; i < 4; ++i) { xa[i] = nxa[i]; ya[i] = nya[i]; yc[i] = nyc[i]; }
            issue(row + step); fetch_sg(row + 2 * step);
        }
        if (LAYER == 4 && rr < NCTX) continue;
        f32x4 x[4];
        if (LAYER == 0) {
            const float* src = rr < NCTX ? F.in[I_CTX] + ((size_t)b * NCTX + rr) * D : F.in[I_X] + ((size_t)b * SEQ + (rr - NCTX)) * D;
#pragma unroll
            for (int i = 0; i < 4; ++i) x[i] = *(const f32x4*)(src + c0 + 256 * i);
        } else {
            const float* g2 = F.modv(LAYER - 1, v, 5);
#pragma unroll
            for (int i = 0; i < 4; ++i) {
                const f32x4 gg = *(const f32x4*)(g2 + c0 + 256 * i);
                x[i][0] = bflo(xa[i].x) + gg[0] * (g0 * bflo(ya[i].x) + g1 * bflo(yc[i].x)); x[i][1] = bfhi(xa[i].x) + gg[1] * (g0 * bfhi(ya[i].x) + g1 * bfhi(yc[i].x));
                x[i][2] = bflo(xa[i].y) + gg[2] * (g0 * bflo(ya[i].y) + g1 * bflo(yc[i].y)); x[i][3] = bfhi(xa[i].y) + gg[3] * (g0 * bfhi(ya[i].y) + g1 * bfhi(yc[i].y));
            }
        }
        float ss = 0.f;
#pragma unroll
        for (int i = 0; i < 4; ++i) ss += x[i][0] * x[i][0] + x[i][1] * x[i][1] + x[i][2] * x[i][2] + x[i][3] * x[i][3];
        ss = wave_sum(ss);
        const float rstd = rsqrtf(ss * (1.0f / D) + EPS);
        if (LAYER == 4) {
            float* op = (dry ? (float*)(F.ws + WS_END) : F.out) + ((size_t)b * SEQ + (rr - NCTX)) * D;
#pragma unroll
            for (int i = 0; i < 4; ++i) { const f32x4 g = *(const f32x4*)(F.in[I_FG] + c0 + 256 * i); f32x4 y;
#pragma unroll
                for (int j = 0; j < 4; ++j) y[j] = x[i][j] * rstd * g[j];
#ifdef MLA_CHECK
                { const float* chk = (const float*)(F.ws + WS_CTL + 32768); if (!(chk[1] > 0.f && chk[0] > 0.f && chk[0] <= MLA_CHECK_TOL * chk[1])) { y[0] = y[1] = y[2] = y[3] = __builtin_nanf(""); } }
#endif
                *(f32x4*)(op + c0 + 256 * i) = y; }
        } else {
            constexpr int LY = LAYER < 4 ? LAYER : 0;
            const float* na = F.moda(LY, v, 0); const float* sh = F.modv(LY, v, 0);
            bf16_t* xo = xdst + (size_t)row * D; bf16_t* ho = hb + (size_t)row * D;
#pragma unroll
            for (int i = 0; i < 4; ++i) {
                const f32x4 g = *(const f32x4*)(na + c0 + 256 * i), s0v = *(const f32x4*)(sh + c0 + 256 * i);
                f32x4 y;
#pragma unroll
                for (int j = 0; j < 4; ++j) y[j] = x[i][j] * rstd * g[j] + s0v[j];
                st_bf4(xo + c0 + 256 * i, x[i]);
                if (GEMM_FP8 && LAYER != 1) st_fp8x4((unsigned char*)hb + (size_t)row * D + c0 + 256 * i, y); else st_bf4(ho + c0 + 256 * i, y);
            }
        }
    }
}

template <int LAYER>
DI void ph_norm2_router(const Frame& F, bool dry = false) {
    if (!dry) { if (LAYER == 0) cvt_moe_range(F, 0, 2960, 3072, F.vcu, F.G); if (LAYER == 3) cvt_moe_range(F, 3, 1952, 3072, F.vcu, F.G); }
    char* Wl = F.lds;
    int* hist = (int*)(F.lds + LDS_MISC + 64);
    int* basee = hist + 32;
    { const u32x4* src = (const u32x4*)(F.ws + WS_RW + (size_t)LAYER * 2 * RW_HALF); u32x4* dst = (u32x4*)Wl;
      constexpr int NCH = 2 * RW_HALF / 16, NIT = (NCH + NTHR - 1) / NTHR;
      u32x4 tmp[NIT];
#pragma unroll
      for (int k = 0; k < NIT; ++k) { const int i = F.tid + k * NTHR; if (i < NCH) tmp[k] = src[i]; }
#pragma unroll
      for (int k = 0; k < NIT; ++k) { const int i = F.tid + k * NTHR; if (i < NCH) dst[i] = tmp[k]; } }
    if (F.tid < 32) hist[F.tid] = 0;
    __syncthreads();
    const bf16_t* xres = (const bf16_t*)(F.ws + WS_XRES);
    bf16_t* hb = (bf16_t*)(F.ws + WS_H);
    const size_t dofs = dry ? (WS_END - WS_EID) : 0;
    int* eid = (int*)(F.ws + WS_EID + dofs); float* gw = (float*)(F.ws + WS_GW + dofs); int* pos = (int*)(F.ws + WS_POS + dofs);
    const float* bg = F.in[I_BGRP] + LAYER * 4; const float* br = F.in[I_BRT] + LAYER * 32;
    const int fr = F.lane & 15, fq = F.lane >> 4;
    const char* w0 = Wl + fr * RW_PITCH + 16 * fq;
    const char* w1 = w0 + 16 * RW_PITCH;
    const char* w2 = Wl + (32 + (fr & 3)) * RW_PITCH + 16 * fq;
    for (int g16 = F.vcu * 8 + F.wave; g16 < T / 16; g16 += F.G * 8) {
        const int row = 16 * g16 + fr, v = row_modv(16 * g16);
        if (LAYER == 3 && v == 0) continue;
        const bf16_t* xp = xres + (size_t)row * D + 8 * fq;
        float ss;
        { const f32x4 q4 = *(const f32x4*)((const float*)(F.ws + WS_SQX) + (size_t)row * 4); ss = q4[0] + q4[1] + q4[2] + q4[3]; }
        const float rstd = rsqrtf(ss * (1.0f / D) + EPS);
        const float* na = F.moda(LAYER, v, 1) + 8 * fq; const float* sh = F.modv(LAYER, v, 3) + 8 * fq;
        unsigned char* h8 = (unsigned char*)hb + (size_t)row * D + 8 * fq;
        f32x4 acc0 = {0.f, 0.f, 0.f, 0.f}, acc1 = acc0, acc2 = acc0;
#pragma unroll 4
        for (int s = 0; s < 32; ++s) {
            float h[8];
            { const u32x4 xw = *(const u32x4*)(xp + 32 * s);
              const f32x4 a = {bflo(xw.x), bfhi(xw.x), bflo(xw.y), bfhi(xw.y)}, b = {bflo(xw.z), bfhi(xw.z), bflo(xw.w), bfhi(xw.w)};
              const f32x4 ga = *(const f32x4*)(na + 32 * s), gb = *(const f32x4*)(na + 32 * s + 4);
              const f32x4 ha = *(const f32x4*)(sh + 32 * s), hbv = *(const f32x4*)(sh + 32 * s + 4);
#pragma unroll
              for (int j = 0; j < 4; ++j) { h[j] = a[j] * rstd * ga[j] + ha[j]; h[4 + j] = b[j] * rstd * gb[j] + hbv[j]; } }
            u32x4 hi, lo;
            hi.x = cvt_pk(h[0], h[1]); hi.y = cvt_pk(h[2], h[3]); hi.z = cvt_pk(h[4], h[5]); hi.w = cvt_pk(h[6], h[7]);
            { u32x2 w8; w8.x = pk4_fp8(h[0], h[1], h[2], h[3]); w8.y = pk4_fp8(h[4], h[5], h[6], h[7]); *(u32x2*)(h8 + 32 * s) = w8; }
            lo.x = cvt_pk(h[0] - bflo(hi.x), h[1] - bfhi(hi.x)); lo.y = cvt_pk(h[2] - bflo(hi.y), h[3] - bfhi(hi.y));
            lo.z = cvt_pk(h[4] - bflo(hi.z), h[5] - bfhi(hi.z)); lo.w = cvt_pk(h[6] - bflo(hi.w), h[7] - bfhi(hi.w));
            const bf16x8 ah = __builtin_bit_cast(bf16x8, hi), alo = __builtin_bit_cast(bf16x8, lo);
            const bf16x8 w0h = *(const bf16x8*)(w0 + 64 * s), w0l = *(const bf16x8*)(w0 + RW_HALF + 64 * s);
            const bf16x8 w1h = *(const bf16x8*)(w1 + 64 * s), w1l = *(const bf16x8*)(w1 + RW_HALF + 64 * s);
            const bf16x8 w2h = *(const bf16x8*)(w2 + 64 * s), w2l = *(const bf16x8*)(w2 + RW_HALF + 64 * s);
            acc0 = __builtin_amdgcn_mfma_f32_16x16x32_bf16(w0h, ah, acc0, 0, 0, 0); acc0 = __builtin_amdgcn_mfma_f32_16x16x32_bf16(w0h, alo, acc0, 0, 0, 0); acc0 = __builtin_amdgcn_mfma_f32_16x16x32_bf16(w0l, ah, acc0, 0, 0, 0);
            acc1 = __builtin_amdgcn_mfma_f32_16x16x32_bf16(w1h, ah, acc1, 0, 0, 0); acc1 = __builtin_amdgcn_mfma_f32_16x16x32_bf16(w1h, alo, acc1, 0, 0, 0); acc1 = __builtin_amdgcn_mfma_f32_16x16x32_bf16(w1l, ah, acc1, 0, 0, 0);
            acc2 = __builtin_amdgcn_mfma_f32_16x16x32_bf16(w2h, ah, acc2, 0, 0, 0); acc2 = __builtin_amdgcn_mfma_f32_16x16x32_bf16(w2h, alo, acc2, 0, 0, 0); acc2 = __builtin_amdgcn_mfma_f32_16x16x32_bf16(w2l, ah, acc2, 0, 0, 0);
        }
        const float l0 = acc2[0] + bg[0], l1 = acc2[1] + bg[1], l2 = acc2[2] + bg[2], l3 = acc2[3] + bg[3];
        int g = 0; float gm = l0;
        if (l1 > gm) { gm = l1; g = 1; }
        if (l2 > gm) { gm = l2; g = 2; }
        if (l3 > gm) { gm = l3; g = 3; }
        const float wgp = 1.0f / (__expf(l0 - gm) + __expf(l1 - gm) + __expf(l2 - gm) + __expf(l3 - gm));
        const f32x4 cnd = (g >> 1) ? acc1 : acc0;
        const int srcl = fr + 32 * (g & 1);
        float le[8];
#pragma unroll
        for (int j = 0; j < 8; ++j) le[j] = __shfl(cnd[j & 3], srcl + 16 * (j >> 2));
        { const f32x4 ba = *(const f32x4*)(br + 8 * g), bb = *(const f32x4*)(br + 8 * g + 4);
#pragma unroll
          for (int j = 0; j < 4; ++j) { le[j] += ba[j]; le[4 + j] += bb[j]; } }
        int e1 = 0; float m1 = le[0];
#pragma unroll
        for (int j = 1; j < 8; ++j) if (le[j] > m1) { m1 = le[j]; e1 = j; }
        int e2 = -1; float m2 = -3.0e38f;
#pragma unroll
        for (int j = 0; j < 8; ++j) if (j != e1 && le[j] > m2) { m2 = le[j]; e2 = j; }
        const float w1g = 1.0f / (1.0f + __expf(m2 - m1)), w2g = 1.0f - w1g;
        if (fq == 0) {
            const int ea = g * 8 + e1, eb = g * 8 + e2;
            eid[2 * row] = ea; eid[2 * row + 1] = eb;
            gw[2 * row] = wgp * w1g; gw[2 * row + 1] = wgp * w2g;
            pos[2 * row] = atomicAdd(&hist[ea], 1); pos[2 * row + 1] = atomicAdd(&hist[eb], 1);
        }
    }
    __syncthreads();
    unsigned* counts = (unsigned*)(F.ws + WS_CTL + CTL_COUNTS) + (LAYER + (dry ? 4 : 0)) * 32;
    int t2 = threadIdx.x; asm volatile("" : "+v"(t2));
    if (t2 < 32) basee[t2] = (int)atomicAdd(&counts[t2], (unsigned)hist[t2]);
    __syncthreads();
    if ((t2 & 63) < 16)
        for (int g16 = F.vcu * 8 + F.wave; g16 < T / 16; g16 += F.G * 8) {
            const int row = 16 * g16 + (t2 & 15);
            if (LAYER == 3 && row_modv(16 * g16) == 0) continue;
            pos[2 * row] += basee[eid[2 * row]]; pos[2 * row + 1] += basee[eid[2 * row + 1]];
        }
    __syncthreads();
}
DI void moe_pstart(const Frame& F, int layer, int* pst) {
    const unsigned* counts = (const unsigned*)(F.ws + WS_CTL + CTL_COUNTS) + layer * 32;
    if (F.tid == 0) { int a = 0; for (int e = 0; e < 32; ++e) { pst[e] = a; a += ((int)counts[e] + 255) / 256 * 256; } pst[32] = a; }
    __syncthreads();
}
template <int LAYER>
DI void ph_scatter(const Frame& F) {
    int* pst = (int*)(F.lds + LDS_MISC + 512);
    moe_pstart(F, LAYER, pst);
    const int* eid = (const int*)(F.ws + WS_EID); const int* pos = (const int*)(F.ws + WS_POS);
    int* slot = (int*)(F.ws + WS_SLOT); int* btok = (int*)(F.ws + WS_BTOK);
    for (int i = F.vcu * NTHR + F.tid; i < 2 * T; i += F.G * NTHR) {
        if (LAYER == 3 && row_modv(i >> 1) == 0) continue;
        const int s = pst[eid[i]] + pos[i];
        slot[i] = s; btok[s] = i >> 1;
    }
    const unsigned* counts = (const unsigned*)(F.ws + WS_CTL + CTL_COUNTS) + LAYER * 32;
    for (int e = F.vcu; e < 32; e += F.G) {
        const int c = (int)counts[e], pc = pst[e + 1] - pst[e];
        for (int p = c + F.tid; p < pc; p += NTHR) btok[pst[e] + p] = 0;
    }
    __syncthreads();
}
DI void tile_rowsumsq(const g8::Acc& acc, const LaneC& L, char* lds, float* out, int stride) {
    float* tb = (float*)lds;
#pragma unroll
    for (int ai = 0; ai < 2; ++ai)
#pragma unroll
        for (int m = 0; m < 4; ++m) {
            float s = 0.f;
#pragma unroll
            for (int bj = 0; bj < 2; ++bj)
#pragma unroll
                for (int n = 0; n < 2; ++n) { const f32x4 v = acc[ai][bj][m][n]; s += v[0] * v[0] + v[1] * v[1] + v[2] * v[2] + v[3] * v[3]; }
            s += __shfl_xor(s, 16); s += __shfl_xor(s, 32);
            if (L.fq == 0) tb[EPI_R(ai, m) * 4 + L.wc] = s;
        }
    __syncthreads();
    int t_ = threadIdx.x; asm volatile("" : "+v"(t_));
    if (t_ < 256) { const f32x4 v = *(const f32x4*)(tb + t_ * 4); out[(size_t)t_ * stride] = v[0] + v[1] + v[2] + v[3]; }
    __syncthreads();
}
DI void rope_cs(const float* rope, int row, int g, int fq, f32x4& c, f32x4& s) {
    const int b = row_batch(row), rr = row - b * TB;
    if (rr < NCTX) { c = (f32x4){1.f, 1.f, 1.f, 1.f}; s = (f32x4){0.f, 0.f, 0.f, 0.f}; return; }
    const int p = rr - NCTX, v = g == 0 ? (p >> 6) : (p & 63);
    const f32x4 a = *(const f32x4*)(rope + (v * 16 + 4 * fq) * 2), bq = *(const f32x4*)(rope + (v * 16 + 4 * fq) * 2 + 4);
    c = (f32x4){a[0], a[2], bq[0], bq[2]}; s = (f32x4){a[1], a[3], bq[1], bq[3]};
}

template <bool KROPE>
DI void ph_mla_proj1(const Frame& F) {
    const bf16_t* hb = (const bf16_t*)(F.ws + WS_H); const bf16_t* W = F.wt(WT_P1);
    bf16_t* cq = F.scr(SC_CQ); bf16_t* ckv = F.scr(SC_CKV); bf16_t* Kb = F.scr(SC_K);
    float* sqq = (float*)(F.ws + WS_SQQ); float* sqkv = (float*)(F.ws + WS_SQKV);
    const float* rope = (const float*)(F.ws + WS_ROPE);
    for (int u = F.vcu; u < 130 * (KROPE ? 1 : 3); u += F.G) {
        const int pm = KROPE ? u : u / 3, pn = KROPE ? 3 : u % 3, R0 = pm * 256;
        g8::Acc acc;
#if GEMM_FP8
        g8::gemm_unit<false, false, true, 124>(g8::opnd(as_h((const unsigned char*)hb + (size_t)R0 * 1024), 512), g8::opnd(as_h((const unsigned char*)W + (size_t)pn * 256 * 1024), 512), 512, F.lds, acc);
#else
        g8::gemm_unit<false>(g8::opnd(hb + (size_t)R0 * 1024, 1024), g8::opnd(W + (size_t)pn * 256 * 1024, 1024), 1024, F.lds, acc);
#endif
        const LaneC L = lane_coords();
        if (pn < 3) {
            bf16_t* dst = pn < 2 ? cq + (size_t)R0 * 512 + pn * 256 : ckv + (size_t)R0 * 256;
            const int ldd = pn < 2 ? 512 : 256;
#pragma unroll
            for (int ai = 0; ai < 2; ++ai)
#pragma unroll
                for (int m = 0; m < 4; ++m)
#pragma unroll
                    for (int bj = 0; bj < 2; ++bj)
#pragma unroll
                        for (int n = 0; n < 2; ++n) { st_bf4(dst + (size_t)EPI_R(ai, m) * ldd + EPI_S(bj, n), acc[ai][bj][m][n]); if (n == 1 && bj == 1) __builtin_amdgcn_sched_barrier(0); }
            if (pn < 2) tile_rowsumsq(acc, L, F.lds, sqq + (size_t)R0 * 2 + pn, 2);
            else tile_rowsumsq(acc, L, F.lds, sqkv + R0, 1);
        } else if (L.wc < 2) {
#pragma unroll
            for (int ai = 0; ai < 2; ++ai)
#pragma unroll
                for (int m = 0; m < 4; ++m) {
                    const int row = R0 + EPI_R(ai, m);
                    f32x4 c, s; rope_cs(rope, row, L.wc & 1, L.fq, c, s);
                    const f32x4 x1 = acc[ai][0][m][0], x2 = acc[ai][0][m][1];
                    const f32x4 o1 = x1 * c - x2 * s, o2 = x1 * s + x2 * c;
#if MLA_KEEP_BF16
                    bf16_t* kp = Kb + (size_t)row * 1536 + 128 + 16 * (L.wc & 1) + 4 * L.fq;
#pragma unroll
                    for (int hh = 0; hh < 8; ++hh) { st_bf4(kp + hh * 192, o1); st_bf4(kp + hh * 192 + 32, o2); }
#endif
#if MLA_FP8
                    { unsigned char* k8 = (unsigned char*)F.scr(SC_K8) + (size_t)row * 1536 + 128 + 16 * (L.wc & 1) + 4 * L.fq;
                      const unsigned w1 = pk4_fp8(o1[0], o1[1], o1[2], o1[3]), w2 = pk4_fp8(o2[0], o2[1], o2[2], o2[3]);
#pragma unroll
                      for (int hh = 0; hh < 8; ++hh) { *(unsigned*)(k8 + hh * 192) = w1; *(unsigned*)(k8 + hh * 192 + 32) = w2; } }
#endif
                }
        }
    }
    if (!KROPE) tail_cvt(F, 390, 0, 0, 976);
}
DI void ph_mla_proj2(const Frame& F) {
    ph_mla_proj1<true>(F);
    const bf16_t* cq = F.scr(SC_CQ); const bf16_t* ckv = F.scr(SC_CKV);
    bf16_t* Qb = F.scr(SC_Q); bf16_t* Kb = F.scr(SC_K); bf16_t* Vb = F.scr(SC_V);
    unsigned char* Q8 = (unsigned char*)F.scr(SC_Q8); unsigned char* K8 = (unsigned char*)F.scr(SC_K8); unsigned char* V8T = (unsigned char*)F.scr(SC_V8T);
    const float* sqq = (const float*)(F.ws + WS_SQQ); const float* sqkv = (const float*)(F.ws + WS_SQKV);
    const float* rope = (const float*)(F.ws + WS_ROPE);
    for (int u0 = F.vcu; u0 < 130 * 14 + 130; u0 += F.G) {
        const int u = u0 - 130;
        if (u < 0) continue;
        const int pm = u / 14, pq = u % 14, R0 = pm * 256;
        g8::Acc acc;
        if (pq < 6) {
            const int pn = pq;
            g8::gemm_unit<false>(g8::opnd(cq + (size_t)R0 * 512, 512), g8::opnd(F.wt(WT_UQ) + (size_t)pn * 256 * 512, 512), 512, F.lds, acc); const LaneC L = lane_coords();
#pragma unroll
            for (int ai = 0; ai < 2; ++ai)
#pragma unroll
                for (int m = 0; m < 4; ++m) {
                    const int row = R0 + EPI_R(ai, m);
                    const float rs = rsqrtf((sqq[2 * row] + sqq[2 * row + 1]) * (1.0f / 512.0f) + EPS);
                    bf16_t* qp = Qb + (size_t)row * 1536 + pn * 256; unsigned char* q8 = Q8 + (size_t)row * 1536 + pn * 256;
#pragma unroll
                    for (int bj = 0; bj < 2; ++bj) {
                        const int seg = 4 * pn + 2 * bj + (L.wc >> 1);
                        if (seg % 3 == 2) {
                            f32x4 c, s; rope_cs(rope, row, L.wc & 1, L.fq, c, s);
                            const f32x4 x1 = acc[ai][bj][m][0] * rs, x2 = acc[ai][bj][m][1] * rs;
                            const int co = bj * 128 + (L.wc >> 1) * 64 + 16 * (L.wc & 1) + 4 * L.fq;
                            const f32x4 y1 = x1 * c - x2 * s, y2 = x1 * s + x2 * c;
#if MLA_KEEP_BF16
                            st_bf4(qp + co, y1); st_bf4(qp + co + 32, y2);
#endif
#if MLA_FP8
                            st_fp8x4(q8 + co, y1); st_fp8x4(q8 + co + 32, y2);
#endif
                        } else {
#pragma unroll
                            for (int n = 0; n < 2; ++n) {
#if MLA_KEEP_BF16
                                st_bf4(qp + EPI_S(bj, n), acc[ai][bj][m][n] * rs);
#endif
#if MLA_FP8
                                st_fp8x4(q8 + EPI_S(bj, n), acc[ai][bj][m][n] * rs);
#endif
                            }
                        }
                    }
                }
        } else if (pq < 10) {
            const int hp = pq - 6;
            const bf16_t* w0 = F.wt(WT_UKV) + (size_t)(2 * hp) * 256 * 256;
            g8::gemm_unit<false>(g8::opnd(ckv + (size_t)R0 * 256, 256), g8::opnd(w0, w0 + 256 * 256, 256), 256, F.lds, acc); const LaneC L = lane_coords();
#pragma unroll
            for (int ai = 0; ai < 2; ++ai)
#pragma unroll
                for (int m = 0; m < 4; ++m) {
                    const int row = R0 + EPI_R(ai, m);
                    const float rs = rsqrtf(sqkv[row] * (1.0f / 256.0f) + EPS);
#pragma unroll
                    for (int bj = 0; bj < 2; ++bj)
#pragma unroll
                        for (int n = 0; n < 2; ++n) {
                            const int co = (2 * hp + bj) * 192 + EPI_S(0, n);
#if MLA_KEEP_BF16
                            st_bf4(Kb + (size_t)row * 1536 + co, acc[ai][bj][m][n] * rs);
#endif
#if MLA_FP8
                            st_fp8x4(K8 + (size_t)row * 1536 + co, acc[ai][bj][m][n] * rs);
#endif
                        }
                }
        } else {
            const int hp = pq - 10;
            const bf16_t* w0 = F.wt(WT_UKV) + ((size_t)(2 * hp) * 256 + 128) * 256;
            g8::gemm_unit<false>(g8::opnd(w0, w0 + 256 * 256, 256), g8::opnd(ckv + (size_t)R0 * 256, 256), 256, F.lds, acc); const LaneC L = lane_coords();
#pragma unroll
            for (int bj = 0; bj < 2; ++bj)
#pragma unroll
                for (int n = 0; n < 2; ++n) {
                    const int s = EPI_S(bj, n), tok = R0 + s;
                    const f32x4 q4 = *(const f32x4*)(sqkv + tok);
                    f32x4 rs;
#pragma unroll
                    for (int j = 0; j < 4; ++j) rs[j] = rsqrtf(q4[j] * (1.0f / 256.0f) + EPS);
#pragma unroll
                    for (int ai = 0; ai < 2; ++ai)
#pragma unroll
                        for (int m = 0; m < 4; ++m) {
                            const int hd = 2 * hp + ai, dv = L.wr * 64 + m * 16 + L.fr;
                            const f32x4 v = acc[ai][bj][m][n] * rs;
#if MLA_FP8
                            st_fp8x4(V8T + (size_t)(hd * 128 + dv) * T + tok, v);
#endif
#if MLA_KEEP_BF16
#pragma unroll
                            for (int j = 0; j < 4; ++j) Vb[(size_t)(tok + j) * 1024 + hd * 128 + dv] = (bf16_t)(cvt_pk(v[j], 0.f) & 0xffffu);
#endif
                        }
                }
        }
    }
}
template <bool F8>
DI void ph_wo(const Frame& F, const bf16_t* A, const bf16_t* W, const float* bias, int layer, bool dry = false) {
    bf16_t* xres = (bf16_t*)(F.ws + WS_XRES);
    bf16_t* xdst = dry ? (bf16_t*)(F.ws + WS_END) : xres;
    const int ntm = layer == 3 ? 128 : 130;
    for (int u = F.vcu; u < ntm * 4; u += F.G) {
        int pm = u >> 2; const int pn = u & 3;
        if (layer == 3) pm = pm + 1 + (pm >= 64 ? 1 : 0);
        const int R0 = pm * 256;
        g8::Acc acc;
        if (F8) g8::gemm_unit<false, false, true, 121>(g8::opnd(as_h((const unsigned char*)A + (size_t)R0 * 1024), 512), g8::opnd(as_h((const unsigned char*)W + (size_t)pn * 256 * 1024), 512), 512, F.lds, acc);
        else g8::gemm_unit<false>(g8::opnd(A + (size_t)R0 * 1024, 1024), g8::opnd(W + (size_t)pn * 256 * 1024, 1024), 1024, F.lds, acc);
        const LaneC L = lane_coords();
        const float* g1 = F.modv(layer, tile_modv(pm), 2) + pn * 256;
        float ssq[2][4];
#pragma unroll
        for (int ai = 0; ai < 2; ++ai)
#pragma unroll
            for (int m = 0; m < 4; ++m) ssq[ai][m] = 0.f;
#pragma unroll
        for (int bj = 0; bj < 2; ++bj)
#pragma unroll
            for (int n = 0; n < 2; ++n) {
                const int s = EPI_S(bj, n);
                const f32x4 g = *(const f32x4*)(g1 + s);
                f32x4 bv = (f32x4){0.f, 0.f, 0.f, 0.f};
                if (bias) bv = *(const f32x4*)(bias + pn * 256 + s);
#pragma unroll
                for (int ai = 0; ai < 2; ++ai)
#pragma unroll
                    for (int m = 0; m < 4; ++m) {
                        bf16_t* xp = xres + (size_t)(R0 + EPI_R(ai, m)) * D + pn * 256 + s;
                        const u32x2 xw = *(const u32x2*)xp;
                        f32x4 x = {bflo(xw.x), bfhi(xw.x), bflo(xw.y), bfhi(xw.y)};
                        x += g * (acc[ai][bj][m][n] + bv);
                        st_bf4(xdst + (xp - xres), x);
                        ssq[ai][m] += x[0] * x[0] + x[1] * x[1] + x[2] * x[2] + x[3] * x[3];
                    }
                __builtin_amdgcn_sched_barrier(0);
            }
        {
            float* tb = (float*)F.lds;
#pragma unroll
            for (int ai = 0; ai < 2; ++ai)
#pragma unroll
                for (int m = 0; m < 4; ++m) {
                    float s = ssq[ai][m];
                    s += __shfl_xor(s, 16); s += __shfl_xor(s, 32);
                    if (L.fq == 0) tb[EPI_R(ai, m) * 4 + L.wc] = s;
                }
            __syncthreads();
            int t_ = threadIdx.x; asm volatile("" : "+v"(t_));
            if (t_ < 256) { const f32x4 v = *(const f32x4*)(tb + t_ * 4);
                ((float*)(F.ws + WS_SQX))[(size_t)(R0 + t_) * 4 + pn] = v[0] + v[1] + v[2] + v[3]; }
            __syncthreads();
        }
    }
    if (!dry) {
        if (layer == 0) tail_cvt(F, 520, 0, 976, 2960);
        if (layer == 1) tail_cvt(F, 520, 1, 1464, 3072);
        if (layer == 2) tail_cvt(F, 520, 2, 1500, 3072);
    }
}
DI void ph_na_qkv(const Frame& F) {
    const bf16_t* hb = (const bf16_t*)(F.ws + WS_H);
    for (int u = F.vcu; u < 130 * 12; u += F.G) {
        const int pm = u / 12, pn = u % 12, R0 = pm * 256;
        g8::Acc acc;
#if GEMM_FP8
        g8::gemm_unit<false, false, true, 124>(g8::opnd(as_h((const unsigned char*)hb + (size_t)R0 * 1024), 512), g8::opnd(as_h((const unsigned char*)F.wt(WT_NAQKV) + (size_t)pn * 256 * 1024), 512), 512, F.lds, acc);
#else
        g8::gemm_unit<false>(g8::opnd(hb + (size_t)R0 * 1024, 1024), g8::opnd(F.wt(WT_NAQKV) + (size_t)pn * 256 * 1024, 1024), 1024, F.lds, acc);
#endif
        const LaneC L = lane_coords();
        bf16_t* dst = F.scr(pn < 4 ? SN_Q : (pn < 8 ? SN_K : SN_V)) + (size_t)R0 * 1024 + (pn & 3) * 256;
#pragma unroll
        for (int ai = 0; ai < 2; ++ai)
#pragma unroll
            for (int m = 0; m < 4; ++m)
#pragma unroll
                for (int bj = 0; bj < 2; ++bj)
#pragma unroll
                    for (int n = 0; n < 2; ++n) st_bf4(dst + (size_t)EPI_R(ai, m) * 1024 + EPI_S(bj, n), acc[ai][bj][m][n]);
    }
    tail_cvt(F, 130 * 12, 2, 0, 1500);
}
DI void ph_swa_qkv(const Frame& F) {
    const bf16_t* hb = (const bf16_t*)(F.ws + WS_H);
    const float* rope = (const float*)(F.ws + WS_ROPE);
    for (int u = F.vcu; u < 130 * 6; u += F.G) {
        const int pm = u / 6, pn = u % 6, R0 = pm * 256;
        g8::Acc acc;
#if GEMM_FP8
        g8::gemm_unit<false, false, true, 124>(g8::opnd(as_h((const unsigned char*)hb + (size_t)R0 * 1024), 512), g8::opnd(as_h((const unsigned char*)F.wt(WT_SWQKV) + (size_t)pn * 256 * 1024), 512), 512, F.lds, acc);
#else
        g8::gemm_unit<false>(g8::opnd(hb + (size_t)R0 * 1024, 1024), g8::opnd(F.wt(WT_SWQKV) + (size_t)pn * 256 * 1024, 1024), 1024, F.lds, acc);
#endif
        const LaneC L = lane_coords();
        if (pn < 5) {
            bf16_t* dst = pn < 4 ? F.scr(SS_Q) + (size_t)R0 * 1024 + pn * 256 : F.scr(SS_K) + (size_t)R0 * 256;
            const int ldd = pn < 4 ? 1024 : 256;
#pragma unroll
            for (int ai = 0; ai < 2; ++ai)
#pragma unroll
                for (int m = 0; m < 4; ++m) {
                    const int rl = EPI_R(ai, m);
                    f32x4 c, s; rope_cs(rope, R0 + rl, L.wc & 1, L.fq, c, s);
#pragma unroll
                    for (int bj = 0; bj < 2; ++bj) {
                        const f32x4 x1 = acc[ai][bj][m][0], x2 = acc[ai][bj][m][1];
                        bf16_t* p = dst + (size_t)rl * ldd + bj * 128 + (L.wc >> 1) * 64 + 16 * (L.wc & 1) + 4 * L.fq;
                        st_bf4(p, x1 * c - x2 * s); st_bf4(p + 32, x1 * s + x2 * c);
                    }
                }
        } else {
            bf16_t* dst = F.scr(SS_V) + (size_t)R0 * 256;
#pragma unroll
            for (int ai = 0; ai < 2; ++ai)
#pragma unroll
                for (int m = 0; m < 4; ++m)
#pragma unroll
                    for (int bj = 0; bj < 2; ++bj)
#pragma unroll
                        for (int n = 0; n < 2; ++n) st_bf4(dst + (size_t)EPI_R(ai, m) * 256 + EPI_S(bj, n), acc[ai][bj][m][n]);
        }
    }
    tail_cvt(F, 130 * 6, 3, 0, 1952);
}
DI int moe_expert_of(const int* pst, int slot0) { int e = 0;
#pragma unroll 1
    for (int q = 1; q < 32; ++q) if (pst[q] <= slot0) e = q; return e; }
constexpr int MOE_WS = 124;
template <bool HALFX>
DI void epi_flush_fp8_128(char* lds, unsigned char* __restrict__ dst, const int ldd) {
    constexpr int P = 144, NR = HALFX ? 128 : 256;
    __syncthreads();
    { int tid = threadIdx.x; asm volatile("" : "+v"(tid));
      const int wave = tid >> 6, lane = tid & 63, sub = lane >> 3, c16 = lane & 7;
#pragma unroll
      for (int i = 0; i < NR / 64; ++i) { const int row = wave * (NR / 8) + 8 * i + sub;
          const u32x4 v = *reinterpret_cast<const u32x4*>(lds + row * P + c16 * 16);
          *reinterpret_cast<u32x4*>(dst + (size_t)row * ldd + c16 * 16) = v; } }
    __syncthreads();
}
template <int LAYER>
DI void ph_moe1(const Frame& F) {
    int* pst = (int*)(F.lds + LDS_MISC + 512);
    moe_pstart(F, LAYER, pst);
    const int MT = pst[32] >> 8, NU = MT * 4, NFULL = (NU / F.G) * F.G, NH = 2 * (NU - NFULL);
    const unsigned char* h8 = F.ws + WS_H; const unsigned char* mw = F.ws + WS_MOEW;
    const int* btok = (const int*)(F.ws + WS_BTOK);
    unsigned char* act = (unsigned char*)F.scr(SM_ACT);
    for (int u = F.vcu; u < NFULL; u += F.G) {
        const int mt = u >> 2, pn = u & 3, e = moe_expert_of(pst, mt * 256);
        g8::Acc acc;
        g8::gemm_unit<true, false, true, MOE_WS>(g8::Opnd{as_h(h8), as_h(h8), 512, btok + mt * 256},
                      g8::opnd(as_h(mw + MOEW_G + (size_t)(e * 512 + pn * 128) * 1024), as_h(mw + MOEW_U + (size_t)(e * 512 + pn * 128) * 1024), 512), 512, F.lds, acc); const LaneC L = lane_coords();
#pragma unroll
        for (int ai = 0; ai < 2; ++ai)
#pragma unroll
            for (int m = 0; m < 4; ++m)
#pragma unroll
                for (int n = 0; n < 2; ++n) {
                    const f32x4 g = acc[ai][0][m][n], up = acc[ai][1][m][n];
                    f32x4 r;
#pragma unroll
                    for (int j = 0; j < 4; ++j) r[j] = silu_f(g[j]) * up[j];
                    *reinterpret_cast<unsigned*>(F.lds + EPI_R(ai, m) * 144 + EPI_S(0, n)) = pk4_fp8(r[0], r[1], r[2], r[3]);
                }
        epi_flush_fp8_128<false>(F.lds, act + (size_t)(mt * 256) * 512 + pn * 128, 512);
    }
    for (int hu = F.vcu; hu < NH; hu += F.G) {
        const int u = NFULL + (hu >> 1), half = hu & 1, mt = u >> 2, pn = u & 3, e = moe_expert_of(pst, mt * 256);
        g8::Acc acc;
        g8::gemm_unit<true, true, true, MOE_WS>(g8::Opnd{as_h(h8), as_h(h8), 512, btok + mt * 256 + 128 * half},
                      g8::opnd(as_h(mw + MOEW_G + (size_t)(e * 512 + pn * 128) * 1024), as_h(mw + MOEW_U + (size_t)(e * 512 + pn * 128) * 1024), 512), 512, F.lds, acc); const LaneC L = lane_coords();
#pragma unroll
        for (int m = 0; m < 4; ++m)
#pragma unroll
            for (int n = 0; n < 2; ++n) {
                const f32x4 g = acc[0][0][m][n], up = acc[0][1][m][n];
                f32x4 r;
#pragma unroll
                for (int j = 0; j < 4; ++j) r[j] = silu_f(g[j]) * up[j];
                *reinterpret_cast<unsigned*>(F.lds + EPI_R(0, m) * 144 + EPI_S(0, n)) = pk4_fp8(r[0], r[1], r[2], r[3]);
            }
        epi_flush_fp8_128<true>(F.lds, act + (size_t)(mt * 256 + 128 * half) * 512 + pn * 128, 512);
    }
}
template <bool HALFX>
DI void epi_tile_bf16(g8::Acc& acc, char* lds, bf16_t* __restrict__ dst, const int ldd) {
    constexpr int P = 528, NR = HALFX ? 128 : 256;
    { const LaneC L = lane_coords();
#pragma unroll
      for (int ai = 0; ai < (HALFX ? 1 : 2); ++ai)
#pragma unroll
        for (int m = 0; m < 4; ++m)
#pragma unroll
            for (int bj = 0; bj < 2; ++bj)
#pragma unroll
                for (int n = 0; n < 2; ++n) { const f32x4 v = acc[ai][bj][m][n]; u32x2 w; w.x = cvt_pk(v[0], v[1]); w.y = cvt_pk(v[2], v[3]);
                    *reinterpret_cast<u32x2*>(lds + EPI_R(ai, m) * P + EPI_S(bj, n) * 2) = w; } }
    __syncthreads();
    { int tid = threadIdx.x; asm volatile("" : "+v"(tid));
      const int wave = tid >> 6, lane = tid & 63, sub = lane >> 5, c16 = lane & 31;
#pragma unroll
      for (int i = 0; i < NR / 16; ++i) { const int row = wave * (NR / 8) + 2 * i + sub;
          const u32x4 v = *reinterpret_cast<const u32x4*>(lds + row * P + c16 * 16);
          __builtin_nontemporal_store(v, reinterpret_cast<u32x4*>(dst + (size_t)row * ldd + c16 * 8)); } }
    __syncthreads();
}
template <int LAYER>
DI void ph_moe2(const Frame& F) {
    int* pst = (int*)(F.lds + LDS_MISC + 512);
    moe_pstart(F, LAYER, pst);
    const int MT = pst[32] >> 8, NU = MT * 4, NFULL = (NU / F.G) * F.G, NH = 2 * (NU - NFULL);
    const unsigned char* mw = F.ws + WS_MOEW;
    const unsigned char* act = (const unsigned char*)F.scr(SM_ACT); bf16_t* yb = F.scr(SM_Y);
    for (int u = F.vcu; u < NFULL; u += F.G) {
        const int mt = u >> 2, pn = u & 3, e = moe_expert_of(pst, mt * 256);
        g8::Acc acc;
        g8::gemm_unit<false, false, true, MOE_WS, true, false>(g8::opnd(as_h(act + (size_t)mt * 256 * 512), 256), g8::opnd(as_h(mw + MOEW_D + (size_t)(e * 1024 + pn * 256) * 512), 256), 256, F.lds, acc);
        epi_tile_bf16<false>(acc, F.lds, yb + (size_t)(mt * 256) * D + pn * 256, D);
    }
    for (int hu = F.vcu; hu < NH; hu += F.G) {
        const int u = NFULL + (hu >> 1), half = hu & 1, mt = u >> 2, pn = u & 3, e = moe_expert_of(pst, mt * 256);
        g8::Acc acc;
        const bf16_t* xa = as_h(act + (size_t)(mt * 256 + 128 * half) * 512);
        g8::gemm_unit<false, true, true, MOE_WS, true, false>(g8::opnd(xa, xa, 256), g8::opnd(as_h(mw + MOEW_D + (size_t)(e * 1024 + pn * 256) * 512), 256), 256, F.lds, acc);
        epi_tile_bf16<true>(acc, F.lds, yb + (size_t)(mt * 256 + 128 * half) * D + pn * 256, D);
    }
}
DI void ph_dft_a(const Frame& F) {
    const bf16_t* hb = (const bf16_t*)(F.ws + WS_H);
    bf16_t* Z = F.scr(SF_Z); bf16_t* Zc = F.scr(SF_ZC);
    for (int u = F.vcu; u < 1024 + 16; u += F.G) {
        g8::Acc acc;
        if (u < 1024) {
            const int st = u & 63, rt = (u >> 6) & 1, g = (u >> 7) & 3, b = u >> 9, bg = b * 4 + g;
            { const bf16_t* yb0 = hb + (size_t)(b * TB + NCTX + 2 * st) * 1024 + g * 256;
              g8::gemm_unit<false>(g8::opnd(F.wt(WT_DFTA) + (size_t)rt * 256 * 256, 256), g8::opnd(yb0, yb0 + 1024, 128 * 1024), 256, F.lds, acc); }
            const LaneC L = lane_coords();
#pragma unroll
            for (int ai = 0; ai < 2; ++ai)
#pragma unroll
                for (int m = 0; m < 4; ++m)
#pragma unroll
                    for (int bj = 0; bj < 2; ++bj)
#pragma unroll
                        for (int n = 0; n < 2; ++n) {
                            const int kc = EPI_R(ai, m), n2 = 2 * st + bj, n1 = L.wc * 32 + n * 16 + 4 * L.fq;
                            st_bf4(Z + ((((size_t)bg * 256 + kc) * 128 + n2) * 2 + rt) * 128 + n1, acc[ai][bj][m][n]);
                        }
        } else {
            const int q = u - 1024, rt = q & 1, g = (q >> 1) & 3, b = q >> 3, bg = b * 4 + g;
            g8::gemm_unit<false>(g8::opnd(F.wt(WT_DFTA) + (size_t)rt * 256 * 256, 256), g8::opnd(hb + (size_t)b * TB * 1024 + g * 256, 1024), 256, F.lds, acc); const LaneC L = lane_coords();
#pragma unroll
            for (int ai = 0; ai < 2; ++ai)
#pragma unroll
                for (int m = 0; m < 4; ++m)
#pragma unroll
                    for (int bj = 0; bj < 2; ++bj)
#pragma unroll
                        for (int n = 0; n < 2; ++n)
                            st_bf4(Zc + (((size_t)bg * 256 + EPI_R(ai, m)) * 2 + rt) * 256 + EPI_S(bj, n), acc[ai][bj][m][n]);
        }
    }
    tail_cvt(F, 1040, 1, 0, 720);
}
DI void ph_dft_1(const Frame& F) {
    const bf16_t* Z = F.scr(SF_Z); const bf16_t* Zc = F.scr(SF_ZC); bf16_t* A1 = F.scr(SF_A1); bf16_t* YF = F.scr(SF_YF);
    for (int u = F.vcu; u < 1024 + 8; u += F.G) {
        g8::Acc acc;
        if (u < 1024) {
            g8::gemm_unit<false>(g8::opnd(F.wt(WT_DFT1), 256), g8::opnd(Z + (size_t)u * 256 * 256, 256), 256, F.lds, acc); const LaneC L = lane_coords();
#pragma unroll
            for (int m = 0; m < 4; ++m) {
                const int kb = L.wr * 64 + m * 16 + L.fr;
#pragma unroll
                for (int bj = 0; bj < 2; ++bj)
#pragma unroll
                    for (int n = 0; n < 2; ++n) {
                        const int n2 = L.wc * 32 + n * 16 + 4 * L.fq, bgkc = 2 * u + bj;
                        const f32x4 re = acc[0][bj][m][n], im = acc[1][bj][m][n];
                        f32x4 ro, io;
#pragma unroll
                        for (int j = 0; j < 4; ++j) {
                            const float th = (float)((n2 + j) * kb) * (1.0f / 16384.0f);
                            const float c = __builtin_amdgcn_cosf(th), s = __builtin_amdgcn_sinf(th);
                            ro[j] = re[j] * c + im[j] * s; io[j] = im[j] * c - re[j] * s;
                        }
                        bf16_t* p = A1 + (((size_t)bgkc * 128 + kb) * 2) * 128 + n2;
                        st_bf4(p, ro); st_bf4(p + 128, io);
                        __builtin_amdgcn_sched_barrier(0);
                    }
            }
        } else {
            const int bg = u - 1024, b = bg >> 2, g = bg & 3;
            g8::gemm_unit<false>(g8::opnd(F.wt(WT_DFTC), 512), g8::opnd(Zc + (size_t)bg * 256 * 512, 512), 512, F.lds, acc); const LaneC L = lane_coords();
#pragma unroll
            for (int ai = 0; ai < 2; ++ai)
#pragma unroll
                for (int m = 0; m < 4; ++m)
#pragma unroll
                    for (int bj = 0; bj < 2; ++bj)
#pragma unroll
                        for (int n = 0; n < 2; ++n)
                            st_bf4(YF + (size_t)(b * TB + EPI_R(ai, m)) * 1024 + g * 256 + EPI_S(bj, n), acc[ai][bj][m][n]);
        }
    }
    tail_cvt(F, 1032, 1, 720, 1464);
}
DI void ph_dft_2(const Frame& F) {
    const bf16_t* A1 = F.scr(SF_A1); bf16_t* YF = F.scr(SF_YF);
    for (int u = F.vcu; u < 1024; u += F.G) {
        const int kb = u & 127, bg = u >> 7, b = bg >> 2, g = bg & 3;
        g8::Acc acc;
        g8::gemm_unit<false>(g8::opnd(F.wt(WT_DFT2), 256), g8::opnd(A1 + ((size_t)bg * 256 * 128 + kb) * 256, 128 * 256), 256, F.lds, acc); const LaneC L = lane_coords();
#pragma unroll
        for (int m = 0; m < 4; ++m) {
            const int ka = L.wr * 64 + m * 16 + L.fr;
#pragma unroll
            for (int bj = 0; bj < 2; ++bj)
#pragma unroll
                for (int n = 0; n < 2; ++n)
                    st_bf4(YF + (size_t)(b * TB + NCTX + 128 * ka + kb) * 1024 + g * 256 + EPI_S(bj, n), acc[0][bj][m][n]);
        }
    }
}
constexpr float LOG2E = 1.4426950408889634f;
struct MlaCfg {
    const bf16_t* Q; const bf16_t* K; const bf16_t* V; bf16_t* O; int qrow0, krow0, nt, head;
    DI const bf16_t* qrow(int w, int r) const { return Q + (size_t)(qrow0 + 32 * w + r) * 1536 + head * 192; }
    DI bf16_t* orow(int w, int r) const { return O + (size_t)(qrow0 + 32 * w + r) * 1024 + head * 128; }
    DI int ntiles() const { return nt; }
    DI const bf16_t* ktile(int t) const { return K + (size_t)(krow0 + 64 * t) * 1536 + head * 192; }
    DI const bf16_t* vtile(int t) const { return V + (size_t)(krow0 + 64 * t) * 1024 + head * 128; }
    DI int ldk() const { return 1536; } DI int ldv() const { return 1024; }
    DI bool active(int, int) const { return true; }
    DI void mask(f32x16&, f32x16&, int, int, int, int, const float*) const {}
    DI void init(f32x16& p0, f32x16& p1, int, int, int, int, const float*) const { _Pragma("unroll") for (int r = 0; r < 16; ++r) { p0[r] = 0.f; p1[r] = 0.f; } }
    DI float m0() const { return -1e28f; } DI float l0() const { return 0.f; }
    DI float cexp() const { return 0.07216878364870322f * LOG2E; }
};
template <int PRB>
DI void ph_mla_attn(const Frame& F) {
    for (int u = F.vcu; u < 1024 + 16; u += F.G) {
        MlaCfg c; c.Q = F.scr(SC_Q); c.K = F.scr(SC_K); c.V = F.scr(SC_V); c.O = PRB ? (bf16_t*)(F.ws + WS_END) : F.scr(SC_O);
        if (u < 1024) { const int b = u >> 9, head = (u >> 6) & 7, qb = u & 63; c.qrow0 = b * TB + NCTX + 256 * qb; c.krow0 = b * TB; c.nt = TB / 64; c.head = head; }
        else { const int q = u - 1024, b = q >> 3; c.head = q & 7; c.qrow0 = b * TB; c.krow0 = b * TB; c.nt = NCTX / 64; }
#if MLA_FP8
        at::mla_attn_unit_fp8<PRB>((const unsigned char*)F.scr(SC_Q8) + (size_t)c.qrow0 * 1536 + c.head * 192, (const unsigned char*)F.scr(SC_K8) + (size_t)c.krow0 * 1536 + c.head * 192,
                              (const unsigned char*)F.scr(SC_V8T) + (size_t)(c.head * 128) * T + c.krow0,
                              WO_FP8 ? (bf16_t*)((unsigned char*)c.O + (size_t)c.qrow0 * 1024 + c.head * 128) : c.O + (size_t)c.qrow0 * 1024 + c.head * 128, c.nt, F.lds);
#else
        at::mla_attn_unit<PRB>(c.Q + (size_t)c.qrow0 * 1536 + c.head * 192, c.K + (size_t)c.krow0 * 1536 + c.head * 192, c.V + (size_t)c.krow0 * 1024 + c.head * 128,
                          c.O + (size_t)c.qrow0 * 1024 + c.head * 128, c.nt, F.lds);
#endif
    }
}
#ifdef MLA_CHECK
DI void ph_mla_attn_ref(const Frame& F) {
    for (int u = F.vcu; u < 1024 + 16; u += F.G) {
        MlaCfg c; c.Q = F.scr(SC_Q); c.K = F.scr(SC_K); c.V = F.scr(SC_V); c.O = (bf16_t*)(F.ws + WS_END);
        if (u < 1024) { const int b = u >> 9, head = (u >> 6) & 7, qb = u & 63; c.qrow0 = b * TB + NCTX + 256 * qb; c.krow0 = b * TB; c.nt = TB / 64; c.head = head; }
        else { const int q = u - 1024, b = q >> 3; c.head = q & 7; c.qrow0 = b * TB; c.krow0 = b * TB; c.nt = NCTX / 64; }
        at::attn_unit<192, 128>(c, F.lds, nullptr);
    }
}
DI void ph_mla_compare(const Frame& F) {
    const bf16_t* a = F.scr(SC_O); const bf16_t* b = (const bf16_t*)(F.ws + WS_END);
    float num = 0.f, den = 0.f;
    for (size_t i = (size_t)F.vcu * NTHR + F.tid; i < (size_t)T * 1024; i += (size_t)F.G * NTHR) { const float x = bf2f(a[i]), y = bf2f(b[i]); num += (x - y) * (x - y); den += y * y; }
    num = wave_sum(num); den = wave_sum(den);
    float* acc = (float*)(F.ws + WS_CTL + 32768);
    if (F.lane == 0) { atomicAdd(acc, num); atomicAdd(acc + 1, den); }
}
#endif
struct NaCfg {
    const bf16_t* Q; const bf16_t* K; const bf16_t* V; bf16_t* O; int qrow0, b, head, rg, rs_lo, nt; bool ctxq;
    DI const bf16_t* qrow(int w, int r) const { return Q + (size_t)(qrow0 + 32 * w + r) * 1024 + head * 64; }
    DI bf16_t* orow(int w, int r) const { return O + (size_t)(qrow0 + 32 * w + r) * 1024 + head * 64; }
    DI int ntiles() const { return nt; }
    DI int krow(int t) const { return t < 4 ? b * TB + 64 * t : b * TB + NCTX + 64 * (rs_lo + t - 4); }
    DI const bf16_t* ktile(int t) const { return K + (size_t)krow(t) * 1024 + head * 64; }
    DI const bf16_t* vtile(int t) const { return V + (size_t)krow(t) * 1024 + head * 64; }
    DI int ldk() const { return 1024; } DI int ldv() const { return 1024; }
    DI static int clampi(int x, int lo, int hi) { return x < lo ? lo : (x > hi ? hi : x); }
    DI bool active(int t, int w) const { if (t < 4) return true; const int qr = 4 * rg + (w >> 1), rs = clampi(qr - 4, 0, 248), kr = rs_lo + t - 4; return kr >= rs && kr < rs + 8; }
    DI void init(f32x16& p0, f32x16& p1, int t, int w, int r32, int hi, const float* tbl) const {
        if (t < 4) {
#pragma unroll
            for (int r = 0; r < 16; ++r) { p0[r] = 0.f; p1[r] = 0.f; }
            return;
        }
        const int qr = 4 * rg + (w >> 1), kr = rs_lo + t - 4, qc = (w & 1) * 32 + r32;
        const float* tb = tbl + (kr - qr + 7) * 31 + 15 - qc;
#pragma unroll
        for (int r = 0; r < 16; ++r) { const int k0 = at::crow(r, hi); p0[r] = tb[k0]; p1[r] = tb[32 + k0]; }
    }
    DI void mask(f32x16& p0, f32x16& p1, int t, int w, int r32, int hi, const float*) const {
        if (t < 4) return;
        const int qc = (w & 1) * 32 + r32, cs = clampi(qc - 8, 0, 48);
#pragma unroll
        for (int r = 0; r < 16; ++r) {
            const int k0 = at::crow(r, hi), k1 = 32 + k0;
            p0[r] = (k0 >= cs && k0 < cs + 16) ? p0[r] : -1e30f;
            p1[r] = (k1 >= cs && k1 < cs + 16) ? p1[r] : -1e30f;
        }
    }
    DI float m0() const { return -1e28f; } DI float l0() const { return 0.f; }
    DI float cexp() const { return 0.125f * LOG2E; }
};
DI void ph_na_attn(const Frame& F) {
    float* tbl = (float*)(F.lds + 24576);
    for (int u = F.vcu; u < 2048 + 32; u += F.G) {
        NaCfg c; c.Q = F.scr(SN_Q); c.K = F.scr(SN_K); c.V = F.scr(SN_V); c.O = F.scr(SN_O);
        if (u < 2048) {
            const int b = u >> 10, head = (u >> 6) & 15, rg = u & 63;
            c.b = b; c.head = head; c.rg = rg; c.qrow0 = b * TB + NCTX + 256 * rg; c.ctxq = false;
            c.rs_lo = NaCfg::clampi(4 * rg - 4, 0, 248);
            const int last = NaCfg::clampi(4 * rg + 3 - 4, 0, 248) + 7;
            c.nt = 4 + last - c.rs_lo + 1;
        } else { const int q = u - 2048; c.b = q >> 4; c.head = q & 15; c.rg = 0; c.rs_lo = 0; c.qrow0 = c.b * TB; c.nt = 4; c.ctxq = true; }
        const float* rpb = F.in[I_RPB] + c.head * 465;
        for (int i = F.tid; i < 465; i += NTHR) tbl[i] = rpb[i] * 8.0f;
        at::attn_unit<64, 64>(c, F.lds, tbl);
    }
}
struct SwaCfg {
    const bf16_t* Q; const bf16_t* K; const bf16_t* V; bf16_t* O; int qrow0, b, head, qb, klo, nt; float sink;
    DI const bf16_t* qrow(int w, int r) const { return Q + (size_t)(qrow0 + 32 * w + r) * 1024 + head * 64; }
    DI bf16_t* orow(int w, int r) const { return O + (size_t)(qrow0 + 32 * w + r) * 1024 + head * 64; }
    DI int ntiles() const { return nt; }
    DI int krow(int t) const { return t < 4 ? b * TB + 64 * t : b * TB + NCTX + 64 * (klo + t - 4); }
    DI const bf16_t* ktile(int t) const { return K + (size_t)krow(t) * 256 + (head >> 2) * 64; }
    DI const bf16_t* vtile(int t) const { return V + (size_t)krow(t) * 256 + (head >> 2) * 64; }
    DI int ldk() const { return 256; } DI int ldv() const { return 256; }
    DI bool active(int t, int w) const { if (t < 4) return true; const int qlo = 256 * qb + 32 * w, k0 = 64 * (klo + t - 4); return k0 + 63 >= qlo - 128 && k0 <= qlo + 31 + 128; }
    DI void mask(f32x16& p0, f32x16& p1, int t, int w, int r32, int hi, const float*) const {
        if (t < 4) return;
        const int d0 = 64 * (klo + t - 4) - (256 * qb + 32 * w + r32);
#pragma unroll
        for (int r = 0; r < 16; ++r) {
            const int da = d0 + at::crow(r, hi), db = da + 32;
            p0[r] = (da >= -128 && da <= 128) ? p0[r] : -1e30f;
            p1[r] = (db >= -128 && db <= 128) ? p1[r] : -1e30f;
        }
    }
    DI void init(f32x16& p0, f32x16& p1, int, int, int, int, const float*) const { _Pragma("unroll") for (int r = 0; r < 16; ++r) { p0[r] = 0.f; p1[r] = 0.f; } }
    DI float m0() const { return sink * 8.0f; } DI float l0() const { return 1.f; }
    DI float cexp() const { return 0.125f * LOG2E; }
};
DI void ph_swa_attn(const Frame& F) {
    for (int u = F.vcu; u < 2048; u += F.G) {
        SwaCfg c; c.Q = F.scr(SS_Q); c.K = F.scr(SS_K); c.V = F.scr(SS_V); c.O = F.scr(SS_O);
        const int b = u >> 10, head = (u >> 6) & 15, qb = u & 63;
        c.b = b; c.head = head; c.qb = qb; c.qrow0 = b * TB + NCTX + 256 * qb;
        c.klo = 4 * qb - 2 < 0 ? 0 : 4 * qb - 2;
        const int khi = 4 * qb + 5 > 255 ? 255 : 4 * qb + 5;
        c.nt = 4 + khi - c.klo + 1;
        c.sink = F.in[I_SINK][head];
        at::attn_unit<64, 64>(c, F.lds, nullptr);
    }
}

#ifdef MLA_CHECK
constexpr int N_PHASES = 39;
#else
constexpr int N_PHASES = 37;
#endif
__global__ void __launch_bounds__(NTHR, 2) mk_fwd(Params P) {
    extern __shared__ __attribute__((aligned(16))) char lds[];
    Frame F;
    F.in = (const float* const __attribute__((address_space(4)))*)__builtin_amdgcn_kernarg_segment_ptr(); F.out = P.out; F.ws = P.ws; F.lds = lds;
    F.tid = threadIdx.x; F.lane = F.tid & 63; F.wave = __builtin_amdgcn_readfirstlane(F.tid >> 6);
    F.G = gridDim.x; { const int bx = blockIdx.x; F.vcu = (F.G % 8 == 0) ? (bx % 8) * (F.G / 8) + bx / 8 : bx; }
    const int lo = P.ph_lo, hi = P.ph_hi;
    volatile LAS unsigned* stw = (volatile LAS unsigned*)(lds + LDS_MISC);
    if (F.tid < 4) stw[F.tid] = 0u;
    __syncthreads();
    XcdBarrier bar; bar.bar = (unsigned*)(P.ws + WS_CTL); bar.x = 0; bar.st = stw;
    if (hi - lo > 1) bar = xcd_barrier_post((unsigned*)(P.ws + WS_CTL), stw);
    int ph = 0;
#ifndef REP_MASK
#define REP_MASK 0ull
#endif
#ifndef ONLY_PHASE
#define ONLY_PHASE (-1)
#endif
#define PHASE(body) do { if (lo <= ph && ph < hi && (ONLY_PHASE < 0 || ph == ONLY_PHASE)) { { int t_ = threadIdx.x; asm volatile("" : "+v"(t_)); F.tid = t_; F.lane = t_ & 63; } body; \
    if ((REP_MASK >> ph) & 1ull) { if (hi - lo > 1) xcd_barrier(bar); body; } if (ph + 1 < hi) xcd_barrier(bar); } ++ph; } while (0)
#define PHASE2(body, drybody) do { if (lo <= ph && ph < hi && (ONLY_PHASE < 0 || ph == ONLY_PHASE)) { { int t_ = threadIdx.x; asm volatile("" : "+v"(t_)); F.tid = t_; F.lane = t_ & 63; } body; \
    if ((REP_MASK >> ph) & 1ull) { if (hi - lo > 1) xcd_barrier(bar); drybody; } if (ph + 1 < hi) xcd_barrier(bar); } ++ph; } while (0)
    PHASE(ph_prologue(F));
    PHASE(ph_modreduce(F));
    PHASE2(ph_norm1<0>(F), ph_norm1<0>(F, true));
    PHASE(ph_mla_proj1<false>(F));
    PHASE(ph_mla_proj2(F));
#ifndef MLA_PRB
#define MLA_PRB 0
#endif
    PHASE2(ph_mla_attn<0>(F), ph_mla_attn<MLA_PRB>(F));
#ifdef MLA_CHECK
    PHASE(ph_mla_attn_ref(F));
    PHASE(ph_mla_compare(F));
#endif
    PHASE2(ph_wo<WO_FP8>(F, F.scr(SC_O), F.wt(WT_WO0), nullptr, 0), ph_wo<WO_FP8>(F, F.scr(SC_O), F.wt(WT_WO0), nullptr, 0, true));
    PHASE2(ph_norm2_router<0>(F), ph_norm2_router<0>(F, true));
    PHASE(ph_scatter<0>(F));
    PHASE(ph_moe1<0>(F));
#ifndef MOE2_EPRB
#define MOE2_EPRB 0
#endif
    PHASE(ph_moe2<0>(F));
    PHASE2(ph_norm1<1>(F), ph_norm1<1>(F, true));
    PHASE(ph_dft_a(F));
    PHASE(ph_dft_1(F));
    PHASE(ph_dft_2(F));
    PHASE2(ph_wo<false>(F, F.scr(SF_YF), F.wt(WT_WO1), F.in[I_FBO], 1), ph_wo<false>(F, F.scr(SF_YF), F.wt(WT_WO1), F.in[I_FBO], 1, true));
    PHASE2(ph_norm2_router<1>(F), ph_norm2_router<1>(F, true));
    PHASE(ph_scatter<1>(F));
    PHASE(ph_moe1<1>(F));
    PHASE(ph_moe2<1>(F));
    PHASE2(ph_norm1<2>(F), ph_norm1<2>(F, true));
    PHASE(ph_na_qkv(F));
    PHASE(ph_na_attn(F));
    PHASE2(ph_wo<WO_FP8>(F, F.scr(SN_O), F.wt(WT_WO2), nullptr, 2), ph_wo<WO_FP8>(F, F.scr(SN_O), F.wt(WT_WO2), nullptr, 2, true));
    PHASE2(ph_norm2_router<2>(F), ph_norm2_router<2>(F, true));
    PHASE(ph_scatter<2>(F));
    PHASE(ph_moe1<2>(F));
    PHASE(ph_moe2<2>(F));
    PHASE2(ph_norm1<3>(F), ph_norm1<3>(F, true));
    PHASE(ph_swa_qkv(F));
    PHASE(ph_swa_attn(F));
    PHASE2(ph_wo<WO_FP8>(F, F.scr(SS_O), F.wt(WT_WO3), nullptr, 3), ph_wo<WO_FP8>(F, F.scr(SS_O), F.wt(WT_WO3), nullptr, 3, true));
    PHASE2(ph_norm2_router<3>(F), ph_norm2_router<3>(F, true));
    PHASE(ph_scatter<3>(F));
    PHASE(ph_moe1<3>(F));
    PHASE(ph_moe2<3>(F));
    PHASE2(ph_norm1<4>(F), ph_norm1<4>(F, true));
#undef PHASE
}

extern "C" void kernel_launch(void* const* d_in, const int* in_sizes, int n_in, void* d_out, int out_size, void* d_ws, size_t ws_size, hipStream_t stream) {
    static int grid = 0;
    if (grid == 0) {
        if (n_in != 31 || ws_size < WS_END) { fprintf(stderr, "kernel_launch: n_in %d ws %zu (need %zu)\n", n_in, ws_size, (size_t)WS_END); grid = -1; return; }
        int dev = 0, cus = 0, per_cu = 0;
        if (hipGetDevice(&dev) != hipSuccess || hipDeviceGetAttribute(&cus, hipDeviceAttributeMultiprocessorCount, dev) != hipSuccess) { grid = -1; return; }
        if (hipFuncSetAttribute((const void*)mk_fwd, hipFuncAttributeMaxDynamicSharedMemorySize, LDS_BYTES) != hipSuccess) { fprintf(stderr, "kernel_launch: hipFuncSetAttribute failed\n"); grid = -1; return; }
        if (hipOccupancyMaxActiveBlocksPerMultiprocessor(&per_cu, (const void*)mk_fwd, NTHR, LDS_BYTES) != hipSuccess || per_cu < 1) { fprintf(stderr, "kernel_launch: occupancy query says %d\n", per_cu); (void)hipGetLastError(); per_cu = 1; }
        grid = cus;
    }
    if (grid < 0) return;
    (void)hipMemsetAsync((char*)d_ws + WS_CTL, 0, CTL_BYTES, stream);
    Params p; memset(&p, 0, sizeof(p));
    for (int i = 0; i < 31; ++i) p.in[i] = (const float*)d_in[i];
    p.out = (float*)d_out; p.ws = (unsigned char*)d_ws;
#if MK_ONE_LAUNCH
    p.ph_lo = 0; p.ph_hi = N_PHASES;
    hipLaunchKernelGGL(mk_fwd, dim3(grid), dim3(NTHR), LDS_BYTES, stream, p);
#else
    for (int k = 0; k < N_PHASES; ++k) { p.ph_lo = k; p.ph_hi = k + 1; hipLaunchKernelGGL(mk_fwd, dim3(grid), dim3(NTHR), LDS_BYTES, stream, p); }
#endif
    const hipError_t le = hipPeekAtLastError();
    if (le != hipSuccess) fprintf(stderr, "kernel_launch: launch failed: %s\n", hipGetErrorName(le));
}
```

```cpp
#include <hip/hip_runtime.h>
#include <stdint.h>
#include <stdio.h>
#include <string.h>

#define DI __device__ __forceinline__
#define LAS __attribute__((address_space(3)))
typedef unsigned short bf16_t;
typedef short bf16x8 __attribute__((ext_vector_type(8)));
typedef short s16x4 __attribute__((ext_vector_type(4)));
typedef float f32x4 __attribute__((ext_vector_type(4)));
typedef float f32x16 __attribute__((ext_vector_type(16)));
typedef unsigned u32x4 __attribute__((ext_vector_type(4)));
typedef unsigned u32x2 __attribute__((ext_vector_type(2)));

#ifndef MLA_FP8
#define MLA_FP8 1
#endif
#if defined(MLA_CHECK) || !MLA_FP8
#define MLA_KEEP_BF16 1
#else
#define MLA_KEEP_BF16 0
#endif
#ifndef GEMM_FP8
#if defined(MLA_CHECK)
#define GEMM_FP8 0
#else
#define GEMM_FP8 1
#endif
#endif
#ifndef WO_FP8
#define WO_FP8 GEMM_FP8
#endif
#ifndef MK_ONE_LAUNCH
#define MK_ONE_LAUNCH 1
#endif

constexpr int D = 1024, SEQ = 16384, NCTX = 256, TB = SEQ + NCTX  , T = 2 * TB  ;
constexpr int NTHR = 512;
constexpr int MOE_MAXT = 292;
constexpr int MOE_SLOTS = MOE_MAXT * 256;
constexpr float EPS = 1e-6f;

constexpr size_t al256(size_t x) { return (x + 255) / 256 * 256; }
constexpr size_t WS_CTL = 0;
constexpr size_t CTL_BYTES = 65536;
constexpr size_t CTL_COUNTS = 16384;
constexpr size_t WS_MODP = WS_CTL + CTL_BYTES;
constexpr size_t WS_MODV = WS_MODP + (size_t)16 * 4 * 3 * 6144 * 4;
constexpr size_t WS_MODA = WS_MODV + (size_t)4 * 3 * 6144 * 4;
constexpr size_t WS_ROPE = WS_MODA + (size_t)4 * 3 * 2 * 1024 * 4;
constexpr size_t WS_EID = WS_ROPE + 256 * 16 * 2 * 4;
constexpr size_t WS_GW = WS_EID + (size_t)T * 8;
constexpr size_t WS_POS = WS_GW + (size_t)T * 8;
constexpr size_t WS_SLOT = WS_POS + (size_t)T * 8;
constexpr size_t WS_BTOK = WS_SLOT + (size_t)T * 8;
constexpr size_t WS_SQQ = al256(WS_BTOK + (size_t)MOE_SLOTS * 4);
constexpr size_t WS_SQKV = WS_SQQ + (size_t)T * 8;
constexpr size_t WS_SQX = WS_SQKV + (size_t)T * 4;
constexpr int RW_PITCH = 2064, RW_HALF = 36 * RW_PITCH;
constexpr size_t WS_RW = al256(WS_SQX + (size_t)T * 16);
constexpr size_t WS_WT = al256(WS_RW + (size_t)4 * 2 * RW_HALF);
constexpr size_t WT_P1 = 0;
constexpr size_t WT_UQ = WT_P1 + (size_t)1024 * 1024;
constexpr size_t WT_UKV = WT_UQ + (size_t)1536 * 512;
constexpr size_t WT_WO0 = WT_UKV + (size_t)2048 * 256;
constexpr size_t WT_WO1 = WT_WO0 + (size_t)1024 * 1024;
constexpr size_t WT_NAQKV = WT_WO1 + (size_t)1024 * 1024;
constexpr size_t WT_WO2 = WT_NAQKV + (size_t)3072 * 1024;
constexpr size_t WT_SWQKV = WT_WO2 + (size_t)1024 * 1024;
constexpr size_t WT_WO3 = WT_SWQKV + (size_t)1536 * 1024;
constexpr size_t WT_DFTA = WT_WO3 + (size_t)1024 * 1024;
constexpr size_t WT_DFT1 = WT_DFTA + (size_t)512 * 256;
constexpr size_t WT_DFT2 = WT_DFT1 + (size_t)256 * 256;
constexpr size_t WT_DFTC = WT_DFT2 + (size_t)256 * 256;
constexpr size_t WT_END = WT_DFTC + (size_t)256 * 512;
constexpr size_t WS_MOEW = al256(WS_WT + WT_END * 2);
constexpr size_t MOEW_G = 0, MOEW_U = (size_t)32 * 512 * 1024, MOEW_D = (size_t)2 * 32 * 512 * 1024, MOEW_EL = (size_t)3 * 32 * 512 * 1024;
constexpr size_t WS_XRES = al256(WS_MOEW + MOEW_EL * 2);
constexpr size_t WS_H = WS_XRES + (size_t)T * D * 4;
constexpr size_t WS_SCR = WS_H + (size_t)T * D * 2;
constexpr size_t SC_CQ = 0;
constexpr size_t SC_CKV = SC_CQ + (size_t)T * 512 * 2;
constexpr size_t SC_Q = SC_CKV + (size_t)T * 256 * 2;
constexpr size_t SC_K = SC_Q + (size_t)T * 1536 * 2;
constexpr size_t SC_V = SC_K + (size_t)T * 1536 * 2;
constexpr size_t SC_O = SC_V + (size_t)T * 1024 * 2;
constexpr size_t SC_Q8 = SC_O + (size_t)T * 1024 * 2;
constexpr size_t SC_K8 = SC_Q8 + (size_t)T * 1536;
constexpr size_t SC_V8T = SC_K8 + (size_t)T * 1536;
constexpr size_t SC_END_MLA = SC_V8T + (size_t)T * 1024;
constexpr size_t SF_Z = 0;
constexpr size_t SF_ZC = SF_Z + (size_t)2048 * 128 * 256 * 2;
constexpr size_t SF_A1 = SF_ZC + (size_t)2048 * 512 * 2;
constexpr size_t SF_YF = SF_A1 + (size_t)2048 * 128 * 256 * 2;
constexpr size_t SN_Q = 0, SN_K = (size_t)T * 2048, SN_V = (size_t)T * 4096, SN_O = (size_t)T * 6144;
constexpr size_t SS_Q = 0, SS_K = (size_t)T * 2048, SS_V = SS_K + (size_t)T * 512, SS_O = SS_V + (size_t)T * 512;
constexpr size_t SM_ACT = 0;
constexpr size_t SM_Y = (size_t)MOE_SLOTS * 1024;
constexpr size_t SM_END = SM_Y + (size_t)MOE_SLOTS * 2048;
constexpr size_t SCR_BYTES = SC_END_MLA > SM_END ? SC_END_MLA : SM_END;
constexpr size_t WS_END = WS_SCR + SCR_BYTES;

constexpr int LDS_MISC = 152 * 1024;
constexpr int LDS_BYTES = 156 * 1024;

DI unsigned cvt_pk(float lo, float hi) { unsigned r; asm volatile("v_cvt_pk_bf16_f32 %0, %1, %2" : "=v"(r) : "v"(lo), "v"(hi)); return r; }
DI float bf2f(bf16_t x) { return __uint_as_float((unsigned)x << 16); }
DI float bflo(unsigned w) { return __uint_as_float(w << 16); }
DI float bfhi(unsigned w) { return __uint_as_float(w & 0xffff0000u); }
DI float silu_f(float x) { return x / (1.0f + __expf(-x)); }
DI float wave_sum(float v) {
#pragma unroll
    for (int o = 32; o >= 1; o >>= 1) v += __shfl_xor(v, o);
    return v;
}

#define XB_TMO      128
#define XB_XCNT(j)  (256  + 64 * (j))
#define XB_XSUB(j)  (1280 + 64 * (j))
#define XB_XGEN(j)  (2304 + 64 * (j))
#define XB_TOP      3328
#define XB_TOPGEN   3392
#define XCD_BAR_WORDS 3456
#define XB_SPIN_CAP (1u << 18)

__device__ __forceinline__ unsigned xb_ld(unsigned* p)              { return __hip_atomic_load(p, __ATOMIC_RELAXED, __HIP_MEMORY_SCOPE_AGENT); }
__device__ __forceinline__ unsigned xb_add(unsigned* p, unsigned v) { return __hip_atomic_fetch_add(p, v, __ATOMIC_RELAXED, __HIP_MEMORY_SCOPE_AGENT); }
__device__ __forceinline__ unsigned xb_xcc_id() { return (unsigned)__builtin_amdgcn_s_getreg((3 << 11) | 20) & 0xFu; }
#define XB_SPIN(cond, bar) do { unsigned _sp = 0; while (cond) { __builtin_amdgcn_s_sleep(1); \
    if ((++_sp & 255u) == 0u) { if (xb_ld(&(bar)[XB_TMO])) break; if (_sp > XB_SPIN_CAP) { atomicAdd(&(bar)[XB_TMO], 1u); break; } } } } while (0)

struct XcdBarrier {
    unsigned* bar; unsigned x;
    volatile LAS unsigned* st;
};
__device__ __forceinline__ XcdBarrier xcd_barrier_post(unsigned* bar, volatile LAS unsigned* st) {
    XcdBarrier b; b.bar = bar; b.x = xb_xcc_id(); b.st = st;
    if (threadIdx.x == 0) (void)xb_add(&bar[XB_XCNT(b.x)], 1u);
    return b;
}
__device__ __forceinline__ void xcd_barrier_complete(unsigned* bar, unsigned x, unsigned& nloc, unsigned& nx) {
    const unsigned G = gridDim.x * gridDim.y * gridDim.z;
    unsigned sum, cnt, mine, sp = 0u;
    for (;;) {
        sum = 0u; cnt = 0u; mine = 0u;
#pragma unroll
        for (unsigned j = 0; j < 16; ++j) { const unsigned c = xb_ld(&bar[XB_XCNT(j)]); sum += c; cnt += (c > 0u) ? 1u : 0u; mine = (j == x) ? c : mine; }
        if (sum == G) break;
        __builtin_amdgcn_s_sleep(1);
        if ((++sp & 255u) == 0u) { if (xb_ld(&bar[XB_TMO])) break; if (sp > XB_SPIN_CAP) { atomicAdd(&bar[XB_TMO], 1u); break; } }
    }
    nloc = mine > 0u ? mine : 1u; nx = cnt > 0u ? cnt : 1u;
}
__device__ __forceinline__ void xcd_barrier(const XcdBarrier& b) {
    asm volatile("s_waitcnt vmcnt(0)" ::: "memory");
    __syncthreads();
    if (threadIdx.x == 0) {
        unsigned* bar = b.bar;
        __builtin_amdgcn_s_waitcnt(0);
        unsigned nloc = b.st[0], nx = b.st[1];
        if (nloc == 0u) { xcd_barrier_complete(bar, b.x, nloc, nx); b.st[0] = nloc; b.st[1] = nx; }
        const unsigned old = xb_add(&bar[XB_XSUB(b.x)], 1u);
        const unsigned gen = old / nloc;
        if (old + 1u == (gen + 1u) * nloc) {
            __builtin_amdgcn_fence(__ATOMIC_RELEASE, "agent");
            asm volatile("s_waitcnt vmcnt(0)" ::: "memory");
            const unsigned og = xb_add(&bar[XB_TOP], 1u);
            const unsigned tg = og / nx;
            if (og + 1u == (tg + 1u) * nx) xb_add(&bar[XB_TOPGEN], 1u);
            else XB_SPIN(xb_ld(&bar[XB_TOPGEN]) == tg, bar);
            __builtin_amdgcn_fence(__ATOMIC_ACQUIRE, "agent");
            xb_add(&bar[XB_XGEN(b.x)], 1u);
            asm volatile("s_waitcnt vmcnt(0)" ::: "memory");
        } else {
            XB_SPIN(xb_ld(&bar[XB_XGEN(b.x)]) == gen, bar);
            __builtin_amdgcn_fence(__ATOMIC_ACQUIRE, "agent");
            asm volatile("s_waitcnt vmcnt(0)" ::: "memory");
        }
    }
    __syncthreads();
}

namespace g8 {
#ifndef PIN8
#define PIN8 1
#endif
#ifndef G8_MERGE
#define G8_MERGE 0
#endif
constexpr int HTB = 128 * 64 * 2;
constexpr int STAGE_BYTES = 8 * HTB;
DI int lds_byte(int r, int c) { const int st = (r >> 4) * 2 + (c >> 5), rr = r & 15, cc = c & 31, ob = rr * 64 + cc * 2; return st * 1024 + (ob ^ (((ob >> 9) & 1) << 5)); }
DI void stage_rc(int b, int& R, int& C) { const int st = b / 1024, sb = b % 1024, swz = sb ^ (((sb >> 9) & 1) << 5); R = (st >> 1) * 16 + swz / 64; C = (st & 1) * 32 + (swz % 64) / 2; }

typedef f32x4 Acc[2][2][4][2];
typedef int v8i_t __attribute__((ext_vector_type(8)));
DI v8i_t ld8_2x16(const char* p) { const u32x4 a = *reinterpret_cast<const u32x4*>(p), b = *reinterpret_cast<const u32x4*>(p + 16); return (v8i_t){(int)a.x, (int)a.y, (int)a.z, (int)a.w, (int)b.x, (int)b.y, (int)b.z, (int)b.w}; }

struct Opnd { const bf16_t* b0; const bf16_t* b1; int ld; const int* idx; };
DI Opnd opnd(const bf16_t* b0, const bf16_t* b1, int ld) { return Opnd{b0, b1, ld, nullptr}; }
DI Opnd opnd(const bf16_t* b0, int ld) { return Opnd{b0, b0 + (size_t)128 * ld, ld, nullptr}; }
template <bool GATHER, bool HALFX = false, bool FP8 = false, int YSCALE = 127, bool LD16 = true, bool MERGE = (G8_MERGE != 0)>
DI void gemm_unit(const Opnd X, const Opnd Y, const int K, char* lds, Acc& acc) {
    int tid = threadIdx.x; asm volatile("" : "+v"(tid));
    int r0, c0; stage_rc(tid * 16, r0, c0);
    unsigned vx0, vx1, vx2, vx3;
    if (GATHER) { vx0 = (unsigned)(X.idx[r0] * X.ld + c0) * 2u; vx1 = (unsigned)(X.idx[r0 + 64] * X.ld + c0) * 2u;
                  if (HALFX) { vx2 = vx0; vx3 = vx1; } else { vx2 = (unsigned)(X.idx[128 + r0] * X.ld + c0) * 2u; vx3 = (unsigned)(X.idx[192 + r0] * X.ld + c0) * 2u; } }
    else { vx0 = (unsigned)(r0 * X.ld + c0) * 2u; vx1 = vx0; vx2 = vx0; vx3 = vx0; }
    const unsigned vy0 = (unsigned)(r0 * Y.ld + c0) * 2u;
    const size_t xd64 = GATHER ? 0 : (size_t)128 * X.ld, yd64 = (size_t)128 * Y.ld;
    const char* const XB0 = (const char*)X.b0; const char* const XB1 = GATHER ? (const char*)X.b0 : (const char*)X.b1;
    const char* const YB0 = (const char*)Y.b0; const char* const YB1 = (const char*)Y.b1;
    const int wid = tid >> 6, lane = tid & 63, wr = wid >> 2, wc = wid & 3, fr = lane & 15, fq = lane >> 4;
    const int wbase = __builtin_amdgcn_readfirstlane(tid >> 6) * 1024;
    const int swz_ = (fr * 64 + fq * 16) ^ ((((fr * 64 + fq * 16) >> 9) & 1) << 5);
    const char* const abase = lds + wr * 8192 + swz_;
    const char* const bbase = lds + 4 * HTB + wc * 4096 + swz_;
    const int swz8_ = (fr * 64 + (fq & 1) * 32) ^ ((((fr * 64 + (fq & 1) * 32) >> 9) & 1) << 5);
    const char* const abase8 = lds + wr * 8192 + (fq >> 1) * 1024 + swz8_;
    const char* const bbase8 = lds + 4 * HTB + wc * 4096 + (fq >> 1) * 1024 + swz8_;
#define SA(b, h) (lds + ((b) * 2 + (h)) * HTB)
#define SB(b, h) (lds + (4 + (b) * 2 + (h)) * HTB)
#define STG(P, BASE, DELTA, o0, o1, kt) do { const char* _s = (BASE) + (size_t)(kt) * 128; unsigned o0_ = (o0), o1_ = (o1); \
    if (FP8) asm volatile("" : "+v"(o0_), "+v"(o1_));     \
    __builtin_amdgcn_global_load_lds((const unsigned*)(_s + o0_), (unsigned*)((P) + wbase), 16, 0, 0); \
    __builtin_amdgcn_global_load_lds((const unsigned*)(_s + (DELTA) + o1_), (unsigned*)((P) + wbase + 8192), 16, 0, 0); } while (0)
#define STGA(b, h, kt) do { if ((h) == 0) STG(SA(b, 0), XB0, xd64, vx0, vx1, kt); else STG(SA(b, 1), XB1, xd64, vx2, vx3, kt); } while (0)
#define STGB(b, h, kt) do { if ((h) == 0) STG(SB(b, 0), YB0, yd64, vy0, vy0, kt); else STG(SB(b, 1), YB1, yd64, vy0, vy0, kt); } while (0)
#define LD8(P) (LD16 ? ld8_2x16(P) : *reinterpret_cast<const v8i_t*>(P))
#define LDA(dst, b, h) do { if (FP8) { _Pragma("unroll") for (int m = 0; m < 4; ++m) dst##8[m] = LD8(abase8 + (((b) * 2 + (h)) * HTB + m * 2048)); } \
    else { _Pragma("unroll") for (int m = 0; m < 4; ++m) _Pragma("unroll") for (int k = 0; k < 2; ++k) dst[m][k] = *reinterpret_cast<const bf16x8*>(abase + (((b) * 2 + (h)) * HTB + m * 2048 + k * 1024)); } } while (0)
#define LDB(dst, b, h) do { if (FP8) { _Pragma("unroll") for (int n = 0; n < 2; ++n) dst##8[n] = LD8(bbase8 + (((b) * 2 + (h)) * HTB + n * 2048)); } \
    else { _Pragma("unroll") for (int n = 0; n < 2; ++n) _Pragma("unroll") for (int k = 0; k < 2; ++k) dst[n][k] = *reinterpret_cast<const bf16x8*>(bbase + (((b) * 2 + (h)) * HTB + n * 2048 + k * 1024)); } } while (0)
#define MMA(ai, bj, At, Bt) do { if (FP8 && HALFX && (ai) == 1) break; if (FP8) __builtin_amdgcn_sched_barrier(0); __builtin_amdgcn_s_setprio(1); \
    if (FP8) { _Pragma("unroll") for (int m = 0; m < 4; ++m) _Pragma("unroll") for (int n = 0; n < 2; ++n) \
      acc[ai][bj][m][n] = __builtin_amdgcn_mfma_scale_f32_16x16x128_f8f6f4(Bt##8[n], At##8[m], acc[ai][bj][m][n], 0, 0, 0, sc_y, 0, sc_x); } \
    else { _Pragma("unroll") for (int m = 0; m < 4; ++m) _Pragma("unroll") for (int n = 0; n < 2; ++n) _Pragma("unroll") for (int k = 0; k < 2; ++k) \
      acc[ai][bj][m][n] = __builtin_amdgcn_mfma_f32_16x16x32_bf16(Bt[n][k], At[m][k], acc[ai][bj][m][n], 0, 0, 0); } \
    __builtin_amdgcn_s_setprio(0); \
    if (FP8 && PIN8) { asm volatile("" :: "v"(acc[ai][bj][0][0]), "v"(acc[ai][bj][0][1]), "v"(acc[ai][bj][1][0]), "v"(acc[ai][bj][1][1]), "v"(acc[ai][bj][2][0]), "v"(acc[ai][bj][2][1]), "v"(acc[ai][bj][3][0]), "v"(acc[ai][bj][3][1])); \
               __builtin_amdgcn_sched_barrier(0); } } while (0)
#define WAIT_V(n) asm volatile("s_waitcnt vmcnt(" #n ")" ::: "memory")
#define WAIT_L(n) asm volatile("s_waitcnt lgkmcnt(" #n ")" ::: "memory")
#define BAR __builtin_amdgcn_s_barrier()
#define SCHED __builtin_amdgcn_sched_barrier(0)
#pragma unroll
    for (int a = 0; a < 2; ++a)
#pragma unroll
        for (int b = 0; b < 2; ++b)
#pragma unroll
            for (int m = 0; m < 4; ++m)
#pragma unroll
                for (int n = 0; n < 2; ++n) acc[a][b][m][n] = (f32x4){0.f, 0.f, 0.f, 0.f};
    bf16x8 At[4][2], B0[2][2], B1[2][2];
    v8i_t At8[4], B08[2], B18[2];
    int sc_y = YSCALE * 0x01010101; if (FP8) asm volatile("" : "+v"(sc_y));
    const int sc_x = sc_y;
    int nt = K / 64; if (FP8) asm volatile("" : "+s"(nt));
    STGB(0, 0, 0); STGA(0, 0, 0); STGB(0, 1, 0); STGA(0, 1, 0);
    if constexpr (FP8 && MERGE) { STGB(1, 0, 1); STGA(1, 0, 1); STGB(1, 1, 1); WAIT_V(6); BAR; if (wr == 1) BAR; }
    else {
    if (wr == 1) BAR;
    WAIT_V(4); BAR;
    STGB(1, 0, 1); STGA(1, 0, 1); STGB(1, 1, 1);
    WAIT_V(6); BAR;
    }
    if constexpr (FP8 && MERGE) {
#pragma unroll 1
    for (int t = 0; t < nt - 2; t += 2) {
        LDB(B0, 0, 0); LDB(B1, 0, 1); SCHED; LDA(At, 0, 0); SCHED; STGA(1, 1, t + 1);
        WAIT_L(0); BAR; MMA(0, 0, At, B0); MMA(0, 1, At, B1); BAR; SCHED;
        LDA(At, 0, 1); SCHED; STGB(0, 0, t + 2); STGA(0, 0, t + 2); STGB(0, 1, t + 2);
        WAIT_V(6); WAIT_L(0); BAR; MMA(1, 0, At, B0); MMA(1, 1, At, B1); BAR; SCHED;
        LDB(B0, 1, 0); LDB(B1, 1, 1); SCHED; LDA(At, 1, 0); SCHED; STGA(0, 1, t + 2);
        WAIT_L(0); BAR; MMA(0, 0, At, B0); MMA(0, 1, At, B1); BAR; SCHED;
        LDA(At, 1, 1); SCHED; STGB(1, 0, t + 3); STGA(1, 0, t + 3); STGB(1, 1, t + 3);
        WAIT_V(6); WAIT_L(0); BAR; MMA(1, 0, At, B0); MMA(1, 1, At, B1); BAR; SCHED;
    }
    { LDB(B0, 0, 0); LDB(B1, 0, 1); SCHED; LDA(At, 0, 0); SCHED; STGA(1, 1, nt - 1);
      WAIT_L(0); BAR; MMA(0, 0, At, B0); MMA(0, 1, At, B1); BAR; SCHED;
      LDA(At, 0, 1); WAIT_V(0); WAIT_L(0); BAR; MMA(1, 0, At, B0); MMA(1, 1, At, B1); BAR; SCHED; }
    { LDB(B0, 1, 0); LDB(B1, 1, 1); SCHED; LDA(At, 1, 0);
      WAIT_L(0); BAR; MMA(0, 0, At, B0); MMA(0, 1, At, B1); BAR; SCHED;
      LDA(At, 1, 1); WAIT_L(0); BAR; MMA(1, 0, At, B0); MMA(1, 1, At, B1); BAR; }
    } else {
#pragma unroll 1
    for (int t = 0; t < nt - 2; t += 2) {
        LDB(B0, 0, 0); SCHED; LDA(At, 0, 0); STGA(1, 1, t + 1);
        WAIT_L(8); BAR; WAIT_L(0); MMA(0, 0, At, B0); BAR; SCHED;
        LDB(B1, 0, 1); STGB(0, 0, t + 2);
        BAR; WAIT_L(0); MMA(0, 1, At, B1); BAR;
        LDA(At, 0, 1); STGA(0, 0, t + 2);
        BAR; WAIT_L(0); MMA(1, 0, At, B0); BAR; SCHED;
        STGB(0, 1, t + 2);
        WAIT_V(6); BAR; MMA(1, 1, At, B1); BAR;
        LDB(B0, 1, 0); SCHED; LDA(At, 1, 0); STGA(0, 1, t + 2);
        WAIT_L(8); BAR; WAIT_L(0); MMA(0, 0, At, B0); BAR; SCHED;
        LDB(B1, 1, 1); STGB(1, 0, t + 3);
        BAR; WAIT_L(0); MMA(0, 1, At, B1); BAR;
        LDA(At, 1, 1); STGA(1, 0, t + 3);
        BAR; WAIT_L(0); MMA(1, 0, At, B0); BAR; SCHED;
        STGB(1, 1, t + 3);
        WAIT_V(6); BAR; MMA(1, 1, At, B1); BAR;
    }
    { LDB(B0, 0, 0); WAIT_V(0); LDA(At, 0, 0); STGA(1, 1, nt - 1);
      BAR; WAIT_L(0); MMA(0, 0, At, B0); BAR;
      LDB(B1, 0, 1); BAR; WAIT_L(0); MMA(0, 1, At, B1); BAR;
      LDA(At, 0, 1); WAIT_V(4); BAR; WAIT_L(0); MMA(1, 0, At, B0); MMA(1, 1, At, B1); BAR; }
    { LDB(B0, 1, 0); LDA(At, 1, 0); WAIT_V(2); BAR; WAIT_L(0); MMA(0, 0, At, B0); BAR;
      LDB(B1, 1, 1); WAIT_V(0); BAR; WAIT_L(0); MMA(0, 1, At, B1); BAR;
      LDA(At, 1, 1); BAR; WAIT_L(0); MMA(1, 0, At, B0); MMA(1, 1, At, B1); BAR; }
    }
    if (wr == 0) BAR;
#undef SA
#undef SB
#undef STG
#undef STGA
#undef STGB
#undef LDA
#undef LDB
#undef MMA
#undef LD8
}
}

struct LaneC { int wr, wc, fr, fq; };
DI LaneC lane_coords() { int tid = threadIdx.x; asm volatile("" : "+v"(tid)); const int wid = tid >> 6, lane = tid & 63; return LaneC{wid >> 2, wid & 3, lane & 15, lane >> 4}; }
#define EPI_R(ai, m) ((ai) * 128 + L.wr * 64 + (m) * 16 + L.fr)
#define EPI_S(bj, n) ((bj) * 128 + L.wc * 32 + (n) * 16 + 4 * L.fq)
DI void st_bf4(bf16_t* p, f32x4 v) { u32x2 w; w.x = cvt_pk(v[0], v[1]); w.y = cvt_pk(v[2], v[3]); *(u32x2*)p = w; }
DI unsigned pk4_fp8(float a, float b, float c, float d) { int w = __builtin_amdgcn_cvt_pk_fp8_f32(a, b, 0, false); w = __builtin_amdgcn_cvt_pk_fp8_f32(c, d, w, true); return (unsigned)w; }
DI unsigned pk4_fp8o(float a, float b, float c, float d) { int w = __builtin_amdgcn_cvt_pk_fp8_f32(a, b, (int)__float_as_uint(a), false); w = __builtin_amdgcn_cvt_pk_fp8_f32(c, d, w, true); return (unsigned)w; }
DI void st_fp8x4(unsigned char* p, f32x4 v) { *(unsigned*)p = pk4_fp8(v[0], v[1], v[2], v[3]); }
DI unsigned char fp8_1(float x) { return (unsigned char)(__builtin_amdgcn_cvt_pk_fp8_f32(x, 0.f, 0, false) & 0xff); }
DI const bf16_t* as_h(const unsigned char* p) { return (const bf16_t*)p; }
namespace at {
DI int crow(int r, int hi) { return (r & 3) + 8 * (r >> 2) + 4 * hi; }
template <int OFF> DI s16x4 tr_read(unsigned a) { s16x4 r; asm volatile("ds_read_b64_tr_b16 %0, %1 offset:%2" : "=&v"(r) : "v"(a), "i"(OFF) : "memory"); return r; }
#define AT_PK4(P, BASE, OUT) do { unsigned a0 = cvt_pk(P[BASE + 0], P[BASE + 1]), a1 = cvt_pk(P[BASE + 2], P[BASE + 3]); \
    unsigned b0 = cvt_pk(P[BASE + 4], P[BASE + 5]), b1 = cvt_pk(P[BASE + 6], P[BASE + 7]); \
    auto r0 = __builtin_amdgcn_permlane32_swap(a0, b0, false, false); auto r1 = __builtin_amdgcn_permlane32_swap(a1, b1, false, false); \
    u32x4 w = {r0[0], r1[0], r0[1], r1[1]}; OUT = __builtin_bit_cast(bf16x8, w); } while (0)

template <int DV, int VROW, int D0> DI void pv_one(f32x16& od, unsigned vb, bf16x8 pa0, bf16x8 pa1, bf16x8 pa2, bf16x8 pa3) {
    const s16x4 l0 = tr_read<(0 * 16) * VROW + 64 * D0>(vb), h0 = tr_read<(0 * 16 + 4) * VROW + 64 * D0>(vb);
    const s16x4 l1 = tr_read<(1 * 16) * VROW + 64 * D0>(vb), h1 = tr_read<(1 * 16 + 4) * VROW + 64 * D0>(vb);
    const s16x4 l2 = tr_read<(2 * 16) * VROW + 64 * D0>(vb), h2 = tr_read<(2 * 16 + 4) * VROW + 64 * D0>(vb);
    const s16x4 l3 = tr_read<(3 * 16) * VROW + 64 * D0>(vb), h3 = tr_read<(3 * 16 + 4) * VROW + 64 * D0>(vb);
    asm volatile("s_waitcnt lgkmcnt(0)" ::: "memory"); __builtin_amdgcn_sched_barrier(0);
#define AT_PK(Lo, Hi) (bf16x8){Lo[0], Lo[1], Lo[2], Lo[3], Hi[0], Hi[1], Hi[2], Hi[3]}
    od = __builtin_amdgcn_mfma_f32_32x32x16_bf16(pa0, AT_PK(l0, h0), od, 0, 0, 0);
    od = __builtin_amdgcn_mfma_f32_32x32x16_bf16(pa1, AT_PK(l1, h1), od, 0, 0, 0);
    od = __builtin_amdgcn_mfma_f32_32x32x16_bf16(pa2, AT_PK(l2, h2), od, 0, 0, 0);
    od = __builtin_amdgcn_mfma_f32_32x32x16_bf16(pa3, AT_PK(l3, h3), od, 0, 0, 0);
#undef AT_PK
}

template <int DQK, int DV, class Cfg>
DI void attn_unit(const Cfg& cfg, char* lds, const float* tbl) {
    constexpr int KROW = DQK * 2 + 16, VROW = DV * 2 + 16, KCH = DQK / 8, VCH = DV / 8, NKL = 64 * KCH / NTHR, NVL = 64 * VCH / NTHR, ND = DQK / 16, NO = DV / 32;
    static_assert(64 * KCH % NTHR == 0 && 64 * VCH % NTHR == 0, "staging split");
    const int tid = threadIdx.x, lane = tid & 63, r32 = lane & 31, hi = lane >> 5;
    const int wave = __builtin_amdgcn_readfirstlane(tid >> 6);
    char* Ks = lds; char* Vs = lds + 64 * KROW; float* al = (float*)(lds + 64 * KROW + 64 * VROW) + wave * 64;
    bf16x8 qr[ND];
    { const bf16_t* qp = cfg.qrow(wave, r32) + hi * 8;
#pragma unroll
      for (int d0 = 0; d0 < ND; ++d0) qr[d0] = *reinterpret_cast<const bf16x8*>(qp + d0 * 16); }
    f32x16 o[NO];
#pragma unroll
    for (int d = 0; d < NO; ++d)
#pragma unroll
        for (int r = 0; r < 16; ++r) o[d][r] = 0.f;
    float m_reg = cfg.m0(), l_reg = cfg.l0();
    const float C = cfg.cexp();
    const int NT = cfg.ntiles(), ldk = cfg.ldk(), ldv = cfg.ldv();
    bf16x8 kreg[NKL], vreg[NVL];
    const unsigned vb = (unsigned)(uintptr_t)Vs + (unsigned)((8 * hi + ((lane & 15) >> 2)) * VROW + (16 * ((lane >> 4) & 1) + 4 * (lane & 3)) * 2);
#define AT_LOAD(t) do { const bf16_t* kp = cfg.ktile(t); const bf16_t* vp = cfg.vtile(t); \
    _Pragma("unroll") for (int i = 0; i < NKL; ++i) { const int c = tid + NTHR * i, row = c / KCH, cc = c % KCH; kreg[i] = *reinterpret_cast<const bf16x8*>(kp + (long)row * ldk + cc * 8); } \
    _Pragma("unroll") for (int i = 0; i < NVL; ++i) { const int c = tid + NTHR * i, row = c / VCH, cc = c % VCH; vreg[i] = *reinterpret_cast<const bf16x8*>(vp + (long)row * ldv + cc * 8); } } while (0)
    AT_LOAD(0);
    for (int t = 0; t < NT; ++t) {
        __syncthreads();
#pragma unroll
        for (int i = 0; i < NKL; ++i) { const int c = tid + NTHR * i, row = c / KCH, cc = c % KCH; *reinterpret_cast<bf16x8*>(Ks + row * KROW + cc * 16) = kreg[i]; }
#pragma unroll
        for (int i = 0; i < NVL; ++i) { const int c = tid + NTHR * i, row = c / VCH, cc = c % VCH; *reinterpret_cast<bf16x8*>(Vs + row * VROW + cc * 16) = vreg[i]; }
        __syncthreads();
        if (t + 1 < NT) AT_LOAD(t + 1);
        if (cfg.active(t, wave)) {
            f32x16 p0, p1;
            cfg.init(p0, p1, t, wave, r32, hi, tbl);
#pragma unroll
            for (int d0 = 0; d0 < ND; ++d0) {
                const int cb = (d0 * 16 + hi * 8) * 2;
                const bf16x8 b0 = *reinterpret_cast<const bf16x8*>(Ks + r32 * KROW + cb);
                const bf16x8 b1 = *reinterpret_cast<const bf16x8*>(Ks + (32 + r32) * KROW + cb);
                p0 = __builtin_amdgcn_mfma_f32_32x32x16_bf16(b0, qr[d0], p0, 0, 0, 0);
                p1 = __builtin_amdgcn_mfma_f32_32x32x16_bf16(b1, qr[d0], p1, 0, 0, 0);
            }
            cfg.mask(p0, p1, t, wave, r32, hi, tbl);
            float pmax = p0[0];
#pragma unroll
            for (int r = 1; r < 16; ++r) pmax = fmaxf(pmax, p0[r]);
#pragma unroll
            for (int r = 0; r < 16; ++r) pmax = fmaxf(pmax, p1[r]);
            { auto rr = __builtin_amdgcn_permlane32_swap(__float_as_uint(pmax), __float_as_uint(pmax), false, false);
              pmax = fmaxf(__uint_as_float(rr[0]), __uint_as_float(rr[1])); }
            const float mn = fmaxf(m_reg, pmax);
            const float alpha = __builtin_amdgcn_exp2f((m_reg - mn) * C);
            m_reg = mn;
            const float mnC = -mn * C;
            float ps = 0.f;
#pragma unroll
            for (int r = 0; r < 16; ++r) { p0[r] = __builtin_amdgcn_exp2f(fmaf(p0[r], C, mnC)); ps += p0[r]; }
#pragma unroll
            for (int r = 0; r < 16; ++r) { p1[r] = __builtin_amdgcn_exp2f(fmaf(p1[r], C, mnC)); ps += p1[r]; }
            { auto rr = __builtin_amdgcn_permlane32_swap(__float_as_uint(ps), __float_as_uint(ps), false, false);
              ps = __uint_as_float(rr[0]) + __uint_as_float(rr[1]); }
            l_reg = l_reg * alpha + ps;
            if (__any(alpha < 1.f)) {
                if (hi == 0) al[r32] = alpha;
                asm volatile("s_waitcnt lgkmcnt(0)" ::: "memory");
#pragma unroll
                for (int r = 0; r < 16; ++r) { const float a = al[crow(r, hi)];
#pragma unroll
                    for (int d = 0; d < NO; ++d) o[d][r] *= a; }
            }
            bf16x8 pa0, pa1, pa2, pa3;
            AT_PK4(p0, 0, pa0); AT_PK4(p0, 8, pa1); AT_PK4(p1, 0, pa2); AT_PK4(p1, 8, pa3);
            pv_one<DV, VROW, 0>(o[0], vb, pa0, pa1, pa2, pa3);
            pv_one<DV, VROW, 1>(o[1], vb, pa0, pa1, pa2, pa3);
            if constexpr (NO > 2) { pv_one<DV, VROW, 2>(o[2], vb, pa0, pa1, pa2, pa3); pv_one<DV, VROW, 3>(o[3], vb, pa0, pa1, pa2, pa3); }
        }
    }
#undef AT_LOAD
    if (hi == 0) al[32 + r32] = l_reg;
    asm volatile("s_waitcnt lgkmcnt(0)" ::: "memory");
#pragma unroll
    for (int r = 0; r < 16; ++r) {
        const int orow_ = crow(r, hi);
        const float li = 1.0f / al[32 + orow_];
        bf16_t* op = cfg.orow(wave, orow_);
#pragma unroll
        for (int d = 0; d < NO; ++d) { if (WO_FP8) ((unsigned char*)cfg.O + (op - cfg.O))[d * 32 + r32] = fp8_1(o[d][r] * li * 64.f);
            else op[d * 32 + r32] = (bf16_t)(cvt_pk(o[d][r] * li, 0.f) & 0xffffu); }
    }
    __syncthreads();
}
constexpr int attn_lds_bytes(int dqk, int dv) { return 64 * (dqk * 2 + 16) + 64 * (dv * 2 + 16) + 8 * 64 * 4; }
}
namespace at {
struct MlaGeo { static constexpr int KROW = 384, VROW = 256, KB = 64 * KROW, VB = 64 * VROW; };
template <int D0> DI void mla_pv_issue(unsigned vb, s16x4 (&t)[8]) {
    t[0] = tr_read<(0 * 16) * MlaGeo::VROW>(vb); t[1] = tr_read<(0 * 16 + 4) * MlaGeo::VROW>(vb);
    t[2] = tr_read<(1 * 16) * MlaGeo::VROW>(vb); t[3] = tr_read<(1 * 16 + 4) * MlaGeo::VROW>(vb);
    t[4] = tr_read<(2 * 16) * MlaGeo::VROW>(vb); t[5] = tr_read<(2 * 16 + 4) * MlaGeo::VROW>(vb);
    t[6] = tr_read<(3 * 16) * MlaGeo::VROW>(vb); t[7] = tr_read<(3 * 16 + 4) * MlaGeo::VROW>(vb);
}
DI void mla_pv_mma(f32x16& od, const s16x4 (&t)[8], bf16x8 pa0, bf16x8 pa1, bf16x8 pa2, bf16x8 pa3) {
#define AT_PK(Lo, Hi) (bf16x8){Lo[0], Lo[1], Lo[2], Lo[3], Hi[0], Hi[1], Hi[2], Hi[3]}
    od = __builtin_amdgcn_mfma_f32_32x32x16_bf16(pa0, AT_PK(t[0], t[1]), od, 0, 0, 0);
    od = __builtin_amdgcn_mfma_f32_32x32x16_bf16(pa1, AT_PK(t[2], t[3]), od, 0, 0, 0);
    od = __builtin_amdgcn_mfma_f32_32x32x16_bf16(pa2, AT_PK(t[4], t[5]), od, 0, 0, 0);
    od = __builtin_amdgcn_mfma_f32_32x32x16_bf16(pa3, AT_PK(t[6], t[7]), od, 0, 0, 0);
#undef AT_PK
}
template <int PRB>
DI void mla_attn_unit(const bf16_t* __restrict__ qp0, const bf16_t* __restrict__ kp0, const bf16_t* __restrict__ vp0, bf16_t* __restrict__ op0, const int NT, char* lds) {
    constexpr int KROW = MlaGeo::KROW, VROW = MlaGeo::VROW, KB = MlaGeo::KB, VB = MlaGeo::VB, LDK = 1536, LDV = 1024, LDQ = 1536, LDO = 1024;
    const int tid = threadIdx.x, lane = tid & 63, r32 = lane & 31, hi = lane >> 5;
    const int wave = __builtin_amdgcn_readfirstlane(tid >> 6);
    const bool grpB = wave >= 4;
    char* const Kb = lds; char* const Vb = lds + 3 * KB;
    float* al = (float*)(lds + 3 * KB + 3 * VB) + wave * 64;
    const float C = 0.07216878364870322f * 1.4426950408889634f;
    bf16x8 qr[12];
    { const bf16_t* qp = qp0 + (size_t)(32 * wave + r32) * LDQ + hi * 8;
#pragma unroll
      for (int d0 = 0; d0 < 12; ++d0) qr[d0] = *reinterpret_cast<const bf16x8*>(qp + d0 * 16); }
    f32x16 o[4];
#pragma unroll
    for (int d = 0; d < 4; ++d)
#pragma unroll
        for (int r = 0; r < 16; ++r) o[d][r] = 0.f;
    float m_reg = -1e28f, l_reg = 0.f;
    unsigned kg0, kg1, kg2, vg0, vg1;
    { const int pa_ = wave * 64 + lane, pb_ = pa_ + 512, pc_ = pa_ + 1024;
      const int ra = pa_ / 24, sa = pa_ % 24, rb = pb_ / 24, sb = pb_ % 24, rc = pc_ / 24, sc_ = pc_ % 24;
      kg0 = (unsigned)(ra * LDK * 2 + ((sa & ~7) | ((sa & 7) ^ ((ra >> 1) & 7))) * 16);
      kg1 = (unsigned)(rb * LDK * 2 + ((sb & ~7) | ((sb & 7) ^ ((rb >> 1) & 7))) * 16);
      kg2 = (unsigned)(rc * LDK * 2 + ((sc_ & ~7) | ((sc_ & 7) ^ ((rc >> 1) & 7))) * 16);
      const int va = pa_ / 16, wa = pa_ % 16, vb2 = pb_ / 16, wb = pb_ % 16;
      vg0 = (unsigned)(va * LDV * 2 + (wa ^ ((va & 3) << 2)) * 16);
      vg1 = (unsigned)(vb2 * LDV * 2 + (wb ^ ((vb2 & 3) << 2)) * 16); }
    const int wdst = wave * 1024;
    int kx[4];
#pragma unroll
    for (int d = 0; d < 4; ++d) kx[d] = r32 * KROW + (((2 * d + hi) ^ ((r32 >> 1) & 7)) * 16);
    unsigned vx[4];
    { const int q = (lane & 15) >> 2;
#pragma unroll
      for (int d = 0; d < 4; ++d) vx[d] = (unsigned)((8 * hi + q) * VROW + 64 * (d ^ q) + 32 * ((lane >> 4) & 1) + 8 * (lane & 3)); }
#define MLA_STAGE(t) do { const int t_ = (t); if (PRB == 2) break; \
    if (t_ < NT) { const char* kb_ = (const char*)kp0 + (size_t)t_ * (64 * LDK * 2); char* kd_ = Kb + (t_ % 3) * KB + wdst; \
        __builtin_amdgcn_global_load_lds((const unsigned*)(kb_ + kg0), (unsigned*)(kd_), 16, 0, 0); \
        __builtin_amdgcn_global_load_lds((const unsigned*)(kb_ + kg1), (unsigned*)(kd_ + 8192), 16, 0, 0); \
        __builtin_amdgcn_global_load_lds((const unsigned*)(kb_ + kg2), (unsigned*)(kd_ + 16384), 16, 0, 0); } \
    if (t_ >= 1) { const char* vb_ = (const char*)vp0 + (size_t)(t_ - 1) * (64 * LDV * 2); char* vd_ = Vb + ((t_ - 1) % 3) * VB + wdst; \
        __builtin_amdgcn_global_load_lds((const unsigned*)(vb_ + vg0), (unsigned*)(vd_), 16, 0, 0); \
        __builtin_amdgcn_global_load_lds((const unsigned*)(vb_ + vg1), (unsigned*)(vd_ + 8192), 16, 0, 0); } } while (0)
#define MLA_BAR(nyoung) do { const int ny_ = (nyoung); if (ny_ >= 5) asm volatile("s_waitcnt vmcnt(5)" ::: "memory"); else if (ny_ >= 2) asm volatile("s_waitcnt vmcnt(2)" ::: "memory"); \
    else asm volatile("s_waitcnt vmcnt(0)" ::: "memory"); \
    asm volatile("s_waitcnt lgkmcnt(0)" ::: "memory"); __builtin_amdgcn_s_barrier(); asm volatile("" ::: "memory"); } while (0)
#define MLA_NY(j_) ((j_) + 2 < NT ? 5 : ((j_) + 2 == NT ? 2 : 0))
#define MLA_PVALL(VBUF) do { const unsigned v0_ = (unsigned)(uintptr_t)(VBUF); s16x4 ta[8], tb[8]; \
    mla_pv_issue<0>(v0_ + vx[0], ta); mla_pv_issue<1>(v0_ + vx[1], tb); \
    asm volatile("s_waitcnt lgkmcnt(8)" ::: "memory"); __builtin_amdgcn_sched_barrier(0); \
    mla_pv_mma(o[0], ta, pa0, pa1, pa2, pa3); __builtin_amdgcn_sched_barrier(0); \
    mla_pv_issue<2>(v0_ + vx[2], ta); \
    asm volatile("s_waitcnt lgkmcnt(8)" ::: "memory"); __builtin_amdgcn_sched_barrier(0); \
    mla_pv_mma(o[1], tb, pa0, pa1, pa2, pa3); __builtin_amdgcn_sched_barrier(0); \
    mla_pv_issue<3>(v0_ + vx[3], tb); \
    asm volatile("s_waitcnt lgkmcnt(8)" ::: "memory"); __builtin_amdgcn_sched_barrier(0); \
    mla_pv_mma(o[2], ta, pa0, pa1, pa2, pa3); \
    asm volatile("s_waitcnt lgkmcnt(0)" ::: "memory"); __builtin_amdgcn_sched_barrier(0); \
    mla_pv_mma(o[3], tb, pa0, pa1, pa2, pa3); } while (0)
    f32x16 p0, p1; bf16x8 pa0, pa1, pa2, pa3;
    MLA_STAGE(0); MLA_STAGE(1);
    MLA_BAR(0);
    if (grpB) { MLA_STAGE(2); MLA_BAR(NT > 2 ? 5 : 2); }
    for (int j = 0; j < NT; ++j) {
        {
            const char* Ks = Kb + (j % 3) * KB;
            const unsigned v0_ = (unsigned)(uintptr_t)(Vb + ((j + 2) % 3) * VB);
            s16x4 ta[8], tb[8];
#pragma unroll
            for (int r = 0; r < 16; ++r) { p0[r] = 0.f; p1[r] = 0.f; }
            bf16x8 f0[12], f1[12];
#pragma unroll
            for (int d = 0; d < 3; ++d) { f0[d] = *reinterpret_cast<const bf16x8*>(Ks + kx[d & 3] + 128 * (d >> 2)); f1[d] = *reinterpret_cast<const bf16x8*>(Ks + kx[d & 3] + 128 * (d >> 2) + 32 * KROW); }
            __builtin_amdgcn_sched_barrier(0);
            if (!grpB && j + 2 <= NT) MLA_STAGE(j + 2);
            __builtin_amdgcn_sched_barrier(0);
#pragma unroll
            for (int d0 = 0; d0 < 12; ++d0) {
                if (d0 + 3 < 12) { f0[d0 + 3] = *reinterpret_cast<const bf16x8*>(Ks + kx[(d0 + 3) & 3] + 128 * ((d0 + 3) >> 2)); f1[d0 + 3] = *reinterpret_cast<const bf16x8*>(Ks + kx[(d0 + 3) & 3] + 128 * ((d0 + 3) >> 2) + 32 * KROW); }
                if (d0 == 9 && j > 0 && PRB != 4) { mla_pv_issue<0>(v0_ + vx[0], ta); mla_pv_issue<1>(v0_ + vx[1], tb); }
                if (PRB != 3 || d0 == 0) { p0 = __builtin_amdgcn_mfma_f32_32x32x16_bf16(f0[d0], qr[d0], p0, 0, 0, 0);
                p1 = __builtin_amdgcn_mfma_f32_32x32x16_bf16(f1[d0], qr[d0], p1, 0, 0, 0); }
                __builtin_amdgcn_sched_barrier(0);
            }
            if (j > 0 && PRB != 4) {
                asm volatile("s_waitcnt lgkmcnt(8)" ::: "memory"); __builtin_amdgcn_sched_barrier(0);
                mla_pv_mma(o[0], ta, pa0, pa1, pa2, pa3); __builtin_amdgcn_sched_barrier(0);
                mla_pv_issue<2>(v0_ + vx[2], ta);
                asm volatile("s_waitcnt lgkmcnt(8)" ::: "memory"); __builtin_amdgcn_sched_barrier(0);
                mla_pv_mma(o[1], tb, pa0, pa1, pa2, pa3); __builtin_amdgcn_sched_barrier(0);
                mla_pv_issue<3>(v0_ + vx[3], tb);
                asm volatile("s_waitcnt lgkmcnt(8)" ::: "memory"); __builtin_amdgcn_sched_barrier(0);
                mla_pv_mma(o[2], ta, pa0, pa1, pa2, pa3);
                asm volatile("s_waitcnt lgkmcnt(0)" ::: "memory"); __builtin_amdgcn_sched_barrier(0);
                mla_pv_mma(o[3], tb, pa0, pa1, pa2, pa3);
            }
        }
        MLA_BAR(MLA_NY(j));
        if (grpB && j + 3 <= NT) MLA_STAGE(j + 3);
        {
            float pmax = p0[0];
#pragma unroll
            for (int r = 1; r < 16; ++r) pmax = fmaxf(pmax, p0[r]);
#pragma unroll
            for (int r = 0; r < 16; ++r) pmax = fmaxf(pmax, p1[r]);
            { auto rr = __builtin_amdgcn_permlane32_swap(__float_as_uint(pmax), __float_as_uint(pmax), false, false);
              pmax = fmaxf(__uint_as_float(rr[0]), __uint_as_float(rr[1])); }
            const float mn = fmaxf(m_reg, pmax);
            const float alpha = __builtin_amdgcn_exp2f((m_reg - mn) * C);
            m_reg = mn;
            const float mnC = -mn * C;
            float ps = 0.f;
#pragma unroll
            for (int r = 0; r < 16; ++r) { p0[r] = PRB == 1 ? fmaf(p0[r], C, mnC) : __builtin_amdgcn_exp2f(fmaf(p0[r], C, mnC)); ps += p0[r]; }
#pragma unroll
            for (int r = 0; r < 16; ++r) { p1[r] = PRB == 1 ? fmaf(p1[r], C, mnC) : __builtin_amdgcn_exp2f(fmaf(p1[r], C, mnC)); ps += p1[r]; }
            { auto rr = __builtin_amdgcn_permlane32_swap(__float_as_uint(ps), __float_as_uint(ps), false, false);
              ps = __uint_as_float(rr[0]) + __uint_as_float(rr[1]); }
            l_reg = l_reg * alpha + ps;
            if (__any(alpha < 1.f)) {
                if (hi == 0) al[r32] = alpha;
                asm volatile("s_waitcnt lgkmcnt(0)" ::: "memory");
#pragma unroll
                for (int r = 0; r < 16; ++r) { const float a_ = al[crow(r, hi)];
#pragma unroll
                    for (int d = 0; d < 4; ++d) o[d][r] *= a_; }
            }
            AT_PK4(p0, 0, pa0); AT_PK4(p0, 8, pa1); AT_PK4(p1, 0, pa2); AT_PK4(p1, 8, pa3);
        }
        MLA_BAR(MLA_NY(j));
    }
    MLA_PVALL(Vb + ((NT - 1) % 3) * VB);
    if (!grpB) MLA_BAR(0);
    if (hi == 0) al[32 + r32] = l_reg;
    asm volatile("s_waitcnt lgkmcnt(0)" ::: "memory");
#pragma unroll
    for (int r = 0; r < 16; ++r) {
        const int orow_ = crow(r, hi);
        const float li = 1.0f / al[32 + orow_];
        bf16_t* op = op0 + (size_t)(32 * wave + orow_) * LDO;
#pragma unroll
        for (int d = 0; d < 4; ++d) op[d * 32 + r32] = (bf16_t)(cvt_pk(o[d][r] * li, 0.f) & 0xffffu);
    }
    __syncthreads();
#undef MLA_STAGE
#undef MLA_BAR
#undef MLA_NY
#undef MLA_PVALL
}
}
namespace at {
typedef int v8i __attribute__((ext_vector_type(8)));
DI f32x16 mfma8(v8i a, v8i b, f32x16 c, int sa, int sb) { return __builtin_amdgcn_mfma_scale_f32_32x32x64_f8f6f4(a, b, c, 0, 0, 0, sa, 0, sb); }
DI v8i ld_frag(const char* p0, const char* p1) { const u32x4 a = *(const u32x4*)p0, b = *(const u32x4*)p1; return (v8i){(int)a.x, (int)a.y, (int)a.z, (int)a.w, (int)b.x, (int)b.y, (int)b.z, (int)b.w}; }
template <int PRB>
DI void mla_attn_unit_fp8(const unsigned char* __restrict__ qp0, const unsigned char* __restrict__ kp0, const unsigned char* __restrict__ vp0, bf16_t* __restrict__ op0, const int NT, char* lds) {
    constexpr int KB8 = 64 * 256, VB8 = 128 * 64, LDK = 1536, LDO = 1024;
    int tid = threadIdx.x; asm volatile("" : "+v"(tid));
    const int lane = tid & 63, r32 = lane & 31, hi = lane >> 5;
    const int wave = __builtin_amdgcn_readfirstlane(tid >> 6);
    const bool grpB = wave >= 4;
    char* const Kb = lds; char* const Vb = lds + 3 * KB8;
    float* al = (float*)(lds + 3 * KB8 + 3 * VB8) + wave * 64;
    const float C = 0.07216878364870322f * 1.4426950408889634f;
    v8i qf[3];
    { const unsigned char* qp = qp0 + (size_t)(32 * wave + r32) * LDK + 32 * hi;
#pragma unroll
      for (int c = 0; c < 3; ++c) qf[c] = ld_frag((const char*)qp + 64 * c, (const char*)qp + 64 * c + 16); }
    f32x16 o[4];
#pragma unroll
    for (int d = 0; d < 4; ++d)
#pragma unroll
        for (int r = 0; r < 16; ++r) o[d][r] = 0.f;
    float m_reg = -1e28f, l_reg = 0.f;
    int s1 = 0x7f7f7f7f; asm volatile("" : "+v"(s1)); const int sp = s1 & 0x7b7b7b7b;
    unsigned kg0, kg1, vg0;
    { const int pa_ = wave * 64 + lane, pb_ = pa_ + 512;
      const int ra = pa_ >> 4, qa = (pa_ & 15) ^ (2 * (ra & 7) + ((ra >> 3) & 1)), rb = pb_ >> 4, qb = (pb_ & 15) ^ (2 * (rb & 7) + ((rb >> 3) & 1));
      kg0 = (unsigned)(ra * LDK + (qa < 12 ? qa * 16 : 0)); kg1 = (unsigned)(rb * LDK + (qb < 12 ? qb * 16 : 0));
      const int vr = pa_ >> 2, vq = (pa_ & 3) ^ (2 * ((vr >> 2) & 1) + ((vr >> 3) & 1));
      vg0 = (unsigned)((size_t)vr * T + vq * 16); }
    const int wdst = wave * 1024;
    const int hs = (r32 >> 3) & 1, hdl = 16 - 32 * hs;
    int kxa[3];
#pragma unroll
    for (int c = 0; c < 3; ++c) kxa[c] = r32 * 256 + (((2 * c + hi) ^ (r32 & 7)) * 32) + 16 * hs;
    const int vxa = r32 * 64 + ((hi ^ ((r32 >> 2) & 1)) * 32) + 16 * hs;
#define M8_STAGE(t) do { const int t_ = (t); \
    if (t_ < NT) { const char* kb_ = (const char*)kp0 + (size_t)t_ * (64 * LDK); char* kd_ = Kb + (t_ % 3) * KB8 + wdst; \
        __builtin_amdgcn_global_load_lds((const unsigned*)(kb_ + kg0), (unsigned*)(kd_), 16, 0, 0); \
        __builtin_amdgcn_global_load_lds((const unsigned*)(kb_ + kg1), (unsigned*)(kd_ + 8192), 16, 0, 0); } \
    if (t_ >= 1) { const char* vb_ = (const char*)vp0 + (size_t)(t_ - 1) * 64; \
        __builtin_amdgcn_global_load_lds((const unsigned*)(vb_ + vg0), (unsigned*)(Vb + ((t_ - 1) % 3) * VB8 + wdst), 16, 0, 0); } } while (0)
#define M8_BAR(ny) do { const int ny_ = (ny); if (ny_ >= 3) asm volatile("s_waitcnt vmcnt(3)" ::: "memory"); else if (ny_ >= 1) asm volatile("s_waitcnt vmcnt(1)" ::: "memory"); \
    else asm volatile("s_waitcnt vmcnt(0)" ::: "memory"); \
    asm volatile("s_waitcnt lgkmcnt(0)" ::: "memory"); __builtin_amdgcn_s_barrier(); asm volatile("" ::: "memory"); } while (0)
#define M8_NY(j_) ((j_) + 2 < NT ? 3 : ((j_) + 2 == NT ? 1 : 0))
    f32x16 p0, p1; v8i pf;
#define M8_MMA(acc, a, b, sa, sb) do { if constexpr ((PRB & 2) != 0) asm volatile("" :: "v"(a), "v"(b)); else acc = mfma8(a, b, acc, sa, sb); } while (0)
#define M8_SB() __builtin_amdgcn_sched_barrier(0)
#define M8_KF(c, kb) ((PRB & 4) ? qf[c] : ld_frag(Ks + kxa[c] + (kb) * 32 * 256, Ks + kxa[c] + hdl + (kb) * 32 * 256))
#define M8_VF(d) ((PRB & 4) ? qf[(d) % 3] : ld_frag(Vs + vxa + (d) * 2048, Vs + vxa + hdl + (d) * 2048))
#define M8_X(jj, QK, PV) do { const int j_ = (jj); const char* Ks = Kb + (j_ % 3) * KB8; const char* Vs = Vb + ((j_ + 2) % 3) * VB8; \
        v8i fa, fb, fc, fd; \
        if (QK) { fa = M8_KF(0, 0); fb = M8_KF(0, 1); fc = M8_KF(1, 0); fd = M8_KF(1, 1); } \
        M8_SB(); if (!grpB && j_ + 2 <= NT) M8_STAGE(j_ + 2); M8_SB(); \
        if (QK) { \
            _Pragma("unroll") for (int r = 0; r < 16; ++r) { p0[r] = 0.f; p1[r] = 0.f; } \
            M8_MMA(p0, fa, qf[0], s1, s1); M8_MMA(p1, fb, qf[0], s1, s1); M8_SB(); \
            fa = M8_KF(2, 0); fb = M8_KF(2, 1); M8_SB(); \
            M8_MMA(p0, fc, qf[1], s1, s1); M8_MMA(p1, fd, qf[1], s1, s1); M8_SB(); \
            if (PV) { fc = M8_VF(0); fd = M8_VF(1); } M8_SB(); \
            M8_MMA(p0, fa, qf[2], s1, s1); M8_MMA(p1, fb, qf[2], s1, s1); M8_SB(); \
        } else { fc = M8_VF(0); fd = M8_VF(1); } \
        if (PV) { fa = M8_VF(2); fb = M8_VF(3); M8_SB(); \
            M8_MMA(o[0], pf, fc, sp, s1); M8_MMA(o[1], pf, fd, sp, s1); M8_SB();     \
            M8_MMA(o[2], pf, fa, sp, s1); M8_MMA(o[3], pf, fb, sp, s1); } } while (0)
    bool pend = false;
#define M8_Y(jj) do { const int j_ = (jj); if (grpB && j_ + 3 <= NT) M8_STAGE(j_ + 3); \
        if constexpr ((PRB & 8) == 0) { \
            float pmax = p0[0]; \
            _Pragma("unroll") for (int r = 1; r < 16; ++r) pmax = fmaxf(pmax, p0[r]); \
            _Pragma("unroll") for (int r = 0; r < 16; ++r) pmax = fmaxf(pmax, p1[r]); \
            { auto rr = __builtin_amdgcn_permlane32_swap(__float_as_uint(pmax), __float_as_uint(pmax), false, false); \
              pmax = fmaxf(__uint_as_float(rr[0]), __uint_as_float(rr[1])); } \
            if (__any(pmax - m_reg > 3.0f / 0.07216878364870322f)) { \
                const float mn = fmaxf(m_reg, pmax); \
                const float alpha = __builtin_amdgcn_exp2f((m_reg - mn) * C); \
                m_reg = mn; l_reg *= alpha; \
                if (hi == 0) al[r32] = alpha; \
                pend = true; \
            } \
            const float mnC = 4.0f - m_reg * C;                     \
            float ps = 0.f; \
            _Pragma("unroll") for (int r = 0; r < 16; ++r) { p0[r] = (PRB & 1) ? fmaf(p0[r], C, mnC) : __builtin_amdgcn_exp2f((PRB & 32) ? p0[r] : fmaf(p0[r], C, mnC)); if (!(PRB & 16)) ps += p0[r]; } \
            _Pragma("unroll") for (int r = 0; r < 16; ++r) { p1[r] = (PRB & 1) ? fmaf(p1[r], C, mnC) : __builtin_amdgcn_exp2f((PRB & 32) ? p1[r] : fmaf(p1[r], C, mnC)); if (!(PRB & 16)) ps += p1[r]; } \
            { auto rr = __builtin_amdgcn_permlane32_swap(__float_as_uint(ps), __float_as_uint(ps), false, false); \
              ps = __uint_as_float(rr[0]) + __uint_as_float(rr[1]); } \
            l_reg += ps * (1.0f / 16.0f); \
              \
            _Pragma("unroll") for (int a = 0; a < 4; ++a) { \
                const unsigned w0 = pk4_fp8o(p0[4 * a], p0[4 * a + 1], p0[4 * a + 2], p0[4 * a + 3]), w1 = pk4_fp8o(p1[4 * a], p1[4 * a + 1], p1[4 * a + 2], p1[4 * a + 3]); \
                auto rr = __builtin_amdgcn_permlane32_swap(w0, w1, false, false); \
                pf[2 * a] = (int)rr[0]; pf[2 * a + 1] = (int)rr[1]; \
            } \
        } } while (0)
    M8_STAGE(0); M8_STAGE(1);
    M8_BAR(0);
    if (grpB) { M8_STAGE(2); M8_BAR(NT > 2 ? 3 : 1); }
    M8_X(0, true, false); M8_BAR(M8_NY(0)); M8_Y(0); M8_BAR(M8_NY(0));
    int j = 1;
    for (;;) {
        if (pend) {
            pend = false;
#pragma unroll
            for (int r = 0; r < 16; ++r) { const float a_ = al[crow(r, hi)];
#pragma unroll
                for (int d = 0; d < 4; ++d) o[d][r] *= a_; }
        }
#pragma unroll 1
        for (; j < NT; ++j) {
            M8_X(j, true, true); M8_BAR(M8_NY(j)); M8_Y(j); M8_BAR(M8_NY(j));
            if (pend) { ++j; break; }
        }
        if (!pend) break;
    }
    M8_X(NT, false, true);
#undef M8_KF
#undef M8_VF
#undef M8_X
#undef M8_Y
#undef M8_SB
    if (!grpB) M8_BAR(0);
    if (hi == 0) al[32 + r32] = l_reg;
    asm volatile("s_waitcnt lgkmcnt(0)" ::: "memory");
#pragma unroll
    for (int r = 0; r < 16; ++r) {
        const int orow_ = crow(r, hi);
        const float li = 1.0f / al[32 + orow_];
        bf16_t* op = op0 + (size_t)(32 * wave + orow_) * LDO;
#pragma unroll
        for (int d = 0; d < 4; ++d) { if (WO_FP8) ((unsigned char*)op0)[(size_t)(32 * wave + orow_) * LDO + d * 32 + r32] = fp8_1(o[d][r] * li * 64.f); else op[d * 32 + r32] = (bf16_t)(cvt_pk(o[d][r] * li, 0.f) & 0xffffu); }
    }
    __syncthreads();
#undef M8_STAGE
#undef M8_BAR
#undef M8_NY
#undef M8_MMA
}
}
struct Params { const float* in[31]; float* out; unsigned char* ws; int ph_lo, ph_hi; };
enum { I_X = 0, I_C, I_CTX, I_CCTX, I_MODW, I_MODB, I_N1G, I_N2G, I_DQ, I_GQ, I_UQ, I_DKV, I_GKV, I_UKV, I_MWO, I_FWO, I_FBO, I_NQKV, I_RPB, I_NWO,
       I_SQKV, I_SINK, I_SWO, I_WGRP, I_BGRP, I_WRT, I_BRT, I_WGATE, I_WUP, I_WDOWN, I_FG };
struct Frame {
    const float* const __attribute__((address_space(4)))* in;
    float* out; unsigned char* ws; char* lds;
    int tid, lane, wave, G, vcu;
    DI bf16_t* wt(size_t el) const { return (bf16_t*)(ws + WS_WT) + el; }
    DI bf16_t* scr(size_t byte) const { return (bf16_t*)(ws + WS_SCR + byte); }
    DI float* moda(int layer, int v, int which) const { return (float*)(ws + WS_MODA) + ((size_t)(layer * 3 + v) * 2 + which) * 1024; }
    DI float* modv(int layer, int v, int part) const { return (float*)(ws + WS_MODV) + ((size_t)(layer * 3 + v) * 6 + part) * 1024; }
};
DI int row_batch(int row) { return row >= TB ? 1 : 0; }
DI int row_modv(int row) { const int b = row_batch(row), rr = row - b * TB; return rr < NCTX ? 0 : 1 + b; }
DI int tile_modv(int pm) { const int b = pm / 65; return (pm % 65 == 0) ? 0 : 1 + b; }
DI int swap45(int c) { return ((c & 16) << 1) | ((c & 32) >> 1) | (c & 15); }

DI int dst_row(int kind, int n) {
    if (kind == 1) return n < 256 ? n : 256 + swap45(n - 256);
    if (kind == 2) { const int h = n / 192, c = n - h * 192; return c < 128 ? n : h * 192 + 128 + swap45(c - 128); }
    if (kind == 3) return n < 1280 ? (n & ~63) + swap45(n & 63) : n;
    return n;
}
DI void cvt_tile(const Frame& F, const float* __restrict__ src, int N, bf16_t* __restrict__ dst, int ldd, int k0, int n0, int kind, const float* __restrict__ kscale, bool f8) {
    float* tl = (float*)F.lds;
    const int tid = F.tid;
    { const int kr = tid >> 3, c8 = (tid & 7) * 8;
      const float sc = kscale ? kscale[k0 + kr] : 1.0f;
      const f32x4 a = *(const f32x4*)(src + (size_t)(k0 + kr) * N + n0 + c8), b = *(const f32x4*)(src + (size_t)(k0 + kr) * N + n0 + c8 + 4);
#pragma unroll
      for (int j = 0; j < 4; ++j) { tl[kr * 65 + c8 + j] = a[j] * sc; tl[kr * 65 + c8 + 4 + j] = b[j] * sc; } }
    __syncthreads();
    { const int nr = tid >> 3, k8 = (tid & 7) * 8;
      float v[8];
#pragma unroll
      for (int j = 0; j < 8; ++j) v[j] = tl[(k8 + j) * 65 + nr];
      if (f8) { u32x2 w; w.x = pk4_fp8(v[0] * 64.f, v[1] * 64.f, v[2] * 64.f, v[3] * 64.f); w.y = pk4_fp8(v[4] * 64.f, v[5] * 64.f, v[6] * 64.f, v[7] * 64.f);
          *(u32x2*)((unsigned char*)dst + (size_t)dst_row(kind, n0 + nr) * ldd + k0 + k8) = w; }
      else { u32x4 w; w.x = cvt_pk(v[0], v[1]); w.y = cvt_pk(v[2], v[3]); w.z = cvt_pk(v[4], v[5]); w.w = cvt_pk(v[6], v[7]);
          *(u32x4*)(dst + (size_t)dst_row(kind, n0 + nr) * ldd + k0 + k8) = w; } }
    __syncthreads();
}
DI void cvt_tile4(const Frame& F, const float* __restrict__ src, int N, unsigned char* __restrict__ dst, int ldd, int k0, int n0) {
    float* tl = (float*)F.lds;
    int tid = threadIdx.x; asm volatile("" : "+v"(tid));
    { const int kr = tid >> 3, c8 = (tid & 7) * 8;
      f32x4 a[4], b[4];
#pragma unroll
      for (int q = 0; q < 4; ++q) { a[q] = __builtin_nontemporal_load((const f32x4*)(src + (size_t)(k0 + kr) * N + n0 + 64 * q + c8)); b[q] = __builtin_nontemporal_load((const f32x4*)(src + (size_t)(k0 + kr) * N + n0 + 64 * q + c8 + 4)); }
#pragma unroll
      for (int q = 0; q < 4; ++q)
#pragma unroll
          for (int j = 0; j < 4; ++j) { tl[q * 4160 + kr * 65 + c8 + j] = a[q][j]; tl[q * 4160 + kr * 65 + c8 + 4 + j] = b[q][j]; } }
    __syncthreads();
    { const int nr = tid >> 3, k8 = (tid & 7) * 8;
#pragma unroll
      for (int q = 0; q < 4; ++q) {
          float v[8];
#pragma unroll
          for (int j = 0; j < 8; ++j) v[j] = tl[q * 4160 + (k8 + j) * 65 + nr] * 64.0f;
          u32x2 w; w.x = pk4_fp8(v[0], v[1], v[2], v[3]); w.y = pk4_fp8(v[4], v[5], v[6], v[7]);
          *(u32x2*)(dst + (size_t)(n0 + 64 * q + nr) * ldd + k0 + k8) = w; } }
    __syncthreads();
}
DI void cvt_moe_range(const Frame& F, int layer, int b0, int b1, int rank, int nr) {
    unsigned char* mw = F.ws + WS_MOEW;
    const float* wg = F.in[I_WGATE] + (size_t)layer * 32 * 1024 * 512;
    const float* wu = F.in[I_WUP] + (size_t)layer * 32 * 1024 * 512;
    const float* wd = F.in[I_WDOWN] + (size_t)layer * 32 * 512 * 1024;
    for (int u = b0 + rank; u < b1; u += nr) {
        const int mat = u / 32, tl = u % 32, which = mat / 32, e = mat % 32;
        if (which < 2) { const int kt = tl / 2, nq = tl % 2;
            cvt_tile4(F, (which ? wu : wg) + (size_t)e * 1024 * 512, 512, mw + (which ? MOEW_U : MOEW_G) + (size_t)e * 512 * 1024, 1024, kt * 64, nq * 256);
        } else { const int kt = tl / 4, nq = tl % 4;
            cvt_tile4(F, wd + (size_t)e * 512 * 1024, 1024, mw + MOEW_D + (size_t)e * 1024 * 512, 512, kt * 64, nq * 256);
        }
    }
}
DI void tail_cvt(const Frame& F, int NU, int layer, int b0, int b1) {
    const int rem = NU % F.G;
    if (rem == 0) { cvt_moe_range(F, layer, b0, b1, F.vcu, F.G); return; }
    if (F.vcu < rem) return;
    cvt_moe_range(F, layer, b0, b1, F.vcu - rem, F.G - rem);
}
struct CvtJob { const float* src; const float* ks; bf16_t* dst; int K, N, ldd, kind; bool f8; };
DI CvtJob cvt_job(const Frame& F, int j) {
    CvtJob J; J.ks = nullptr; J.kind = 0; J.f8 = false;
    switch (j) {
        case 0: J.src = F.in[I_DQ]; J.K = 1024; J.N = 512; J.dst = F.wt(WT_P1); J.ldd = 1024; J.f8 = GEMM_FP8; break;
        case 1: J.src = F.in[I_DKV]; J.K = 1024; J.N = 320; J.dst = GEMM_FP8 ? (bf16_t*)((unsigned char*)F.wt(WT_P1) + (size_t)512 * 1024) : F.wt(WT_P1 + (size_t)512 * 1024); J.ldd = 1024; J.kind = 1; J.f8 = GEMM_FP8; break;
        case 2: J.src = F.in[I_UQ]; J.K = 512; J.N = 1536; J.dst = F.wt(WT_UQ); J.ldd = 512; J.kind = 2; J.ks = F.in[I_GQ]; break;
        case 3: J.src = F.in[I_UKV]; J.K = 256; J.N = 2048; J.dst = F.wt(WT_UKV); J.ldd = 256; J.ks = F.in[I_GKV]; break;
        case 4: J.src = F.in[I_MWO]; J.K = 1024; J.N = 1024; J.dst = F.wt(WT_WO0); J.ldd = 1024; J.f8 = WO_FP8; break;
        case 5: J.src = F.in[I_FWO]; J.K = 1024; J.N = 1024; J.dst = F.wt(WT_WO1); J.ldd = 1024; break;
        case 6: J.src = F.in[I_NQKV]; J.K = 1024; J.N = 3072; J.dst = F.wt(WT_NAQKV); J.ldd = 1024; J.f8 = GEMM_FP8; break;
        case 7: J.src = F.in[I_NWO]; J.K = 1024; J.N = 1024; J.dst = F.wt(WT_WO2); J.ldd = 1024; J.f8 = WO_FP8; break;
        case 8: J.src = F.in[I_SQKV]; J.K = 1024; J.N = 1536; J.dst = F.wt(WT_SWQKV); J.ldd = 1024; J.kind = 3; J.f8 = GEMM_FP8; break;
        default: J.src = F.in[I_SWO]; J.K = 1024; J.N = 1024; J.dst = F.wt(WT_WO3); J.ldd = 1024; J.f8 = WO_FP8; break;
    }
    return J;
}

DI void ph_prologue(const Frame& F) {
    for (int u = F.vcu; u < 256; u += F.G) {
        const int layer = u >> 6, kc = (u >> 2) & 15, nq = u & 3;
        const float* mw = F.in[I_MODW] + ((size_t)layer * 1024 + kc * 64) * 6144 + nq * 1536 + F.tid;
        float acc[3][3];
#pragma unroll
        for (int j = 0; j < 3; ++j) { acc[j][0] = 0.f; acc[j][1] = 0.f; acc[j][2] = 0.f; }
#pragma unroll 8
        for (int k = 0; k < 64; ++k) {
            const int kk = kc * 64 + k;
            const float a0 = silu_f(F.in[I_CCTX][kk]), a1 = silu_f(F.in[I_C][kk]), a2 = silu_f(F.in[I_C][1024 + kk]);
#pragma unroll
            for (int j = 0; j < 3; ++j) { const float w = mw[(size_t)k * 6144 + j * 512]; acc[j][0] += a0 * w; acc[j][1] += a1 * w; acc[j][2] += a2 * w; }
        }
        float* mp = (float*)(F.ws + WS_MODP) + ((size_t)(kc * 4 + layer) * 3) * 6144 + nq * 1536 + F.tid;
#pragma unroll
        for (int j = 0; j < 3; ++j) { mp[j * 512] = acc[j][0]; mp[6144 + j * 512] = acc[j][1]; mp[2 * 6144 + j * 512] = acc[j][2]; }
    }
    {
        const int ntile[10] = {128, 80, 192, 128, 256, 256, 768, 256, 384, 256};
        int total = 0;
#pragma unroll
        for (int j = 0; j < 10; ++j) total += ntile[j];
        for (int u = F.vcu; u < total; u += F.G) {
            int j = 0, rem = u;
#pragma unroll
            for (int q = 0; q < 9; ++q) { if (j == q && rem >= ntile[q]) { rem -= ntile[q]; j = q + 1; } }
            const CvtJob J = cvt_job(F, j);
            const int nn = J.N / 64, kt = rem / nn, nt = rem % nn;
            cvt_tile(F, J.src, J.N, J.dst, J.ldd, kt * 64, nt * 64, J.kind, J.ks, J.f8);
        }
    }
    {
        const int gt = F.vcu * NTHR + F.tid, gs = F.G * NTHR;
        bf16_t* A = F.wt(WT_DFTA); bf16_t* D1 = F.wt(WT_DFT1); bf16_t* D2 = F.wt(WT_DFT2); bf16_t* DC = F.wt(WT_DFTC);
        for (int i = gt; i < 512 * 256; i += gs) {
            const int r = i >> 8, c = i & 255, kc = r & 255, ph = (c * kc) & 255; const float x = (float)ph * (1.0f / 128.0f);
            const float v = (r < 256 ? cospif(x) : -sinpif(x)) * 0.0625f;
            A[i] = (bf16_t)(cvt_pk(v, 0.f) & 0xffffu);
        }
        const float s128 = 0.08838834764831845f;
        for (int i = gt; i < 256 * 256; i += gs) {
            const int r = i >> 8, c = i & 255, kb = r & 127, n1 = c & 127, ph = (kb * n1) & 127; const float x = (float)ph * (1.0f / 64.0f);
            const float cs = cospif(x) * s128, sn = sinpif(x) * s128;
            const float v1 = (r < 128) ? (c < 128 ? cs : sn) : (c < 128 ? -sn : cs);
            D1[i] = (bf16_t)(cvt_pk(v1, 0.f) & 0xffffu);
            const float v2 = (r < 128) ? (c < 128 ? cs : sn) : 0.f;
            D2[i] = (bf16_t)(cvt_pk(v2, 0.f) & 0xffffu);
        }
        for (int i = gt; i < 256 * 512; i += gs) {
            const int r = i >> 9, c = i & 511, n = c & 255, ph = (r * n) & 255; const float x = (float)ph * (1.0f / 128.0f);
            const float v = (c < 256 ? cospif(x) : sinpif(x)) * 0.0625f;
            DC[i] = (bf16_t)(cvt_pk(v, 0.f) & 0xffffu);
        }
        float* rope = (float*)(F.ws + WS_ROPE);
        for (int i = gt; i < 256 * 16; i += gs) {
            const int v = i >> 4, m = i & 15;
            const float inv = powf(10000.0f, -(float)m / 16.0f);
            const float ang = (float)v * inv;
            rope[2 * i] = cosf(ang); rope[2 * i + 1] = sinf(ang);
        }
    }
    {
        for (int i = F.vcu * NTHR + F.tid; i < 4 * 36 * 1024; i += F.G * NTHR) {
            const int layer = i / (36 * 1024), r = i % (36 * 1024), n = r >> 10, k = r & 1023;
            const float w = n < 32 ? F.in[I_WRT][((size_t)layer * 1024 + k) * 32 + n] : F.in[I_WGRP][((size_t)layer * 1024 + k) * 4 + (n - 32)];
            const unsigned hi = cvt_pk(w, 0.f) & 0xffffu; const float lo = w - bflo(hi);
            unsigned char* img = F.ws + WS_RW + (size_t)layer * 2 * RW_HALF + (size_t)n * RW_PITCH + 2 * k;
            *(bf16_t*)img = (bf16_t)hi; *(bf16_t*)(img + RW_HALF) = (bf16_t)(cvt_pk(lo, 0.f) & 0xffffu);
        }
    }
}
DI void ph_modreduce(const Frame& F) {
    for (int i = F.vcu * NTHR + F.tid; i < 4 * 3 * 6144; i += F.G * NTHR) {
        const int layer = i / (3 * 6144), r = i % (3 * 6144), v = r / 6144, n = r % 6144;
        const float* mp = (const float*)(F.ws + WS_MODP) + (size_t)layer * 3 * 6144 + r;
        float s = F.in[I_MODB][layer * 6144 + n];
#pragma unroll
        for (int kc = 0; kc < 16; ++kc) s += mp[(size_t)kc * 4 * 3 * 6144];
        ((float*)(F.ws + WS_MODV))[i] = s;
        const int part = n >> 10, col = n & 1023;
        if (part == 1) F.moda(layer, v, 0)[col] = F.in[I_N1G][layer * D + col] * (1.0f + s);
        if (part == 4) F.moda(layer, v, 1)[col] = F.in[I_N2G][layer * D + col] * (1.0f + s);
    }
}

template <int LAYER>
DI void ph_norm1(const Frame& F, bool dry = false) {
    bf16_t* xres = (bf16_t*)(F.ws + WS_XRES);
    bf16_t* xdst = dry ? (bf16_t*)(F.ws + WS_END) : xres;
    bf16_t* hb = dry ? (bf16_t*)(F.ws + WS_END + (size_t)T * D * 4) : (bf16_t*)(F.ws + WS_H);
    const int* slot = (const int*)(F.ws + WS_SLOT);
    const float* gw = (const float*)(F.ws + WS_GW);
    const bf16_t* yb = F.scr(SM_Y);
    const int c0 = 4 * F.lane;
    const int step = F.G * 8;
    u32x2 nxa[4], nya[4], nyc[4]; float ng0 = 0.f, ng1 = 0.f;
    int ps0 = 0, ps1 = 0; float pg0 = 0.f, pg1 = 0.f;
    auto valid = [&](int r) { return r < T && !(LAYER == 4 && (r - row_batch(r) * TB) < NCTX); };
    auto fetch_sg = [&](int r) { if (LAYER != 0 && valid(r)) { ps0 = slot[2 * r]; ps1 = slot[2 * r + 1]; pg0 = gw[2 * r]; pg1 = gw[2 * r + 1]; } };
    auto issue = [&](int r) { if (LAYER != 0 && valid(r)) { const bf16_t* src = xres + (size_t)r * D; ng0 = pg0; ng1 = pg1;
#pragma unroll
            for (int i = 0; i < 4; ++i) { nxa[i] = *(const u32x2*)(src + c0 + 256 * i); nya[i] = __builtin_nontemporal_load((const u32x2*)(yb + (size_t)ps0 * D + c0 + 256 * i)); nyc[i] = __builtin_nontemporal_load((const u32x2*)(yb + (size_t)ps1 * D + c0 + 256 * i)); } } };
    { const int r0 = F.vcu * 8 + F.wave; fetch_sg(r0); issue(r0); fetch_sg(r0 + step); }
    for (int row = F.vcu * 8 + F.wave; row < T; row += step) {
        const int b = row_batch(row), rr = row - b * TB, v = rr < NCTX ? 0 : 1 + b;
        u32x2 xa[4], ya[4], yc[4]; const float g0 = ng0, g1 = ng1;
        if (LAYER != 0) {
#pragma unroll
            for (int i = 0; i < 4; ++i) { xa[i] = nxa[i]; ya[i] = nya[i]; yc[i] = nyc[i]; }
            issue(row + step); fetch_sg(row + 2 * step);
        }
        if (LAYER == 4 && rr < NCTX) continue;
        f32x4 x[4];
        if (LAYER == 0) {
            const float* src = rr < NCTX ? F.in[I_CTX] + ((size_t)b * NCTX + rr) * D : F.in[I_X] + ((size_t)b * SEQ + (rr - NCTX)) * D;
#pragma unroll
            for (int i = 0; i < 4; ++i) x[i] = *(const f32x4*)(src + c0 + 256 * i);
        } else {
            const float* g2 = F.modv(LAYER - 1, v, 5);
#pragma unroll
            for (int i = 0; i < 4; ++i) {
                const f32x4 gg = *(const f32x4*)(g2 + c0 + 256 * i);
                x[i][0] = bflo(xa[i].x) + gg[0] * (g0 * bflo(ya[i].x) + g1 * bflo(yc[i].x)); x[i][1] = bfhi(xa[i].x) + gg[1] * (g0 * bfhi(ya[i].x) + g1 * bfhi(yc[i].x));
                x[i][2] = bflo(xa[i].y) + gg[2] * (g0 * bflo(ya[i].y) + g1 * bflo(yc[i].y)); x[i][3] = bfhi(xa[i].y) + gg[3] * (g0 * bfhi(ya[i].y) + g1 * bfhi(yc[i].y));
            }
        }
        float ss = 0.f;
#pragma unroll
        for (int i = 0; i < 4; ++i) ss += x[i][0] * x[i][0] + x[i][1] * x[i][1] + x[i][2] * x[i][2] + x[i][3] * x[i][3];
        ss = wave_sum(ss);
        const float rstd = rsqrtf(ss * (1.0f / D) + EPS);
        if (LAYER == 4) {
            float* op = (dry ? (float*)(F.ws + WS_END) : F.out) + ((size_t)b * SEQ + (rr - NCTX)) * D;
#pragma unroll
            for (int i = 0; i < 4; ++i) { const f32x4 g = *(const f32x4*)(F.in[I_FG] + c0 + 256 * i); f32x4 y;
#pragma unroll
                for (int j = 0; j < 4; ++j) y[j] = x[i][j] * rstd * g[j];
#ifdef MLA_CHECK
                { const float* chk = (const float*)(F.ws + WS_CTL + 32768); if (!(chk[1] > 0.f && chk[0] > 0.f && chk[0] <= MLA_CHECK_TOL * chk[1])) { y[0] = y[1] = y[2] = y[3] = __builtin_nanf(""); } }
#endif
                *(f32x4*)(op + c0 + 256 * i) = y; }
        } else {
            constexpr int LY = LAYER < 4 ? LAYER : 0;
            const float* na = F.moda(LY, v, 0); const float* sh = F.modv(LY, v, 0);
            bf16_t* xo = xdst + (size_t)row * D; bf16_t* ho = hb + (size_t)row * D;
#pragma unroll
            for (int i = 0; i < 4; ++i) {
                const f32x4 g = *(const f32x4*)(na + c0 + 256 * i), s0v = *(const f32x4*)(sh + c0 + 256 * i);
                f32x4 y;
#pragma unroll
                for (int j = 0; j < 4; ++j) y[j] = x[i][j] * rstd * g[j] + s0v[j];
                st_bf4(xo + c0 + 256 * i, x[i]);
                if (GEMM_FP8 && LAYER != 1) st_fp8x4((unsigned char*)hb + (size_t)row * D + c0 + 256 * i, y); else st_bf4(ho + c0 + 256 * i, y);
            }
        }
    }
}

template <int LAYER>
DI void ph_norm2_router(const Frame& F, bool dry = false) {
    if (!dry) { if (LAYER == 0) cvt_moe_range(F, 0, 2960, 3072, F.vcu, F.G); if (LAYER == 3) cvt_moe_range(F, 3, 1952, 3072, F.vcu, F.G); }
    char* Wl = F.lds;
    int* hist = (int*)(F.lds + LDS_MISC + 64);
    int* basee = hist + 32;
    { const u32x4* src = (const u32x4*)(F.ws + WS_RW + (size_t)LAYER * 2 * RW_HALF); u32x4* dst = (u32x4*)Wl;
      constexpr int NCH = 2 * RW_HALF / 16, NIT = (NCH + NTHR - 1) / NTHR;
      u32x4 tmp[NIT];
#pragma unroll
      for (int k = 0; k < NIT; ++k) { const int i = F.tid + k * NTHR; if (i < NCH) tmp[k] = src[i]; }
#pragma unroll
      for (int k = 0; k < NIT; ++k) { const int i = F.tid + k * NTHR; if (i < NCH) dst[i] = tmp[k]; } }
    if (F.tid < 32) hist[F.tid] = 0;
    __syncthreads();
    const bf16_t* xres = (const bf16_t*)(F.ws + WS_XRES);
    bf16_t* hb = (bf16_t*)(F.ws + WS_H);
    const size_t dofs = dry ? (WS_END - WS_EID) : 0;
    int* eid = (int*)(F.ws + WS_EID + dofs); float* gw = (float*)(F.ws + WS_GW + dofs); int* pos = (int*)(F.ws + WS_POS + dofs);
    const float* bg = F.in[I_BGRP] + LAYER * 4; const float* br = F.in[I_BRT] + LAYER * 32;
    const int fr = F.lane & 15, fq = F.lane >> 4;
    const char* w0 = Wl + fr * RW_PITCH + 16 * fq;
    const char* w1 = w0 + 16 * RW_PITCH;
    const char* w2 = Wl + (32 + (fr & 3)) * RW_PITCH + 16 * fq;
    auto run = [&](const int g16, const int s0, const bool whole, f32x4& acc0, f32x4& acc1, f32x4& acc2) __attribute__((always_inline)) {
        const int row = 16 * g16 + fr, v = row_modv(16 * g16);
        const bf16_t* xp = xres + (size_t)row * D + 8 * fq;
        float ss;
        { const f32x4 q4 = *(const f32x4*)((const float*)(F.ws + WS_SQX) + (size_t)row * 4); ss = q4[0] + q4[1] + q4[2] + q4[3]; }
        const float rstd = rsqrtf(ss * (1.0f / D) + EPS);
        const float* na = F.moda(LAYER, v, 1) + 8 * fq; const float* sh = F.modv(LAYER, v, 3) + 8 * fq;
        unsigned char* h8 = (unsigned char*)hb + (size_t)row * D + 8 * fq;

        if (whole) {
#pragma unroll 4
            for (int s = 0; s < 32; ++s) {
            float h[8];
            { const u32x4 xw = *(const u32x4*)(xp + 32 * s);
              const f32x4 a = {bflo(xw.x), bfhi(xw.x), bflo(xw.y), bfhi(xw.y)}, b = {bflo(xw.z), bfhi(xw.z), bflo(xw.w), bfhi(xw.w)};
              const f32x4 ga = *(const f32x4*)(na + 32 * s), gb = *(const f32x4*)(na + 32 * s + 4);
              const f32x4 ha = *(const f32x4*)(sh + 32 * s), hbv = *(const f32x4*)(sh + 32 * s + 4);
#pragma unroll
              for (int j = 0; j < 4; ++j) { h[j] = a[j] * rstd * ga[j] + ha[j]; h[4 + j] = b[j] * rstd * gb[j] + hbv[j]; } }
            u32x4 hi, lo;
            hi.x = cvt_pk(h[0], h[1]); hi.y = cvt_pk(h[2], h[3]); hi.z = cvt_pk(h[4], h[5]); hi.w = cvt_pk(h[6], h[7]);
            { u32x2 w8; w8.x = pk4_fp8(h[0], h[1], h[2], h[3]); w8.y = pk4_fp8(h[4], h[5], h[6], h[7]); *(u32x2*)(h8 + 32 * s) = w8; }
            lo.x = cvt_pk(h[0] - bflo(hi.x), h[1] - bfhi(hi.x)); lo.y = cvt_pk(h[2] - bflo(hi.y), h[3] - bfhi(hi.y));
            lo.z = cvt_pk(h[4] - bflo(hi.z), h[5] - bfhi(hi.z)); lo.w = cvt_pk(h[6] - bflo(hi.w), h[7] - bfhi(hi.w));
            const bf16x8 ah = __builtin_bit_cast(bf16x8, hi), alo = __builtin_bit_cast(bf16x8, lo);
            const bf16x8 w0h = *(const bf16x8*)(w0 + 64 * s), w0l = *(const bf16x8*)(w0 + RW_HALF + 64 * s);
            const bf16x8 w1h = *(const bf16x8*)(w1 + 64 * s), w1l = *(const bf16x8*)(w1 + RW_HALF + 64 * s);
            const bf16x8 w2h = *(const bf16x8*)(w2 + 64 * s), w2l = *(const bf16x8*)(w2 + RW_HALF + 64 * s);
            acc0 = __builtin_amdgcn_mfma_f32_16x16x32_bf16(w0h, ah, acc0, 0, 0, 0); acc0 = __builtin_amdgcn_mfma_f32_16x16x32_bf16(w0h, alo, acc0, 0, 0, 0); acc0 = __builtin_amdgcn_mfma_f32_16x16x32_bf16(w0l, ah, acc0, 0, 0, 0);
            acc1 = __builtin_amdgcn_mfma_f32_16x16x32_bf16(w1h, ah, acc1, 0, 0, 0); acc1 = __builtin_amdgcn_mfma_f32_16x16x32_bf16(w1h, alo, acc1, 0, 0, 0); acc1 = __builtin_amdgcn_mfma_f32_16x16x32_bf16(w1l, ah, acc1, 0, 0, 0);
            acc2 = __builtin_amdgcn_mfma_f32_16x16x32_bf16(w2h, ah, acc2, 0, 0, 0); acc2 = __builtin_amdgcn_mfma_f32_16x16x32_bf16(w2h, alo, acc2, 0, 0, 0); acc2 = __builtin_amdgcn_mfma_f32_16x16x32_bf16(w2l, ah, acc2, 0, 0, 0);
            }
        } else {
#pragma unroll
            for (int k_ = 0; k_ < 4; ++k_) { const int s = s0 + k_;
            float h[8];
            { const u32x4 xw = *(const u32x4*)(xp + 32 * s);
              const f32x4 a = {bflo(xw.x), bfhi(xw.x), bflo(xw.y), bfhi(xw.y)}, b = {bflo(xw.z), bfhi(xw.z), bflo(xw.w), bfhi(xw.w)};
              const f32x4 ga = *(const f32x4*)(na + 32 * s), gb = *(const f32x4*)(na + 32 * s + 4);
              const f32x4 ha = *(const f32x4*)(sh + 32 * s), hbv = *(const f32x4*)(sh + 32 * s + 4);
#pragma unroll
              for (int j = 0; j < 4; ++j) { h[j] = a[j] * rstd * ga[j] + ha[j]; h[4 + j] = b[j] * rstd * gb[j] + hbv[j]; } }
            u32x4 hi, lo;
            hi.x = cvt_pk(h[0], h[1]); hi.y = cvt_pk(h[2], h[3]); hi.z = cvt_pk(h[4], h[5]); hi.w = cvt_pk(h[6], h[7]);
            { u32x2 w8; w8.x = pk4_fp8(h[0], h[1], h[2], h[3]); w8.y = pk4_fp8(h[4], h[5], h[6], h[7]); *(u32x2*)(h8 + 32 * s) = w8; }
            lo.x = cvt_pk(h[0] - bflo(hi.x), h[1] - bfhi(hi.x)); lo.y = cvt_pk(h[2] - bflo(hi.y), h[3] - bfhi(hi.y));
            lo.z = cvt_pk(h[4] - bflo(hi.z), h[5] - bfhi(hi.z)); lo.w = cvt_pk(h[6] - bflo(hi.w), h[7] - bfhi(hi.w));
            const bf16x8 ah = __builtin_bit_cast(bf16x8, hi), alo = __builtin_bit_cast(bf16x8, lo);
            const bf16x8 w0h = *(const bf16x8*)(w0 + 64 * s), w0l = *(const bf16x8*)(w0 + RW_HALF + 64 * s);
            const bf16x8 w1h = *(const bf16x8*)(w1 + 64 * s), w1l = *(const bf16x8*)(w1 + RW_HALF + 64 * s);
            const bf16x8 w2h = *(const bf16x8*)(w2 + 64 * s), w2l = *(const bf16x8*)(w2 + RW_HALF + 64 * s);
            acc0 = __builtin_amdgcn_mfma_f32_16x16x32_bf16(w0h, ah, acc0, 0, 0, 0); acc0 = __builtin_amdgcn_mfma_f32_16x16x32_bf16(w0h, alo, acc0, 0, 0, 0); acc0 = __builtin_amdgcn_mfma_f32_16x16x32_bf16(w0l, ah, acc0, 0, 0, 0);
            acc1 = __builtin_amdgcn_mfma_f32_16x16x32_bf16(w1h, ah, acc1, 0, 0, 0); acc1 = __builtin_amdgcn_mfma_f32_16x16x32_bf16(w1h, alo, acc1, 0, 0, 0); acc1 = __builtin_amdgcn_mfma_f32_16x16x32_bf16(w1l, ah, acc1, 0, 0, 0);
            acc2 = __builtin_amdgcn_mfma_f32_16x16x32_bf16(w2h, ah, acc2, 0, 0, 0); acc2 = __builtin_amdgcn_mfma_f32_16x16x32_bf16(w2h, alo, acc2, 0, 0, 0); acc2 = __builtin_amdgcn_mfma_f32_16x16x32_bf16(w2l, ah, acc2, 0, 0, 0);
            }
        }
    };
    auto decide = [&](const int g16, const f32x4 acc0, const f32x4 acc1, const f32x4 acc2) __attribute__((always_inline)) {
        const int row = 16 * g16 + fr;
        const float l0 = acc2[0] + bg[0], l1 = acc2[1] + bg[1], l2 = acc2[2] + bg[2], l3 = acc2[3] + bg[3];
        int g = 0; float gm = l0;
        if (l1 > gm) { gm = l1; g = 1; }
        if (l2 > gm) { gm = l2; g = 2; }
        if (l3 > gm) { gm = l3; g = 3; }
        const float wgp = 1.0f / (__expf(l0 - gm) + __expf(l1 - gm) + __expf(l2 - gm) + __expf(l3 - gm));
        const f32x4 cnd = (g >> 1) ? acc1 : acc0;
        const int srcl = fr + 32 * (g & 1);
        float le[8];
#pragma unroll
        for (int j = 0; j < 8; ++j) le[j] = __shfl(cnd[j & 3], srcl + 16 * (j >> 2));
        { const f32x4 ba = *(const f32x4*)(br + 8 * g), bb = *(const f32x4*)(br + 8 * g + 4);
#pragma unroll
          for (int j = 0; j < 4; ++j) { le[j] += ba[j]; le[4 + j] += bb[j]; } }
        int e1 = 0; float m1 = le[0];
#pragma unroll
        for (int j = 1; j < 8; ++j) if (le[j] > m1) { m1 = le[j]; e1 = j; }
        int e2 = -1; float m2 = -3.0e38f;
#pragma unroll
        for (int j = 0; j < 8; ++j) if (j != e1 && le[j] > m2) { m2 = le[j]; e2 = j; }
        const float w1g = 1.0f / (1.0f + __expf(m2 - m1)), w2g = 1.0f - w1g;
        if (fq == 0) {
            const int ea = g * 8 + e1, eb = g * 8 + e2;
            eid[2 * row] = ea; eid[2 * row + 1] = eb;
            gw[2 * row] = wgp * w1g; gw[2 * row + 1] = wgp * w2g;
            pos[2 * row] = atomicAdd(&hist[ea], 1); pos[2 * row + 1] = atomicAdd(&hist[eb], 1);
        }
    };
    const int wi = F.vcu * 8 + F.wave;
    const int gmain = LAYER == 3 ? (wi < 1024 ? 16 + wi : 1056 + (wi - 1024)) : wi;
    { f32x4 a0 = {0.f, 0.f, 0.f, 0.f}, a1 = a0, a2 = a0; run(gmain, 0, true, a0, a1, a2); decide(gmain, a0, a1, a2); }
    const bool coop = LAYER != 3 && (F.vcu & 7) == 0;
    const int gextra = 2048 + (F.vcu >> 3);
    if (coop) {
        f32x4 a0 = {0.f, 0.f, 0.f, 0.f}, a1 = a0, a2 = a0; run(gextra, 4 * F.wave, false, a0, a1, a2);
        float* xb = (float*)F.scr(SM_Y) + (dry ? ((size_t)1 << 20) : 0) + (size_t)(F.vcu >> 3) * (8 * 64 * 12);
        if (F.wave != 0) { float* q = xb + (F.wave * 64 + F.lane) * 12; *(f32x4*)q = a0; *(f32x4*)(q + 4) = a1; *(f32x4*)(q + 8) = a2; }
        __builtin_amdgcn_fence(__ATOMIC_RELEASE, "agent");
        __syncthreads();
        if (F.wave == 0) {
            __builtin_amdgcn_fence(__ATOMIC_ACQUIRE, "agent");
            for (int w = 1; w < 8; ++w) { const float* q = xb + (w * 64 + F.lane) * 12; a0 += *(const f32x4*)q; a1 += *(const f32x4*)(q + 4); a2 += *(const f32x4*)(q + 8); }
            decide(gextra, a0, a1, a2);
        }
    }
    __syncthreads();
    unsigned* counts = (unsigned*)(F.ws + WS_CTL + CTL_COUNTS) + (LAYER + (dry ? 4 : 0)) * 32;
    int t2 = threadIdx.x; asm volatile("" : "+v"(t2));
    if (t2 < 32) basee[t2] = (int)atomicAdd(&counts[t2], (unsigned)hist[t2]);
    __syncthreads();
    if ((t2 & 63) < 16) {
        const int wi2 = F.vcu * 8 + (t2 >> 6), gm2 = LAYER == 3 ? (wi2 < 1024 ? 16 + wi2 : 1056 + (wi2 - 1024)) : wi2;
        { const int row = 16 * gm2 + (t2 & 15); pos[2 * row] += basee[eid[2 * row]]; pos[2 * row + 1] += basee[eid[2 * row + 1]]; }
        if (LAYER != 3 && (F.vcu & 7) == 0 && (t2 >> 6) == 0) { const int row = 16 * (2048 + (F.vcu >> 3)) + (t2 & 15); pos[2 * row] += basee[eid[2 * row]]; pos[2 * row + 1] += basee[eid[2 * row + 1]]; }
    }
    __syncthreads();
}
DI void moe_pstart(const Frame& F, int layer, int* pst) {
    const unsigned* counts = (const unsigned*)(F.ws + WS_CTL + CTL_COUNTS) + layer * 32;
    if (F.tid == 0) { int a = 0; for (int e = 0; e < 32; ++e) { pst[e] = a; a += ((int)counts[e] + 255) / 256 * 256; } pst[32] = a; }
    __syncthreads();
}
template <int LAYER>
DI void ph_scatter(const Frame& F) {
    int* pst = (int*)(F.lds + LDS_MISC + 512);
    moe_pstart(F, LAYER, pst);
    const int* eid = (const int*)(F.ws + WS_EID); const int* pos = (const int*)(F.ws + WS_POS);
    int* slot = (int*)(F.ws + WS_SLOT); int* btok = (int*)(F.ws + WS_BTOK);
    for (int i = F.vcu * NTHR + F.tid; i < 2 * T; i += F.G * NTHR) {
        if (LAYER == 3 && row_modv(i >> 1) == 0) continue;
        const int s = pst[eid[i]] + pos[i];
        slot[i] = s; btok[s] = i >> 1;
    }
    const unsigned* counts = (const unsigned*)(F.ws + WS_CTL + CTL_COUNTS) + LAYER * 32;
    for (int e = F.vcu; e < 32; e += F.G) {
        const int c = (int)counts[e], pc = pst[e + 1] - pst[e];
        for (int p = c + F.tid; p < pc; p += NTHR) btok[pst[e] + p] = 0;
    }
    __syncthreads();
}
DI void tile_rowsumsq(const g8::Acc& acc, const LaneC& L, char* lds, float* out, int stride) {
    float* tb = (float*)lds;
#pragma unroll
    for (int ai = 0; ai < 2; ++ai)
#pragma unroll
        for (int m = 0; m < 4; ++m) {
            float s = 0.f;
#pragma unroll
            for (int bj = 0; bj < 2; ++bj)
#pragma unroll
                for (int n = 0; n < 2; ++n) { const f32x4 v = acc[ai][bj][m][n]; s += v[0] * v[0] + v[1] * v[1] + v[2] * v[2] + v[3] * v[3]; }
            s += __shfl_xor(s, 16); s += __shfl_xor(s, 32);
            if (L.fq == 0) tb[EPI_R(ai, m) * 4 + L.wc] = s;
        }
    __syncthreads();
    int t_ = threadIdx.x; asm volatile("" : "+v"(t_));
    if (t_ < 256) { const f32x4 v = *(const f32x4*)(tb + t_ * 4); out[(size_t)t_ * stride] = v[0] + v[1] + v[2] + v[3]; }
    __syncthreads();
}
DI void rope_cs(const float* rope, int row, int g, int fq, f32x4& c, f32x4& s) {
    const int b = row_batch(row), rr = row - b * TB;
    if (rr < NCTX) { c = (f32x4){1.f, 1.f, 1.f, 1.f}; s = (f32x4){0.f, 0.f, 0.f, 0.f}; return; }
    const int p = rr - NCTX, v = g == 0 ? (p >> 6) : (p & 63);
    const f32x4 a = *(const f32x4*)(rope + (v * 16 + 4 * fq) * 2), bq = *(const f32x4*)(rope + (v * 16 + 4 * fq) * 2 + 4);
    c = (f32x4){a[0], a[2], bq[0], bq[2]}; s = (f32x4){a[1], a[3], bq[1], bq[3]};
}

template <bool KROPE>
DI void ph_mla_proj1(const Frame& F) {
    const bf16_t* hb = (const bf16_t*)(F.ws + WS_H); const bf16_t* W = F.wt(WT_P1);
    bf16_t* cq = F.scr(SC_CQ); bf16_t* ckv = F.scr(SC_CKV); bf16_t* Kb = F.scr(SC_K);
    float* sqq = (float*)(F.ws + WS_SQQ); float* sqkv = (float*)(F.ws + WS_SQKV);
    const float* rope = (const float*)(F.ws + WS_ROPE);
    for (int u = F.vcu; u < 130 * (KROPE ? 1 : 3); u += F.G) {
        const int pm = KROPE ? u : u / 3, pn = KROPE ? 3 : u % 3, R0 = pm * 256;
        g8::Acc acc;
#if GEMM_FP8
        g8::gemm_unit<false, false, true, 124>(g8::opnd(as_h((const unsigned char*)hb + (size_t)R0 * 1024), 512), g8::opnd(as_h((const unsigned char*)W + (size_t)pn * 256 * 1024), 512), 512, F.lds, acc);
#else
        g8::gemm_unit<false>(g8::opnd(hb + (size_t)R0 * 1024, 1024), g8::opnd(W + (size_t)pn * 256 * 1024, 1024), 1024, F.lds, acc);
#endif
        const LaneC L = lane_coords();
        if (pn < 3) {
            bf16_t* dst = pn < 2 ? cq + (size_t)R0 * 512 + pn * 256 : ckv + (size_t)R0 * 256;
            const int ldd = pn < 2 ? 512 : 256;
#pragma unroll
            for (int ai = 0; ai < 2; ++ai)
#pragma unroll
                for (int m = 0; m < 4; ++m)
#pragma unroll
                    for (int bj = 0; bj < 2; ++bj)
#pragma unroll
                        for (int n = 0; n < 2; ++n) { st_bf4(dst + (size_t)EPI_R(ai, m) * ldd + EPI_S(bj, n), acc[ai][bj][m][n]); if (n == 1 && bj == 1) __builtin_amdgcn_sched_barrier(0); }
            if (pn < 2) tile_rowsumsq(acc, L, F.lds, sqq + (size_t)R0 * 2 + pn, 2);
            else tile_rowsumsq(acc, L, F.lds, sqkv + R0, 1);
        } else if (L.wc < 2) {
#pragma unroll
            for (int ai = 0; ai < 2; ++ai)
#pragma unroll
                for (int m = 0; m < 4; ++m) {
                    const int row = R0 + EPI_R(ai, m);
                    f32x4 c, s; rope_cs(rope, row, L.wc & 1, L.fq, c, s);
                    const f32x4 x1 = acc[ai][0][m][0], x2 = acc[ai][0][m][1];
                    const f32x4 o1 = x1 * c - x2 * s, o2 = x1 * s + x2 * c;
#if MLA_KEEP_BF16
                    bf16_t* kp = Kb + (size_t)row * 1536 + 128 + 16 * (L.wc & 1) + 4 * L.fq;
#pragma unroll
                    for (int hh = 0; hh < 8; ++hh) { st_bf4(kp + hh * 192, o1); st_bf4(kp + hh * 192 + 32, o2); }
#endif
#if MLA_FP8
                    { unsigned char* k8 = (unsigned char*)F.scr(SC_K8) + (size_t)row * 1536 + 128 + 16 * (L.wc & 1) + 4 * L.fq;
                      const unsigned w1 = pk4_fp8(o1[0], o1[1], o1[2], o1[3]), w2 = pk4_fp8(o2[0], o2[1], o2[2], o2[3]);
#pragma unroll
                      for (int hh = 0; hh < 8; ++hh) { *(unsigned*)(k8 + hh * 192) = w1; *(unsigned*)(k8 + hh * 192 + 32) = w2; } }
#endif
                }
        }
    }
    if (!KROPE) tail_cvt(F, 390, 0, 0, 976);
}
DI void ph_mla_proj2(const Frame& F) {
    ph_mla_proj1<true>(F);
    const bf16_t* cq = F.scr(SC_CQ); const bf16_t* ckv = F.scr(SC_CKV);
    bf16_t* Qb = F.scr(SC_Q); bf16_t* Kb = F.scr(SC_K); bf16_t* Vb = F.scr(SC_V);
    unsigned char* Q8 = (unsigned char*)F.scr(SC_Q8); unsigned char* K8 = (unsigned char*)F.scr(SC_K8); unsigned char* V8T = (unsigned char*)F.scr(SC_V8T);
    const float* sqq = (const float*)(F.ws + WS_SQQ); const float* sqkv = (const float*)(F.ws + WS_SQKV);
    const float* rope = (const float*)(F.ws + WS_ROPE);
    for (int u0 = F.vcu; u0 < 130 * 14 + 130; u0 += F.G) {
        const int u = u0 - 130;
        if (u < 0) continue;
        const int pm = u / 14, pq = u % 14, R0 = pm * 256;
        g8::Acc acc;
        if (pq < 6) {
            const int pn = pq;
            g8::gemm_unit<false>(g8::opnd(cq + (size_t)R0 * 512, 512), g8::opnd(F.wt(WT_UQ) + (size_t)pn * 256 * 512, 512), 512, F.lds, acc); const LaneC L = lane_coords();
#pragma unroll
            for (int ai = 0; ai < 2; ++ai)
#pragma unroll
                for (int m = 0; m < 4; ++m) {
                    const int row = R0 + EPI_R(ai, m);
                    const float rs = rsqrtf((sqq[2 * row] + sqq[2 * row + 1]) * (1.0f / 512.0f) + EPS);
                    bf16_t* qp = Qb + (size_t)row * 1536 + pn * 256; unsigned char* q8 = Q8 + (size_t)row * 1536 + pn * 256;
#pragma unroll
                    for (int bj = 0; bj < 2; ++bj) {
                        const int seg = 4 * pn + 2 * bj + (L.wc >> 1);
                        if (seg % 3 == 2) {
                            f32x4 c, s; rope_cs(rope, row, L.wc & 1, L.fq, c, s);
                            const f32x4 x1 = acc[ai][bj][m][0] * rs, x2 = acc[ai][bj][m][1] * rs;
                            const int co = bj * 128 + (L.wc >> 1) * 64 + 16 * (L.wc & 1) + 4 * L.fq;
                            const f32x4 y1 = x1 * c - x2 * s, y2 = x1 * s + x2 * c;
#if MLA_KEEP_BF16
                            st_bf4(qp + co, y1); st_bf4(qp + co + 32, y2);
#endif
#if MLA_FP8
                            st_fp8x4(q8 + co, y1); st_fp8x4(q8 + co + 32, y2);
#endif
                        } else {
#pragma unroll
                            for (int n = 0; n < 2; ++n) {
#if MLA_KEEP_BF16
                                st_bf4(qp + EPI_S(bj, n), acc[ai][bj][m][n] * rs);
#endif
#if MLA_FP8
                                st_fp8x4(q8 + EPI_S(bj, n), acc[ai][bj][m][n] * rs);
#endif
                            }
                        }
                    }
                }
        } else if (pq < 10) {
            const int hp = pq - 6;
            const bf16_t* w0 = F.wt(WT_UKV) + (size_t)(2 * hp) * 256 * 256;
            g8::gemm_unit<false>(g8::opnd(ckv + (size_t)R0 * 256, 256), g8::opnd(w0, w0 + 256 * 256, 256), 256, F.lds, acc); const LaneC L = lane_coords();
#pragma unroll
            for (int ai = 0; ai < 2; ++ai)
#pragma unroll
                for (int m = 0; m < 4; ++m) {
                    const int row = R0 + EPI_R(ai, m);
                    const float rs = rsqrtf(sqkv[row] * (1.0f / 256.0f) + EPS);
#pragma unroll
                    for (int bj = 0; bj < 2; ++bj)
#pragma unroll
                        for (int n = 0; n < 2; ++n) {
                            const int co = (2 * hp + bj) * 192 + EPI_S(0, n);
#if MLA_KEEP_BF16
                            st_bf4(Kb + (size_t)row * 1536 + co, acc[ai][bj][m][n] * rs);
#endif
#if MLA_FP8
                            st_fp8x4(K8 + (size_t)row * 1536 + co, acc[ai][bj][m][n] * rs);
#endif
                        }
                }
        } else {
            const int hp = pq - 10;
            const bf16_t* w0 = F.wt(WT_UKV) + ((size_t)(2 * hp) * 256 + 128) * 256;
            g8::gemm_unit<false>(g8::opnd(w0, w0 + 256 * 256, 256), g8::opnd(ckv + (size_t)R0 * 256, 256), 256, F.lds, acc); const LaneC L = lane_coords();
#pragma unroll
            for (int bj = 0; bj < 2; ++bj)
#pragma unroll
                for (int n = 0; n < 2; ++n) {
                    const int s = EPI_S(bj, n), tok = R0 + s;
                    const f32x4 q4 = *(const f32x4*)(sqkv + tok);
                    f32x4 rs;
#pragma unroll
                    for (int j = 0; j < 4; ++j) rs[j] = rsqrtf(q4[j] * (1.0f / 256.0f) + EPS);
#pragma unroll
                    for (int ai = 0; ai < 2; ++ai)
#pragma unroll
                        for (int m = 0; m < 4; ++m) {
                            const int hd = 2 * hp + ai, dv = L.wr * 64 + m * 16 + L.fr;
                            const f32x4 v = acc[ai][bj][m][n] * rs;
#if MLA_FP8
                            st_fp8x4(V8T + (size_t)(hd * 128 + dv) * T + tok, v);
#endif
#if MLA_KEEP_BF16
#pragma unroll
                            for (int j = 0; j < 4; ++j) Vb[(size_t)(tok + j) * 1024 + hd * 128 + dv] = (bf16_t)(cvt_pk(v[j], 0.f) & 0xffffu);
#endif
                        }
                }
        }
    }
}
template <bool F8>
DI void ph_wo(const Frame& F, const bf16_t* A, const bf16_t* W, const float* bias, int layer, bool dry = false) {
    bf16_t* xres = (bf16_t*)(F.ws + WS_XRES);
    bf16_t* xdst = dry ? (bf16_t*)(F.ws + WS_END) : xres;
    const int ntm = layer == 3 ? 128 : 130;
    for (int u = F.vcu; u < ntm * 4; u += F.G) {
        int pm = u >> 2; const int pn = u & 3;
        if (layer == 3) pm = pm + 1 + (pm >= 64 ? 1 : 0);
        const int R0 = pm * 256;
        g8::Acc acc;
        if (F8) g8::gemm_unit<false, false, true, 121>(g8::opnd(as_h((const unsigned char*)A + (size_t)R0 * 1024), 512), g8::opnd(as_h((const unsigned char*)W + (size_t)pn * 256 * 1024), 512), 512, F.lds, acc);
        else g8::gemm_unit<false>(g8::opnd(A + (size_t)R0 * 1024, 1024), g8::opnd(W + (size_t)pn * 256 * 1024, 1024), 1024, F.lds, acc);
        const LaneC L = lane_coords();
        const float* g1 = F.modv(layer, tile_modv(pm), 2) + pn * 256;
        float ssq[2][4];
#pragma unroll
        for (int ai = 0; ai < 2; ++ai)
#pragma unroll
            for (int m = 0; m < 4; ++m) ssq[ai][m] = 0.f;
#pragma unroll
        for (int bj = 0; bj < 2; ++bj)
#pragma unroll
            for (int n = 0; n < 2; ++n) {
                const int s = EPI_S(bj, n);
                const f32x4 g = *(const f32x4*)(g1 + s);
                f32x4 bv = (f32x4){0.f, 0.f, 0.f, 0.f};
                if (bias) bv = *(const f32x4*)(bias + pn * 256 + s);
#pragma unroll
                for (int ai = 0; ai < 2; ++ai)
#pragma unroll
                    for (int m = 0; m < 4; ++m) {
                        bf16_t* xp = xres + (size_t)(R0 + EPI_R(ai, m)) * D + pn * 256 + s;
                        const u32x2 xw = *(const u32x2*)xp;
                        f32x4 x = {bflo(xw.x), bfhi(xw.x), bflo(xw.y), bfhi(xw.y)};
                        x += g * (acc[ai][bj][m][n] + bv);
                        st_bf4(xdst + (xp - xres), x);
                        ssq[ai][m] += x[0] * x[0] + x[1] * x[1] + x[2] * x[2] + x[3] * x[3];
                    }
                __builtin_amdgcn_sched_barrier(0);
            }
        {
            float* tb = (float*)F.lds;
#pragma unroll
            for (int ai = 0; ai < 2; ++ai)
#pragma unroll
                for (int m = 0; m < 4; ++m) {
                    float s = ssq[ai][m];
                    s += __shfl_xor(s, 16); s += __shfl_xor(s, 32);
                    if (L.fq == 0) tb[EPI_R(ai, m) * 4 + L.wc] = s;
                }
            __syncthreads();
            int t_ = threadIdx.x; asm volatile("" : "+v"(t_));
            if (t_ < 256) { const f32x4 v = *(const f32x4*)(tb + t_ * 4);
                ((float*)(F.ws + WS_SQX))[(size_t)(R0 + t_) * 4 + pn] = v[0] + v[1] + v[2] + v[3]; }
            __syncthreads();
        }
    }
    if (!dry) {
        if (layer == 0) tail_cvt(F, 520, 0, 976, 2960);
        if (layer == 1) tail_cvt(F, 520, 1, 1464, 3072);
        if (layer == 2) tail_cvt(F, 520, 2, 1500, 3072);
    }
}
DI void ph_na_qkv(const Frame& F) {
    const bf16_t* hb = (const bf16_t*)(F.ws + WS_H);
    for (int u = F.vcu; u < 130 * 12; u += F.G) {
        const int pm = u / 12, pn = u % 12, R0 = pm * 256;
        g8::Acc acc;
#if GEMM_FP8
        g8::gemm_unit<false, false, true, 124>(g8::opnd(as_h((const unsigned char*)hb + (size_t)R0 * 1024), 512), g8::opnd(as_h((const unsigned char*)F.wt(WT_NAQKV) + (size_t)pn * 256 * 1024), 512), 512, F.lds, acc);
#else
        g8::gemm_unit<false>(g8::opnd(hb + (size_t)R0 * 1024, 1024), g8::opnd(F.wt(WT_NAQKV) + (size_t)pn * 256 * 1024, 1024), 1024, F.lds, acc);
#endif
        const LaneC L = lane_coords();
        bf16_t* dst = F.scr(pn < 4 ? SN_Q : (pn < 8 ? SN_K : SN_V)) + (size_t)R0 * 1024 + (pn & 3) * 256;
#pragma unroll
        for (int ai = 0; ai < 2; ++ai)
#pragma unroll
            for (int m = 0; m < 4; ++m)
#pragma unroll
                for (int bj = 0; bj < 2; ++bj)
#pragma unroll
                    for (int n = 0; n < 2; ++n) st_bf4(dst + (size_t)EPI_R(ai, m) * 1024 + EPI_S(bj, n), acc[ai][bj][m][n]);
    }
    tail_cvt(F, 130 * 12, 2, 0, 1500);
}
DI void ph_swa_qkv(const Frame& F) {
    const bf16_t* hb = (const bf16_t*)(F.ws + WS_H);
    const float* rope = (const float*)(F.ws + WS_ROPE);
    for (int u = F.vcu; u < 130 * 6; u += F.G) {
        const int pm = u / 6, pn = u % 6, R0 = pm * 256;
        g8::Acc acc;
#if GEMM_FP8
        g8::gemm_unit<false, false, true, 124>(g8::opnd(as_h((const unsigned char*)hb + (size_t)R0 * 1024), 512), g8::opnd(as_h((const unsigned char*)F.wt(WT_SWQKV) + (size_t)pn * 256 * 1024), 512), 512, F.lds, acc);
#else
        g8::gemm_unit<false>(g8::opnd(hb + (size_t)R0 * 1024, 1024), g8::opnd(F.wt(WT_SWQKV) + (size_t)pn * 256 * 1024, 1024), 1024, F.lds, acc);
#endif
        const LaneC L = lane_coords();
        if (pn < 5) {
            bf16_t* dst = pn < 4 ? F.scr(SS_Q) + (size_t)R0 * 1024 + pn * 256 : F.scr(SS_K) + (size_t)R0 * 256;
            const int ldd = pn < 4 ? 1024 : 256;
#pragma unroll
            for (int ai = 0; ai < 2; ++ai)
#pragma unroll
                for (int m = 0; m < 4; ++m) {
                    const int rl = EPI_R(ai, m);
                    f32x4 c, s; rope_cs(rope, R0 + rl, L.wc & 1, L.fq, c, s);
#pragma unroll
                    for (int bj = 0; bj < 2; ++bj) {
                        const f32x4 x1 = acc[ai][bj][m][0], x2 = acc[ai][bj][m][1];
                        bf16_t* p = dst + (size_t)rl * ldd + bj * 128 + (L.wc >> 1) * 64 + 16 * (L.wc & 1) + 4 * L.fq;
                        st_bf4(p, x1 * c - x2 * s); st_bf4(p + 32, x1 * s + x2 * c);
                    }
                }
        } else {
            bf16_t* dst = F.scr(SS_V) + (size_t)R0 * 256;
#pragma unroll
            for (int ai = 0; ai < 2; ++ai)
#pragma unroll
                for (int m = 0; m < 4; ++m)
#pragma unroll
                    for (int bj = 0; bj < 2; ++bj)
#pragma unroll
                        for (int n = 0; n < 2; ++n) st_bf4(dst + (size_t)EPI_R(ai, m) * 256 + EPI_S(bj, n), acc[ai][bj][m][n]);
        }
    }
    tail_cvt(F, 130 * 6, 3, 0, 1952);
}
DI int moe_expert_of(const int* pst, int slot0) { int e = 0;
#pragma unroll 1
    for (int q = 1; q < 32; ++q) if (pst[q] <= slot0) e = q; return e; }
constexpr int MOE_WS = 124;
template <int LAYER>
DI void ph_moe1(const Frame& F) {
    int* pst = (int*)(F.lds + LDS_MISC + 512);
    moe_pstart(F, LAYER, pst);
    const int MT = pst[32] >> 8, NU = MT * 4, NFULL = (NU / F.G) * F.G, NH = 2 * (NU - NFULL);
    const unsigned char* h8 = F.ws + WS_H; const unsigned char* mw = F.ws + WS_MOEW;
    const int* btok = (const int*)(F.ws + WS_BTOK);
    unsigned char* act = (unsigned char*)F.scr(SM_ACT);
    for (int u = F.vcu; u < NFULL; u += F.G) {
        const int mt = u >> 2, pn = u & 3, e = moe_expert_of(pst, mt * 256);
        g8::Acc acc;
        g8::gemm_unit<true, false, true, MOE_WS>(g8::Opnd{as_h(h8), as_h(h8), 512, btok + mt * 256},
                      g8::opnd(as_h(mw + MOEW_G + (size_t)(e * 512 + pn * 128) * 1024), as_h(mw + MOEW_U + (size_t)(e * 512 + pn * 128) * 1024), 512), 512, F.lds, acc); const LaneC L = lane_coords();
#pragma unroll
        for (int ai = 0; ai < 2; ++ai)
#pragma unroll
            for (int m = 0; m < 4; ++m)
#pragma unroll
                for (int n = 0; n < 2; ++n) {
                    const f32x4 g = acc[ai][0][m][n], up = acc[ai][1][m][n];
                    f32x4 r;
#pragma unroll
                    for (int j = 0; j < 4; ++j) r[j] = silu_f(g[j]) * up[j];
                    st_fp8x4(act + (size_t)(mt * 256 + EPI_R(ai, m)) * 512 + pn * 128 + EPI_S(0, n), r);
                }
    }
    for (int hu = F.vcu; hu < NH; hu += F.G) {
        const int u = NFULL + (hu >> 1), half = hu & 1, mt = u >> 2, pn = u & 3, e = moe_expert_of(pst, mt * 256);
        g8::Acc acc;
        g8::gemm_unit<true, true, true, MOE_WS>(g8::Opnd{as_h(h8), as_h(h8), 512, btok + mt * 256 + 128 * half},
                      g8::opnd(as_h(mw + MOEW_G + (size_t)(e * 512 + pn * 128) * 1024), as_h(mw + MOEW_U + (size_t)(e * 512 + pn * 128) * 1024), 512), 512, F.lds, acc); const LaneC L = lane_coords();
#pragma unroll
        for (int m = 0; m < 4; ++m)
#pragma unroll
            for (int n = 0; n < 2; ++n) {
                const f32x4 g = acc[0][0][m][n], up = acc[0][1][m][n];
                f32x4 r;
#pragma unroll
                for (int j = 0; j < 4; ++j) r[j] = silu_f(g[j]) * up[j];
                st_fp8x4(act + (size_t)(mt * 256 + 128 * half + EPI_R(0, m)) * 512 + pn * 128 + EPI_S(0, n), r);
            }
    }
}
template <bool HALFX>
DI void epi_tile_bf16(g8::Acc& acc, char* lds, bf16_t* __restrict__ dst, const int ldd) {
    constexpr int P = 528, NR = HALFX ? 128 : 256;
    { const LaneC L = lane_coords();
#pragma unroll
      for (int ai = 0; ai < (HALFX ? 1 : 2); ++ai)
#pragma unroll
        for (int m = 0; m < 4; ++m)
#pragma unroll
            for (int bj = 0; bj < 2; ++bj)
#pragma unroll
                for (int n = 0; n < 2; ++n) { const f32x4 v = acc[ai][bj][m][n]; u32x2 w; w.x = cvt_pk(v[0], v[1]); w.y = cvt_pk(v[2], v[3]);
                    *reinterpret_cast<u32x2*>(lds + EPI_R(ai, m) * P + EPI_S(bj, n) * 2) = w; } }
    __syncthreads();
    { int tid = threadIdx.x; asm volatile("" : "+v"(tid));
      const int wave = tid >> 6, lane = tid & 63, sub = lane >> 5, c16 = lane & 31;
#pragma unroll
      for (int i = 0; i < NR / 16; ++i) { const int row = wave * (NR / 8) + 2 * i + sub;
          const u32x4 v = *reinterpret_cast<const u32x4*>(lds + row * P + c16 * 16);
          __builtin_nontemporal_store(v, reinterpret_cast<u32x4*>(dst + (size_t)row * ldd + c16 * 8)); } }
    __syncthreads();
}
template <int LAYER>
DI void ph_moe2(const Frame& F) {
    int* pst = (int*)(F.lds + LDS_MISC + 512);
    moe_pstart(F, LAYER, pst);
    const int MT = pst[32] >> 8, NU = MT * 4, NFULL = (NU / F.G) * F.G, NH = 2 * (NU - NFULL);
    const unsigned char* mw = F.ws + WS_MOEW;
    const unsigned char* act = (const unsigned char*)F.scr(SM_ACT); bf16_t* yb = F.scr(SM_Y);
    for (int u = F.vcu; u < NFULL; u += F.G) {
        const int mt = u >> 2, pn = u & 3, e = moe_expert_of(pst, mt * 256);
        g8::Acc acc;
        g8::gemm_unit<false, false, true, MOE_WS, true, false>(g8::opnd(as_h(act + (size_t)mt * 256 * 512), 256), g8::opnd(as_h(mw + MOEW_D + (size_t)(e * 1024 + pn * 256) * 512), 256), 256, F.lds, acc);
        epi_tile_bf16<false>(acc, F.lds, yb + (size_t)(mt * 256) * D + pn * 256, D);
    }
    for (int hu = F.vcu; hu < NH; hu += F.G) {
        const int u = NFULL + (hu >> 1), half = hu & 1, mt = u >> 2, pn = u & 3, e = moe_expert_of(pst, mt * 256);
        g8::Acc acc;
        const bf16_t* xa = as_h(act + (size_t)(mt * 256 + 128 * half) * 512);
        g8::gemm_unit<false, true, true, MOE_WS, true, false>(g8::opnd(xa, xa, 256), g8::opnd(as_h(mw + MOEW_D + (size_t)(e * 1024 + pn * 256) * 512), 256), 256, F.lds, acc);
        epi_tile_bf16<true>(acc, F.lds, yb + (size_t)(mt * 256 + 128 * half) * D + pn * 256, D);
    }
}
DI void ph_dft_a(const Frame& F) {
    const bf16_t* hb = (const bf16_t*)(F.ws + WS_H);
    bf16_t* Z = F.scr(SF_Z); bf16_t* Zc = F.scr(SF_ZC);
    for (int u = F.vcu; u < 1024 + 16; u += F.G) {
        g8::Acc acc;
        if (u < 1024) {
            const int st = u & 63, rt = (u >> 6) & 1, g = (u >> 7) & 3, b = u >> 9, bg = b * 4 + g;
            { const bf16_t* yb0 = hb + (size_t)(b * TB + NCTX + 2 * st) * 1024 + g * 256;
              g8::gemm_unit<false>(g8::opnd(F.wt(WT_DFTA) + (size_t)rt * 256 * 256, 256), g8::opnd(yb0, yb0 + 1024, 128 * 1024), 256, F.lds, acc); }
            const LaneC L = lane_coords();
#pragma unroll
            for (int ai = 0; ai < 2; ++ai)
#pragma unroll
                for (int m = 0; m < 4; ++m)
#pragma unroll
                    for (int bj = 0; bj < 2; ++bj)
#pragma unroll
                        for (int n = 0; n < 2; ++n) {
                            const int kc = EPI_R(ai, m), n2 = 2 * st + bj, n1 = L.wc * 32 + n * 16 + 4 * L.fq;
                            st_bf4(Z + ((((size_t)bg * 256 + kc) * 128 + n2) * 2 + rt) * 128 + n1, acc[ai][bj][m][n]);
                        }
        } else {
            const int q = u - 1024, rt = q & 1, g = (q >> 1) & 3, b = q >> 3, bg = b * 4 + g;
            g8::gemm_unit<false>(g8::opnd(F.wt(WT_DFTA) + (size_t)rt * 256 * 256, 256), g8::opnd(hb + (size_t)b * TB * 1024 + g * 256, 1024), 256, F.lds, acc); const LaneC L = lane_coords();
#pragma unroll
            for (int ai = 0; ai < 2; ++ai)
#pragma unroll
                for (int m = 0; m < 4; ++m)
#pragma unroll
                    for (int bj = 0; bj < 2; ++bj)
#pragma unroll
                        for (int n = 0; n < 2; ++n)
                            st_bf4(Zc + (((size_t)bg * 256 + EPI_R(ai, m)) * 2 + rt) * 256 + EPI_S(bj, n), acc[ai][bj][m][n]);
        }
    }
    tail_cvt(F, 1040, 1, 0, 720);
}
DI void ph_dft_1(const Frame& F) {
    const bf16_t* Z = F.scr(SF_Z); const bf16_t* Zc = F.scr(SF_ZC); bf16_t* A1 = F.scr(SF_A1); bf16_t* YF = F.scr(SF_YF);
    for (int u = F.vcu; u < 1024 + 8; u += F.G) {
        g8::Acc acc;
        if (u < 1024) {
            g8::gemm_unit<false>(g8::opnd(F.wt(WT_DFT1), 256), g8::opnd(Z + (size_t)u * 256 * 256, 256), 256, F.lds, acc); const LaneC L = lane_coords();
#pragma unroll
            for (int m = 0; m < 4; ++m) {
                const int kb = L.wr * 64 + m * 16 + L.fr;
#pragma unroll
                for (int bj = 0; bj < 2; ++bj)
#pragma unroll
                    for (int n = 0; n < 2; ++n) {
                        const int n2 = L.wc * 32 + n * 16 + 4 * L.fq, bgkc = 2 * u + bj;
                        const f32x4 re = acc[0][bj][m][n], im = acc[1][bj][m][n];
                        f32x4 ro, io;
#pragma unroll
                        for (int j = 0; j < 4; ++j) {
                            const float th = (float)((n2 + j) * kb) * (1.0f / 16384.0f);
                            const float c = __builtin_amdgcn_cosf(th), s = __builtin_amdgcn_sinf(th);
                            ro[j] = re[j] * c + im[j] * s; io[j] = im[j] * c - re[j] * s;
                        }
                        bf16_t* p = A1 + (((size_t)bgkc * 128 + kb) * 2) * 128 + n2;
                        st_bf4(p, ro); st_bf4(p + 128, io);
                        __builtin_amdgcn_sched_barrier(0);
                    }
            }
        } else {
            const int bg = u - 1024, b = bg >> 2, g = bg & 3;
            g8::gemm_unit<false>(g8::opnd(F.wt(WT_DFTC), 512), g8::opnd(Zc + (size_t)bg * 256 * 512, 512), 512, F.lds, acc); const LaneC L = lane_coords();
#pragma unroll
            for (int ai = 0; ai < 2; ++ai)
#pragma unroll
                for (int m = 0; m < 4; ++m)
#pragma unroll
                    for (int bj = 0; bj < 2; ++bj)
#pragma unroll
                        for (int n = 0; n < 2; ++n)
                            st_bf4(YF + (size_t)(b * TB + EPI_R(ai, m)) * 1024 + g * 256 + EPI_S(bj, n), acc[ai][bj][m][n]);
        }
    }
    tail_cvt(F, 1032, 1, 720, 1464);
}
DI void ph_dft_2(const Frame& F) {
    const bf16_t* A1 = F.scr(SF_A1); bf16_t* YF = F.scr(SF_YF);
    for (int u = F.vcu; u < 1024; u += F.G) {
        const int kb = u & 127, bg = u >> 7, b = bg >> 2, g = bg & 3;
        g8::Acc acc;
        g8::gemm_unit<false>(g8::opnd(F.wt(WT_DFT2), 256), g8::opnd(A1 + ((size_t)bg * 256 * 128 + kb) * 256, 128 * 256), 256, F.lds, acc); const LaneC L = lane_coords();
#pragma unroll
        for (int m = 0; m < 4; ++m) {
            const int ka = L.wr * 64 + m * 16 + L.fr;
#pragma unroll
            for (int bj = 0; bj < 2; ++bj)
#pragma unroll
                for (int n = 0; n < 2; ++n)
                    st_bf4(YF + (size_t)(b * TB + NCTX + 128 * ka + kb) * 1024 + g * 256 + EPI_S(bj, n), acc[0][bj][m][n]);
        }
    }
}
constexpr float LOG2E = 1.4426950408889634f;
struct MlaCfg {
    const bf16_t* Q; const bf16_t* K; const bf16_t* V; bf16_t* O; int qrow0, krow0, nt, head;
    DI const bf16_t* qrow(int w, int r) const { return Q + (size_t)(qrow0 + 32 * w + r) * 1536 + head * 192; }
    DI bf16_t* orow(int w, int r) const { return O + (size_t)(qrow0 + 32 * w + r) * 1024 + head * 128; }
    DI int ntiles() const { return nt; }
    DI const bf16_t* ktile(int t) const { return K + (size_t)(krow0 + 64 * t) * 1536 + head * 192; }
    DI const bf16_t* vtile(int t) const { return V + (size_t)(krow0 + 64 * t) * 1024 + head * 128; }
    DI int ldk() const { return 1536; } DI int ldv() const { return 1024; }
    DI bool active(int, int) const { return true; }
    DI void mask(f32x16&, f32x16&, int, int, int, int, const float*) const {}
    DI void init(f32x16& p0, f32x16& p1, int, int, int, int, const float*) const { _Pragma("unroll") for (int r = 0; r < 16; ++r) { p0[r] = 0.f; p1[r] = 0.f; } }
    DI float m0() const { return -1e28f; } DI float l0() const { return 0.f; }
    DI float cexp() const { return 0.07216878364870322f * LOG2E; }
};
template <int PRB>
DI void ph_mla_attn(const Frame& F) {
    for (int u = F.vcu; u < 1024 + 16; u += F.G) {
        MlaCfg c; c.Q = F.scr(SC_Q); c.K = F.scr(SC_K); c.V = F.scr(SC_V); c.O = PRB ? (bf16_t*)(F.ws + WS_END) : F.scr(SC_O);
        if (u < 1024) { const int b = u >> 9, head = (u >> 6) & 7, qb = u & 63; c.qrow0 = b * TB + NCTX + 256 * qb; c.krow0 = b * TB; c.nt = TB / 64; c.head = head; }
        else { const int q = u - 1024, b = q >> 3; c.head = q & 7; c.qrow0 = b * TB; c.krow0 = b * TB; c.nt = NCTX / 64; }
#if MLA_FP8
        at::mla_attn_unit_fp8<PRB>((const unsigned char*)F.scr(SC_Q8) + (size_t)c.qrow0 * 1536 + c.head * 192, (const unsigned char*)F.scr(SC_K8) + (size_t)c.krow0 * 1536 + c.head * 192,
                              (const unsigned char*)F.scr(SC_V8T) + (size_t)(c.head * 128) * T + c.krow0,
                              WO_FP8 ? (bf16_t*)((unsigned char*)c.O + (size_t)c.qrow0 * 1024 + c.head * 128) : c.O + (size_t)c.qrow0 * 1024 + c.head * 128, c.nt, F.lds);
#else
        at::mla_attn_unit<PRB>(c.Q + (size_t)c.qrow0 * 1536 + c.head * 192, c.K + (size_t)c.krow0 * 1536 + c.head * 192, c.V + (size_t)c.krow0 * 1024 + c.head * 128,
                          c.O + (size_t)c.qrow0 * 1024 + c.head * 128, c.nt, F.lds);
#endif
    }
}
#ifdef MLA_CHECK
DI void ph_mla_attn_ref(const Frame& F) {
    for (int u = F.vcu; u < 1024 + 16; u += F.G) {
        MlaCfg c; c.Q = F.scr(SC_Q); c.K = F.scr(SC_K); c.V = F.scr(SC_V); c.O = (bf16_t*)(F.ws + WS_END);
        if (u < 1024) { const int b = u >> 9, head = (u >> 6) & 7, qb = u & 63; c.qrow0 = b * TB + NCTX + 256 * qb; c.krow0 = b * TB; c.nt = TB / 64; c.head = head; }
        else { const int q = u - 1024, b = q >> 3; c.head = q & 7; c.qrow0 = b * TB; c.krow0 = b * TB; c.nt = NCTX / 64; }
        at::attn_unit<192, 128>(c, F.lds, nullptr);
    }
}
DI void ph_mla_compare(const Frame& F) {
    const bf16_t* a = F.scr(SC_O); const bf16_t* b = (const bf16_t*)(F.ws + WS_END);
    float num = 0.f, den = 0.f;
    for (size_t i = (size_t)F.vcu * NTHR + F.tid; i < (size_t)T * 1024; i += (size_t)F.G * NTHR) { const float x = bf2f(a[i]), y = bf2f(b[i]); num += (x - y) * (x - y); den += y * y; }
    num = wave_sum(num); den = wave_sum(den);
    float* acc = (float*)(F.ws + WS_CTL + 32768);
    if (F.lane == 0) { atomicAdd(acc, num); atomicAdd(acc + 1, den); }
}
#endif
struct NaCfg {
    const bf16_t* Q; const bf16_t* K; const bf16_t* V; bf16_t* O; int qrow0, b, head, rg, rs_lo, nt; bool ctxq;
    DI const bf16_t* qrow(int w, int r) const { return Q + (size_t)(qrow0 + 32 * w + r) * 1024 + head * 64; }
    DI bf16_t* orow(int w, int r) const { return O + (size_t)(qrow0 + 32 * w + r) * 1024 + head * 64; }
    DI int ntiles() const { return nt; }
    DI int krow(int t) const { return t < 4 ? b * TB + 64 * t : b * TB + NCTX + 64 * (rs_lo + t - 4); }
    DI const bf16_t* ktile(int t) const { return K + (size_t)krow(t) * 1024 + head * 64; }
    DI const bf16_t* vtile(int t) const { return V + (size_t)krow(t) * 1024 + head * 64; }
    DI int ldk() const { return 1024; } DI int ldv() const { return 1024; }
    DI static int clampi(int x, int lo, int hi) { return x < lo ? lo : (x > hi ? hi : x); }
    DI bool active(int t, int w) const { if (t < 4) return true; const int qr = 4 * rg + (w >> 1), rs = clampi(qr - 4, 0, 248), kr = rs_lo + t - 4; return kr >= rs && kr < rs + 8; }
    DI void init(f32x16& p0, f32x16& p1, int t, int w, int r32, int hi, const float* tbl) const {
        if (t < 4) {
#pragma unroll
            for (int r = 0; r < 16; ++r) { p0[r] = 0.f; p1[r] = 0.f; }
            return;
        }
        const int qr = 4 * rg + (w >> 1), kr = rs_lo + t - 4, qc = (w & 1) * 32 + r32;
        const float* tb = tbl + (kr - qr + 7) * 31 + 15 - qc;
#pragma unroll
        for (int r = 0; r < 16; ++r) { const int k0 = at::crow(r, hi); p0[r] = tb[k0]; p1[r] = tb[32 + k0]; }
    }
    DI void mask(f32x16& p0, f32x16& p1, int t, int w, int r32, int hi, const float*) const {
        if (t < 4) return;
        const int qc = (w & 1) * 32 + r32, cs = clampi(qc - 8, 0, 48);
#pragma unroll
        for (int r = 0; r < 16; ++r) {
            const int k0 = at::crow(r, hi), k1 = 32 + k0;
            p0[r] = (k0 >= cs && k0 < cs + 16) ? p0[r] : -1e30f;
            p1[r] = (k1 >= cs && k1 < cs + 16) ? p1[r] : -1e30f;
        }
    }
    DI float m0() const { return -1e28f; } DI float l0() const { return 0.f; }
    DI float cexp() const { return 0.125f * LOG2E; }
};
DI void ph_na_attn(const Frame& F) {
    float* tbl = (float*)(F.lds + 24576);
    for (int u = F.vcu; u < 2048 + 32; u += F.G) {
        NaCfg c; c.Q = F.scr(SN_Q); c.K = F.scr(SN_K); c.V = F.scr(SN_V); c.O = F.scr(SN_O);
        if (u < 2048) {
            const int b = u >> 10, head = (u >> 6) & 15, rg = u & 63;
            c.b = b; c.head = head; c.rg = rg; c.qrow0 = b * TB + NCTX + 256 * rg; c.ctxq = false;
            c.rs_lo = NaCfg::clampi(4 * rg - 4, 0, 248);
            const int last = NaCfg::clampi(4 * rg + 3 - 4, 0, 248) + 7;
            c.nt = 4 + last - c.rs_lo + 1;
        } else { const int q = u - 2048; c.b = q >> 4; c.head = q & 15; c.rg = 0; c.rs_lo = 0; c.qrow0 = c.b * TB; c.nt = 4; c.ctxq = true; }
        const float* rpb = F.in[I_RPB] + c.head * 465;
        for (int i = F.tid; i < 465; i += NTHR) tbl[i] = rpb[i] * 8.0f;
        at::attn_unit<64, 64>(c, F.lds, tbl);
    }
}
struct SwaCfg {
    const bf16_t* Q; const bf16_t* K; const bf16_t* V; bf16_t* O; int qrow0, b, head, qb, klo, nt; float sink;
    DI const bf16_t* qrow(int w, int r) const { return Q + (size_t)(qrow0 + 32 * w + r) * 1024 + head * 64; }
    DI bf16_t* orow(int w, int r) const { return O + (size_t)(qrow0 + 32 * w + r) * 1024 + head * 64; }
    DI int ntiles() const { return nt; }
    DI int krow(int t) const { return t < 4 ? b * TB + 64 * t : b * TB + NCTX + 64 * (klo + t - 4); }
    DI const bf16_t* ktile(int t) const { return K + (size_t)krow(t) * 256 + (head >> 2) * 64; }
    DI const bf16_t* vtile(int t) const { return V + (size_t)krow(t) * 256 + (head >> 2) * 64; }
    DI int ldk() const { return 256; } DI int ldv() const { return 256; }
    DI bool active(int t, int w) const { if (t < 4) return true; const int qlo = 256 * qb + 32 * w, k0 = 64 * (klo + t - 4); return k0 + 63 >= qlo - 128 && k0 <= qlo + 31 + 128; }
    DI void mask(f32x16& p0, f32x16& p1, int t, int w, int r32, int hi, const float*) const {
        if (t < 4) return;
        const int d0 = 64 * (klo + t - 4) - (256 * qb + 32 * w + r32);
#pragma unroll
        for (int r = 0; r < 16; ++r) {
            const int da = d0 + at::crow(r, hi), db = da + 32;
            p0[r] = (da >= -128 && da <= 128) ? p0[r] : -1e30f;
            p1[r] = (db >= -128 && db <= 128) ? p1[r] : -1e30f;
        }
    }
    DI void init(f32x16& p0, f32x16& p1, int, int, int, int, const float*) const { _Pragma("unroll") for (int r = 0; r < 16; ++r) { p0[r] = 0.f; p1[r] = 0.f; } }
    DI float m0() const { return sink * 8.0f; } DI float l0() const { return 1.f; }
    DI float cexp() const { return 0.125f * LOG2E; }
};
DI void ph_swa_attn(const Frame& F) {
    for (int u = F.vcu; u < 2048; u += F.G) {
        SwaCfg c; c.Q = F.scr(SS_Q); c.K = F.scr(SS_K); c.V = F.scr(SS_V); c.O = F.scr(SS_O);
        const int b = u >> 10, head = (u >> 6) & 15, qb = u & 63;
        c.b = b; c.head = head; c.qb = qb; c.qrow0 = b * TB + NCTX + 256 * qb;
        c.klo = 4 * qb - 2 < 0 ? 0 : 4 * qb - 2;
        const int khi = 4 * qb + 5 > 255 ? 255 : 4 * qb + 5;
        c.nt = 4 + khi - c.klo + 1;
        c.sink = F.in[I_SINK][head];
        at::attn_unit<64, 64>(c, F.lds, nullptr);
    }
}

#ifdef MLA_CHECK
constexpr int N_PHASES = 39;
#else
constexpr int N_PHASES = 37;
#endif
__global__ void __launch_bounds__(NTHR, 2) mk_fwd(Params P) {
    extern __shared__ __attribute__((aligned(16))) char lds[];
    Frame F;
    F.in = (const float* const __attribute__((address_space(4)))*)__builtin_amdgcn_kernarg_segment_ptr(); F.out = P.out; F.ws = P.ws; F.lds = lds;
    F.tid = threadIdx.x; F.lane = F.tid & 63; F.wave = __builtin_amdgcn_readfirstlane(F.tid >> 6);
    F.G = gridDim.x; { const int bx = blockIdx.x; F.vcu = (F.G % 8 == 0) ? (bx % 8) * (F.G / 8) + bx / 8 : bx; }
    const int lo = P.ph_lo, hi = P.ph_hi;
    volatile LAS unsigned* stw = (volatile LAS unsigned*)(lds + LDS_MISC);
    if (F.tid < 4) stw[F.tid] = 0u;
    __syncthreads();
    XcdBarrier bar; bar.bar = (unsigned*)(P.ws + WS_CTL); bar.x = 0; bar.st = stw;
    if (hi - lo > 1) bar = xcd_barrier_post((unsigned*)(P.ws + WS_CTL), stw);
    int ph = 0;
#ifndef REP_MASK
#define REP_MASK 0ull
#endif
#ifndef ONLY_PHASE
#define ONLY_PHASE (-1)
#endif
#define PHASE(body) do { if (lo <= ph && ph < hi && (ONLY_PHASE < 0 || ph == ONLY_PHASE)) { { int t_ = threadIdx.x; asm volatile("" : "+v"(t_)); F.tid = t_; F.lane = t_ & 63; } body; \
    if ((REP_MASK >> ph) & 1ull) { if (hi - lo > 1) xcd_barrier(bar); body; } if (ph + 1 < hi) xcd_barrier(bar); } ++ph; } while (0)
#define PHASE2(body, drybody) do { if (lo <= ph && ph < hi && (ONLY_PHASE < 0 || ph == ONLY_PHASE)) { { int t_ = threadIdx.x; asm volatile("" : "+v"(t_)); F.tid = t_; F.lane = t_ & 63; } body; \
    if ((REP_MASK >> ph) & 1ull) { if (hi - lo > 1) xcd_barrier(bar); drybody; } if (ph + 1 < hi) xcd_barrier(bar); } ++ph; } while (0)
    PHASE(ph_prologue(F));
    PHASE(ph_modreduce(F));
    PHASE2(ph_norm1<0>(F), ph_norm1<0>(F, true));
    PHASE(ph_mla_proj1<false>(F));
    PHASE(ph_mla_proj2(F));
#ifndef MLA_PRB
#define MLA_PRB 0
#endif
    PHASE2(ph_mla_attn<0>(F), ph_mla_attn<MLA_PRB>(F));
#ifdef MLA_CHECK
    PHASE(ph_mla_attn_ref(F));
    PHASE(ph_mla_compare(F));
#endif
    PHASE2(ph_wo<WO_FP8>(F, F.scr(SC_O), F.wt(WT_WO0), nullptr, 0), ph_wo<WO_FP8>(F, F.scr(SC_O), F.wt(WT_WO0), nullptr, 0, true));
    PHASE2(ph_norm2_router<0>(F), ph_norm2_router<0>(F, true));
    PHASE(ph_scatter<0>(F));
    PHASE(ph_moe1<0>(F));
#ifndef MOE2_EPRB
#define MOE2_EPRB 0
#endif
    PHASE(ph_moe2<0>(F));
    PHASE2(ph_norm1<1>(F), ph_norm1<1>(F, true));
    PHASE(ph_dft_a(F));
    PHASE(ph_dft_1(F));
    PHASE(ph_dft_2(F));
    PHASE2(ph_wo<false>(F, F.scr(SF_YF), F.wt(WT_WO1), F.in[I_FBO], 1), ph_wo<false>(F, F.scr(SF_YF), F.wt(WT_WO1), F.in[I_FBO], 1, true));
    PHASE2(ph_norm2_router<1>(F), ph_norm2_router<1>(F, true));
    PHASE(ph_scatter<1>(F));
    PHASE(ph_moe1<1>(F));
    PHASE(ph_moe2<1>(F));
    PHASE2(ph_norm1<2>(F), ph_norm1<2>(F, true));
    PHASE(ph_na_qkv(F));
    PHASE(ph_na_attn(F));
    PHASE2(ph_wo<WO_FP8>(F, F.scr(SN_O), F.wt(WT_WO2), nullptr, 2), ph_wo<WO_FP8>(F, F.scr(SN_O), F.wt(WT_WO2), nullptr, 2, true));
    PHASE2(ph_norm2_router<2>(F), ph_norm2_router<2>(F, true));
    PHASE(ph_scatter<2>(F));
    PHASE(ph_moe1<2>(F));
    PHASE(ph_moe2<2>(F));
    PHASE2(ph_norm1<3>(F), ph_norm1<3>(F, true));
    PHASE(ph_swa_qkv(F));
    PHASE(ph_swa_attn(F));
    PHASE2(ph_wo<WO_FP8>(F, F.scr(SS_O), F.wt(WT_WO3), nullptr, 3), ph_wo<WO_FP8>(F, F.scr(SS_O), F.wt(WT_WO3), nullptr, 3, true));
    PHASE2(ph_norm2_router<3>(F), ph_norm2_router<3>(F, true));
    PHASE(ph_scatter<3>(F));
    PHASE(ph_moe1<3>(F));
    PHASE(ph_moe2<3>(F));
    PHASE2(ph_norm1<4>(F), ph_norm1<4>(F, true));
#undef PHASE
}

extern "C" void kernel_launch(void* const* d_in, const int* in_sizes, int n_in, void* d_out, int out_size, void* d_ws, size_t ws_size, hipStream_t stream) {
    static int grid = 0;
    if (grid == 0) {
        if (n_in != 31 || ws_size < WS_END) { fprintf(stderr, "kernel_launch: n_in %d ws %zu (need %zu)\n", n_in, ws_size, (size_t)WS_END); grid = -1; return; }
        int dev = 0, cus = 0, per_cu = 0;
        if (hipGetDevice(&dev) != hipSuccess || hipDeviceGetAttribute(&cus, hipDeviceAttributeMultiprocessorCount, dev) != hipSuccess) { grid = -1; return; }
        if (hipFuncSetAttribute((const void*)mk_fwd, hipFuncAttributeMaxDynamicSharedMemorySize, LDS_BYTES) != hipSuccess) { fprintf(stderr, "kernel_launch: hipFuncSetAttribute failed\n"); grid = -1; return; }
        if (hipOccupancyMaxActiveBlocksPerMultiprocessor(&per_cu, (const void*)mk_fwd, NTHR, LDS_BYTES) != hipSuccess || per_cu < 1) { fprintf(stderr, "kernel_launch: occupancy query says %d\n", per_cu); (void)hipGetLastError(); per_cu = 1; }
        grid = cus;
    }
    if (grid < 0) return;
    (void)hipMemsetAsync((char*)d_ws + WS_CTL, 0, CTL_BYTES, stream);
    Params p; memset(&p, 0, sizeof(p));
    for (int i = 0; i < 31; ++i) p.in[i] = (const float*)d_in[i];
    p.out = (float*)d_out; p.ws = (unsigned char*)d_ws;
#if MK_ONE_LAUNCH
    p.ph_lo = 0; p.ph_hi = N_PHASES;
    hipLaunchKernelGGL(mk_fwd, dim3(grid), dim3(NTHR), LDS_BYTES, stream, p);
#else
    for (int k = 0; k < N_PHASES; ++k) { p.ph_lo = k; p.ph_hi = k + 1; hipLaunchKernelGGL(mk_fwd, dim3(grid), dim3(NTHR), LDS_BYTES, stream, p); }
#endif
    const hipError_t le = hipPeekAtLastError();
    if (le != hipSuccess) fprintf(stderr, "kernel_launch: launch failed: %s\n", hipGetErrorName(le));
}
```

```cpp
#include <hip/hip_runtime.h>
#include <stdint.h>
#include <stdio.h>
#include <string.h>

#define DI __device__ __forceinline__
#define LAS __attribute__((address_space(3)))
typedef unsigned short bf16_t;
typedef short bf16x8 __attribute__((ext_vector_type(8)));
typedef short s16x4 __attribute__((ext_vector_type(4)));
typedef float f32x4 __attribute__((ext_vector_type(4)));
typedef float f32x16 __attribute__((ext_vector_type(16)));
typedef unsigned u32x4 __attribute__((ext_vector_type(4)));
typedef unsigned u32x2 __attribute__((ext_vector_type(2)));

#ifndef MLA_FP8
#define MLA_FP8 1
#endif
#if defined(MLA_CHECK) || !MLA_FP8
#define MLA_KEEP_BF16 1
#else
#define MLA_KEEP_BF16 0
#endif
#ifndef GEMM_FP8
#if defined(MLA_CHECK)
#define GEMM_FP8 0
#else
#define GEMM_FP8 1
#endif
#endif
#ifndef WO_FP8
#define WO_FP8 GEMM_FP8
#endif
#ifndef MK_ONE_LAUNCH
#define MK_ONE_LAUNCH 1
#endif

constexpr int D = 1024, SEQ = 16384, NCTX = 256, TB = SEQ + NCTX  , T = 2 * TB  ;
constexpr int NTHR = 512;
constexpr int MOE_MAXT = 292;
constexpr int MOE_SLOTS = MOE_MAXT * 256;
constexpr float EPS = 1e-6f;

constexpr size_t al256(size_t x) { return (x + 255) / 256 * 256; }
constexpr size_t WS_CTL = 0;
constexpr size_t CTL_BYTES = 65536;
constexpr size_t CTL_COUNTS = 16384;
constexpr size_t WS_MODP = WS_CTL + CTL_BYTES;
constexpr size_t WS_MODV = WS_MODP + (size_t)16 * 4 * 3 * 6144 * 4;
constexpr size_t WS_MODA = WS_MODV + (size_t)4 * 3 * 6144 * 4;
constexpr size_t WS_ROPE = WS_MODA + (size_t)4 * 3 * 2 * 1024 * 4;
constexpr size_t WS_EID = WS_ROPE + 256 * 16 * 2 * 4;
constexpr size_t WS_GW = WS_EID + (size_t)T * 8;
constexpr size_t WS_POS = WS_GW + (size_t)T * 8;
constexpr size_t WS_SLOT = WS_POS + (size_t)T * 8;
constexpr size_t WS_BTOK = WS_SLOT + (size_t)T * 8;
constexpr size_t WS_SQQ = al256(WS_BTOK + (size_t)MOE_SLOTS * 4);
constexpr size_t WS_SQKV = WS_SQQ + (size_t)T * 8;
constexpr size_t WS_SQX = WS_SQKV + (size_t)T * 4;
constexpr int RW_PITCH = 2064, RW_HALF = 36 * RW_PITCH;
constexpr size_t WS_RW = al256(WS_SQX + (size_t)T * 16);
constexpr size_t WS_WT = al256(WS_RW + (size_t)4 * 2 * RW_HALF);
constexpr size_t WT_P1 = 0;
constexpr size_t WT_UQ = WT_P1 + (size_t)1024 * 1024;
constexpr size_t WT_UKV = WT_UQ + (size_t)1536 * 512;
constexpr size_t WT_WO0 = WT_UKV + (size_t)2048 * 256;
constexpr size_t WT_WO1 = WT_WO0 + (size_t)1024 * 1024;
constexpr size_t WT_NAQKV = WT_WO1 + (size_t)1024 * 1024;
constexpr size_t WT_WO2 = WT_NAQKV + (size_t)3072 * 1024;
constexpr size_t WT_SWQKV = WT_WO2 + (size_t)1024 * 1024;
constexpr size_t WT_WO3 = WT_SWQKV + (size_t)1536 * 1024;
constexpr size_t WT_DFTA = WT_WO3 + (size_t)1024 * 1024;
constexpr size_t WT_DFT1 = WT_DFTA + (size_t)512 * 256;
constexpr size_t WT_DFT2 = WT_DFT1 + (size_t)256 * 256;
constexpr size_t WT_DFTC = WT_DFT2 + (size_t)256 * 256;
constexpr size_t WT_END = WT_DFTC + (size_t)256 * 512;
constexpr size_t WS_MOEW = al256(WS_WT + WT_END * 2);
constexpr size_t MOEW_G = 0, MOEW_U = (size_t)32 * 512 * 1024, MOEW_D = (size_t)2 * 32 * 512 * 1024, MOEW_EL = (size_t)3 * 32 * 512 * 1024;
constexpr size_t WS_XRES = al256(WS_MOEW + MOEW_EL * 2);
constexpr size_t WS_H = WS_XRES + (size_t)T * D * 4;
constexpr size_t WS_SCR = WS_H + (size_t)T * D * 2;
constexpr size_t SC_CQ = 0;
constexpr size_t SC_CKV = SC_CQ + (size_t)T * 512 * 2;
constexpr size_t SC_Q = SC_CKV + (size_t)T * 256 * 2;
constexpr size_t SC_K = SC_Q + (size_t)T * 1536 * 2;
constexpr size_t SC_V = SC_K + (size_t)T * 1536 * 2;
constexpr size_t SC_O = SC_V + (size_t)T * 1024 * 2;
constexpr size_t SC_Q8 = SC_O + (size_t)T * 1024 * 2;
constexpr size_t SC_K8 = SC_Q8 + (size_t)T * 1536;
constexpr size_t SC_V8T = SC_K8 + (size_t)T * 1536;
constexpr size_t SC_END_MLA = SC_V8T + (size_t)T * 1024;
constexpr size_t SF_Z = 0;
constexpr size_t SF_ZC = SF_Z + (size_t)2048 * 128 * 256 * 2;
constexpr size_t SF_A1 = SF_ZC + (size_t)2048 * 512 * 2;
constexpr size_t SF_YF = SF_A1 + (size_t)2048 * 128 * 256 * 2;
constexpr size_t SN_Q = 0, SN_K = (size_t)T * 2048, SN_V = (size_t)T * 4096, SN_O = (size_t)T * 6144;
constexpr size_t SS_Q = 0, SS_K = (size_t)T * 2048, SS_V = SS_K + (size_t)T * 512, SS_O = SS_V + (size_t)T * 512;
constexpr size_t SM_ACT = 0;
constexpr size_t SM_Y = (size_t)MOE_SLOTS * 1024;
constexpr size_t SM_END = SM_Y + (size_t)MOE_SLOTS * 2048;
constexpr size_t SCR_BYTES = SC_END_MLA > SM_END ? SC_END_MLA : SM_END;
constexpr size_t WS_END = WS_SCR + SCR_BYTES;

constexpr int LDS_MISC = 152 * 1024;
constexpr int LDS_BYTES = 156 * 1024;

DI unsigned cvt_pk(float lo, float hi) { unsigned r; asm volatile("v_cvt_pk_bf16_f32 %0, %1, %2" : "=v"(r) : "v"(lo), "v"(hi)); return r; }
DI float bf2f(bf16_t x) { return __uint_as_float((unsigned)x << 16); }
DI float bflo(unsigned w) { return __uint_as_float(w << 16); }
DI float bfhi(unsigned w) { return __uint_as_float(w & 0xffff0000u); }
DI float silu_f(float x) { return x / (1.0f + __expf(-x)); }
DI float wave_sum(float v) {
#pragma unroll
    for (int o = 32; o >= 1; o >>= 1) v += __shfl_xor(v, o);
    return v;
}

#define XB_TMO      128
#define XB_XCNT(j)  (256  + 64 * (j))
#define XB_XSUB(j)  (1280 + 64 * (j))
#define XB_XGEN(j)  (2304 + 64 * (j))
#define XB_TOP      3328
#define XB_TOPGEN   3392
#define XCD_BAR_WORDS 3456
#define XB_SPIN_CAP (1u << 18)

__device__ __forceinline__ unsigned xb_ld(unsigned* p)              { return __hip_atomic_load(p, __ATOMIC_RELAXED, __HIP_MEMORY_SCOPE_AGENT); }
__device__ __forceinline__ unsigned xb_add(unsigned* p, unsigned v) { return __hip_atomic_fetch_add(p, v, __ATOMIC_RELAXED, __HIP_MEMORY_SCOPE_AGENT); }
__device__ __forceinline__ unsigned xb_xcc_id() { return (unsigned)__builtin_amdgcn_s_getreg((3 << 11) | 20) & 0xFu; }
#define XB_SPIN(cond, bar) do { unsigned _sp = 0; while (cond) { __builtin_amdgcn_s_sleep(1); \
    if ((++_sp & 255u) == 0u) { if (xb_ld(&(bar)[XB_TMO])) break; if (_sp > XB_SPIN_CAP) { atomicAdd(&(bar)[XB_TMO], 1u); break; } } } } while (0)

struct XcdBarrier {
    unsigned* bar; unsigned x;
    volatile LAS unsigned* st;
};
__device__ __forceinline__ XcdBarrier xcd_barrier_post(unsigned* bar, volatile LAS unsigned* st) {
    XcdBarrier b; b.bar = bar; b.x = xb_xcc_id(); b.st = st;
    if (threadIdx.x == 0) (void)xb_add(&bar[XB_XCNT(b.x)], 1u);
    return b;
}
__device__ __forceinline__ void xcd_barrier_complete(unsigned* bar, unsigned x, unsigned& nloc, unsigned& nx) {
    const unsigned G = gridDim.x * gridDim.y * gridDim.z;
    unsigned sum, cnt, mine, sp = 0u;
    for (;;) {
        sum = 0u; cnt = 0u; mine = 0u;
#pragma unroll
        for (unsigned j = 0; j < 16; ++j) { const unsigned c = xb_ld(&bar[XB_XCNT(j)]); sum += c; cnt += (c > 0u) ? 1u : 0u; mine = (j == x) ? c : mine; }
        if (sum == G) break;
        __builtin_amdgcn_s_sleep(1);
        if ((++sp & 255u) == 0u) { if (xb_ld(&bar[XB_TMO])) break; if (sp > XB_SPIN_CAP) { atomicAdd(&bar[XB_TMO], 1u); break; } }
    }
    nloc = mine > 0u ? mine : 1u; nx = cnt > 0u ? cnt : 1u;
}
__device__ __forceinline__ void xcd_barrier(const XcdBarrier& b) {
    asm volatile("s_waitcnt vmcnt(0)" ::: "memory");
    __syncthreads();
    if (threadIdx.x == 0) {
        unsigned* bar = b.bar;
        __builtin_amdgcn_s_waitcnt(0);
        unsigned nloc = b.st[0], nx = b.st[1];
        if (nloc == 0u) { xcd_barrier_complete(bar, b.x, nloc, nx); b.st[0] = nloc; b.st[1] = nx; }
        const unsigned old = xb_add(&bar[XB_XSUB(b.x)], 1u);
        const unsigned gen = old / nloc;
        if (old + 1u == (gen + 1u) * nloc) {
            __builtin_amdgcn_fence(__ATOMIC_RELEASE, "agent");
            asm volatile("s_waitcnt vmcnt(0)" ::: "memory");
            const unsigned og = xb_add(&bar[XB_TOP], 1u);
            const unsigned tg = og / nx;
            if (og + 1u == (tg + 1u) * nx) xb_add(&bar[XB_TOPGEN], 1u);
            else XB_SPIN(xb_ld(&bar[XB_TOPGEN]) == tg, bar);
            __builtin_amdgcn_fence(__ATOMIC_ACQUIRE, "agent");
            xb_add(&bar[XB_XGEN(b.x)], 1u);
            asm volatile("s_waitcnt vmcnt(0)" ::: "memory");
        } else {
            XB_SPIN(xb_ld(&bar[XB_XGEN(b.x)]) == gen, bar);
            __builtin_amdgcn_fence(__ATOMIC_ACQUIRE, "agent");
            asm volatile("s_waitcnt vmcnt(0)" ::: "memory");
        }
    }
    __syncthreads();
}

namespace g8 {
#ifndef PIN8
#define PIN8 1
#endif
#ifndef G8_MERGE
#define G8_MERGE 0
#endif
constexpr int HTB = 128 * 64 * 2;
constexpr int STAGE_BYTES = 8 * HTB;
DI int lds_byte(int r, int c) { const int st = (r >> 4) * 2 + (c >> 5), rr = r & 15, cc = c & 31, ob = rr * 64 + cc * 2; return st * 1024 + (ob ^ (((ob >> 9) & 1) << 5)); }
DI void stage_rc(int b, int& R, int& C) { const int st = b / 1024, sb = b % 1024, swz = sb ^ (((sb >> 9) & 1) << 5); R = (st >> 1) * 16 + swz / 64; C = (st & 1) * 32 + (swz % 64) / 2; }

typedef f32x4 Acc[2][2][4][2];
typedef int v8i_t __attribute__((ext_vector_type(8)));
DI v8i_t ld8_2x16(const char* p) { const u32x4 a = *reinterpret_cast<const u32x4*>(p), b = *reinterpret_cast<const u32x4*>(p + 16); return (v8i_t){(int)a.x, (int)a.y, (int)a.z, (int)a.w, (int)b.x, (int)b.y, (int)b.z, (int)b.w}; }

struct Opnd { const bf16_t* b0; const bf16_t* b1; int ld; const int* idx; };
DI Opnd opnd(const bf16_t* b0, const bf16_t* b1, int ld) { return Opnd{b0, b1, ld, nullptr}; }
DI Opnd opnd(const bf16_t* b0, int ld) { return Opnd{b0, b0 + (size_t)128 * ld, ld, nullptr}; }
template <bool GATHER, bool HALFX = false, bool FP8 = false, int YSCALE = 127, bool LD16 = true, bool MERGE = (G8_MERGE != 0)>
DI void gemm_unit(const Opnd X, const Opnd Y, const int K, char* lds, Acc& acc) {
    int tid = threadIdx.x; asm volatile("" : "+v"(tid));
    int r0, c0; stage_rc(tid * 16, r0, c0);
    unsigned vx0, vx1, vx2, vx3;
    if (GATHER) { vx0 = (unsigned)(X.idx[r0] * X.ld + c0) * 2u; vx1 = (unsigned)(X.idx[r0 + 64] * X.ld + c0) * 2u;
                  if (HALFX) { vx2 = vx0; vx3 = vx1; } else { vx2 = (unsigned)(X.idx[128 + r0] * X.ld + c0) * 2u; vx3 = (unsigned)(X.idx[192 + r0] * X.ld + c0) * 2u; } }
    else { vx0 = (unsigned)(r0 * X.ld + c0) * 2u; vx1 = vx0; vx2 = vx0; vx3 = vx0; }
    const unsigned vy0 = (unsigned)(r0 * Y.ld + c0) * 2u;
    const size_t xd64 = GATHER ? 0 : (size_t)128 * X.ld, yd64 = (size_t)128 * Y.ld;
    const char* const XB0 = (const char*)X.b0; const char* const XB1 = GATHER ? (const char*)X.b0 : (const char*)X.b1;
    const char* const YB0 = (const char*)Y.b0; const char* const YB1 = (const char*)Y.b1;
    const int wid = tid >> 6, lane = tid & 63, wr = wid >> 2, wc = wid & 3, fr = lane & 15, fq = lane >> 4;
    const int wbase = __builtin_amdgcn_readfirstlane(tid >> 6) * 1024;
    const int swz_ = (fr * 64 + fq * 16) ^ ((((fr * 64 + fq * 16) >> 9) & 1) << 5);
    const char* const abase = lds + wr * 8192 + swz_;
    const char* const bbase = lds + 4 * HTB + wc * 4096 + swz_;
    const int swz8_ = (fr * 64 + (fq & 1) * 32) ^ ((((fr * 64 + (fq & 1) * 32) >> 9) & 1) << 5);
    const char* const abase8 = lds + wr * 8192 + (fq >> 1) * 1024 + swz8_;
    const char* const bbase8 = lds + 4 * HTB + wc * 4096 + (fq >> 1) * 1024 + swz8_;
#define SA(b, h) (lds + ((b) * 2 + (h)) * HTB)
#define SB(b, h) (lds + (4 + (b) * 2 + (h)) * HTB)
#define STG(P, BASE, DELTA, o0, o1, kt) do { const char* _s = (BASE) + (size_t)(kt) * 128; unsigned o0_ = (o0), o1_ = (o1); \
    if (FP8) asm volatile("" : "+v"(o0_), "+v"(o1_));     \
    __builtin_amdgcn_global_load_lds((const unsigned*)(_s + o0_), (unsigned*)((P) + wbase), 16, 0, 0); \
    __builtin_amdgcn_global_load_lds((const unsigned*)(_s + (DELTA) + o1_), (unsigned*)((P) + wbase + 8192), 16, 0, 0); } while (0)
#define STGA(b, h, kt) do { if ((h) == 0) STG(SA(b, 0), XB0, xd64, vx0, vx1, kt); else STG(SA(b, 1), XB1, xd64, vx2, vx3, kt); } while (0)
#define STGB(b, h, kt) do { if ((h) == 0) STG(SB(b, 0), YB0, yd64, vy0, vy0, kt); else STG(SB(b, 1), YB1, yd64, vy0, vy0, kt); } while (0)
#define LD8(P) (LD16 ? ld8_2x16(P) : *reinterpret_cast<const v8i_t*>(P))
#define LDA(dst, b, h) do { if (FP8) { _Pragma("unroll") for (int m = 0; m < 4; ++m) dst##8[m] = LD8(abase8 + (((b) * 2 + (h)) * HTB + m * 2048)); } \
    else { _Pragma("unroll") for (int m = 0; m < 4; ++m) _Pragma("unroll") for (int k = 0; k < 2; ++k) dst[m][k] = *reinterpret_cast<const bf16x8*>(abase + (((b) * 2 + (h)) * HTB + m * 2048 + k * 1024)); } } while (0)
#define LDB(dst, b, h) do { if (FP8) { _Pragma("unroll") for (int n = 0; n < 2; ++n) dst##8[n] = LD8(bbase8 + (((b) * 2 + (h)) * HTB + n * 2048)); } \
    else { _Pragma("unroll") for (int n = 0; n < 2; ++n) _Pragma("unroll") for (int k = 0; k < 2; ++k) dst[n][k] = *reinterpret_cast<const bf16x8*>(bbase + (((b) * 2 + (h)) * HTB + n * 2048 + k * 1024)); } } while (0)
#define MMA(ai, bj, At, Bt) do { if (FP8 && HALFX && (ai) == 1) break; if (FP8) __builtin_amdgcn_sched_barrier(0); __builtin_amdgcn_s_setprio(1); \
    if (FP8) { _Pragma("unroll") for (int m = 0; m < 4; ++m) _Pragma("unroll") for (int n = 0; n < 2; ++n) \
      acc[ai][bj][m][n] = __builtin_amdgcn_mfma_scale_f32_16x16x128_f8f6f4(Bt##8[n], At##8[m], acc[ai][bj][m][n], 0, 0, 0, sc_y, 0, sc_x); } \
    else { _Pragma("unroll") for (int m = 0; m < 4; ++m) _Pragma("unroll") for (int n = 0; n < 2; ++n) _Pragma("unroll") for (int k = 0; k < 2; ++k) \
      acc[ai][bj][m][n] = __builtin_amdgcn_mfma_f32_16x16x32_bf16(Bt[n][k], At[m][k], acc[ai][bj][m][n], 0, 0, 0); } \
    __builtin_amdgcn_s_setprio(0); \
    if (FP8 && PIN8) { asm volatile("" :: "v"(acc[ai][bj][0][0]), "v"(acc[ai][bj][0][1]), "v"(acc[ai][bj][1][0]), "v"(acc[ai][bj][1][1]), "v"(acc[ai][bj][2][0]), "v"(acc[ai][bj][2][1]), "v"(acc[ai][bj][3][0]), "v"(acc[ai][bj][3][1])); \
               __builtin_amdgcn_sched_barrier(0); } } while (0)
#define WAIT_V(n) asm volatile("s_waitcnt vmcnt(" #n ")" ::: "memory")
#define WAIT_L(n) asm volatile("s_waitcnt lgkmcnt(" #n ")" ::: "memory")
#define BAR __builtin_amdgcn_s_barrier()
#define SCHED __builtin_amdgcn_sched_barrier(0)
#pragma unroll
    for (int a = 0; a < 2; ++a)
#pragma unroll
        for (int b = 0; b < 2; ++b)
#pragma unroll
            for (int m = 0; m < 4; ++m)
#pragma unroll
                for (int n = 0; n < 2; ++n) acc[a][b][m][n] = (f32x4){0.f, 0.f, 0.f, 0.f};
    bf16x8 At[4][2], B0[2][2], B1[2][2];
    v8i_t At8[4], B08[2], B18[2];
    int sc_y = YSCALE * 0x01010101; if (FP8) asm volatile("" : "+v"(sc_y));
    const int sc_x = sc_y;
    int nt = K / 64; if (FP8) asm volatile("" : "+s"(nt));
    STGB(0, 0, 0); STGA(0, 0, 0); STGB(0, 1, 0); STGA(0, 1, 0);
    if constexpr (FP8 && MERGE) { STGB(1, 0, 1); STGA(1, 0, 1); STGB(1, 1, 1); WAIT_V(6); BAR; if (wr == 1) BAR; }
    else {
    if (wr == 1) BAR;
    WAIT_V(4); BAR;
    STGB(1, 0, 1); STGA(1, 0, 1); STGB(1, 1, 1);
    WAIT_V(6); BAR;
    }
    if constexpr (FP8 && MERGE) {
#pragma unroll 1
    for (int t = 0; t < nt - 2; t += 2) {
        LDB(B0, 0, 0); LDB(B1, 0, 1); SCHED; LDA(At, 0, 0); SCHED; STGA(1, 1, t + 1);
        WAIT_L(0); BAR; MMA(0, 0, At, B0); MMA(0, 1, At, B1); BAR; SCHED;
        LDA(At, 0, 1); SCHED; STGB(0, 0, t + 2); STGA(0, 0, t + 2); STGB(0, 1, t + 2);
        WAIT_V(6); WAIT_L(0); BAR; MMA(1, 0, At, B0); MMA(1, 1, At, B1); BAR; SCHED;
        LDB(B0, 1, 0); LDB(B1, 1, 1); SCHED; LDA(At, 1, 0); SCHED; STGA(0, 1, t + 2);
        WAIT_L(0); BAR; MMA(0, 0, At, B0); MMA(0, 1, At, B1); BAR; SCHED;
        LDA(At, 1, 1); SCHED; STGB(1, 0, t + 3); STGA(1, 0, t + 3); STGB(1, 1, t + 3);
        WAIT_V(6); WAIT_L(0); BAR; MMA(1, 0, At, B0); MMA(1, 1, At, B1); BAR; SCHED;
    }
    { LDB(B0, 0, 0); LDB(B1, 0, 1); SCHED; LDA(At, 0, 0); SCHED; STGA(1, 1, nt - 1);
      WAIT_L(0); BAR; MMA(0, 0, At, B0); MMA(0, 1, At, B1); BAR; SCHED;
      LDA(At, 0, 1); WAIT_V(0); WAIT_L(0); BAR; MMA(1, 0, At, B0); MMA(1, 1, At, B1); BAR; SCHED; }
    { LDB(B0, 1, 0); LDB(B1, 1, 1); SCHED; LDA(At, 1, 0);
      WAIT_L(0); BAR; MMA(0, 0, At, B0); MMA(0, 1, At, B1); BAR; SCHED;
      LDA(At, 1, 1); WAIT_L(0); BAR; MMA(1, 0, At, B0); MMA(1, 1, At, B1); BAR; }
    } else {
#pragma unroll 1
    for (int t = 0; t < nt - 2; t += 2) {
        LDB(B0, 0, 0); SCHED; LDA(At, 0, 0); STGA(1, 1, t + 1);
        WAIT_L(8); BAR; WAIT_L(0); MMA(0, 0, At, B0); BAR; SCHED;
        LDB(B1, 0, 1); STGB(0, 0, t + 2);
        BAR; WAIT_L(0); MMA(0, 1, At, B1); BAR;
        LDA(At, 0, 1); STGA(0, 0, t + 2);
        BAR; WAIT_L(0); MMA(1, 0, At, B0); BAR; SCHED;
        STGB(0, 1, t + 2);
        WAIT_V(6); BAR; MMA(1, 1, At, B1); BAR;
        LDB(B0, 1, 0); SCHED; LDA(At, 1, 0); STGA(0, 1, t + 2);
        WAIT_L(8); BAR; WAIT_L(0); MMA(0, 0, At, B0); BAR; SCHED;
        LDB(B1, 1, 1); STGB(1, 0, t + 3);
        BAR; WAIT_L(0); MMA(0, 1, At, B1); BAR;
        LDA(At, 1, 1); STGA(1, 0, t + 3);
        BAR; WAIT_L(0); MMA(1, 0, At, B0); BAR; SCHED;
        STGB(1, 1, t + 3);
        WAIT_V(6); BAR; MMA(1, 1, At, B1); BAR;
    }
    { LDB(B0, 0, 0); WAIT_V(0); LDA(At, 0, 0); STGA(1, 1, nt - 1);
      BAR; WAIT_L(0); MMA(0, 0, At, B0); BAR;
      LDB(B1, 0, 1); BAR; WAIT_L(0); MMA(0, 1, At, B1); BAR;
      LDA(At, 0, 1); WAIT_V(4); BAR; WAIT_L(0); MMA(1, 0, At, B0); MMA(1, 1, At, B1); BAR; }
    { LDB(B0, 1, 0); LDA(At, 1, 0); WAIT_V(2); BAR; WAIT_L(0); MMA(0, 0, At, B0); BAR;
      LDB(B1, 1, 1); WAIT_V(0); BAR; WAIT_L(0); MMA(0, 1, At, B1); BAR;
      LDA(At, 1, 1); BAR; WAIT_L(0); MMA(1, 0, At, B0); MMA(1, 1, At, B1); BAR; }
    }
    if (wr == 0) BAR;
#undef SA
#undef SB
#undef STG
#undef STGA
#undef STGB
#undef LDA
#undef LDB
#undef MMA
#undef LD8
}
}

struct LaneC { int wr, wc, fr, fq; };
DI LaneC lane_coords() { int tid = threadIdx.x; asm volatile("" : "+v"(tid)); const int wid = tid >> 6, lane = tid & 63; return LaneC{wid >> 2, wid & 3, lane & 15, lane >> 4}; }
#define EPI_R(ai, m) ((ai) * 128 + L.wr * 64 + (m) * 16 + L.fr)
#define EPI_S(bj, n) ((bj) * 128 + L.wc * 32 + (n) * 16 + 4 * L.fq)
DI void st_bf4(bf16_t* p, f32x4 v) { u32x2 w; w.x = cvt_pk(v[0], v[1]); w.y = cvt_pk(v[2], v[3]); *(u32x2*)p = w; }
DI unsigned pk4_fp8(float a, float b, float c, float d) { int w = __builtin_amdgcn_cvt_pk_fp8_f32(a, b, 0, false); w = __builtin_amdgcn_cvt_pk_fp8_f32(c, d, w, true); return (unsigned)w; }
DI unsigned pk4_fp8o(float a, float b, float c, float d) { int w = __builtin_amdgcn_cvt_pk_fp8_f32(a, b, (int)__float_as_uint(a), false); w = __builtin_amdgcn_cvt_pk_fp8_f32(c, d, w, true); return (unsigned)w; }
DI void st_fp8x4(unsigned char* p, f32x4 v) { *(unsigned*)p = pk4_fp8(v[0], v[1], v[2], v[3]); }
DI unsigned char fp8_1(float x) { return (unsigned char)(__builtin_amdgcn_cvt_pk_fp8_f32(x, 0.f, 0, false) & 0xff); }
DI const bf16_t* as_h(const unsigned char* p) { return (const bf16_t*)p; }
namespace at {
DI int crow(int r, int hi) { return (r & 3) + 8 * (r >> 2) + 4 * hi; }
template <int OFF> DI s16x4 tr_read(unsigned a) { s16x4 r; asm volatile("ds_read_b64_tr_b16 %0, %1 offset:%2" : "=&v"(r) : "v"(a), "i"(OFF) : "memory"); return r; }
#define AT_PK4(P, BASE, OUT) do { unsigned a0 = cvt_pk(P[BASE + 0], P[BASE + 1]), a1 = cvt_pk(P[BASE + 2], P[BASE + 3]); \
    unsigned b0 = cvt_pk(P[BASE + 4], P[BASE + 5]), b1 = cvt_pk(P[BASE + 6], P[BASE + 7]); \
    auto r0 = __builtin_amdgcn_permlane32_swap(a0, b0, false, false); auto r1 = __builtin_amdgcn_permlane32_swap(a1, b1, false, false); \
    u32x4 w = {r0[0], r1[0], r0[1], r1[1]}; OUT = __builtin_bit_cast(bf16x8, w); } while (0)

template <int DV, int VROW, int D0> DI void pv_one(f32x16& od, unsigned vb, bf16x8 pa0, bf16x8 pa1, bf16x8 pa2, bf16x8 pa3) {
    const s16x4 l0 = tr_read<(0 * 16) * VROW + 64 * D0>(vb), h0 = tr_read<(0 * 16 + 4) * VROW + 64 * D0>(vb);
    const s16x4 l1 = tr_read<(1 * 16) * VROW + 64 * D0>(vb), h1 = tr_read<(1 * 16 + 4) * VROW + 64 * D0>(vb);
    const s16x4 l2 = tr_read<(2 * 16) * VROW + 64 * D0>(vb), h2 = tr_read<(2 * 16 + 4) * VROW + 64 * D0>(vb);
    const s16x4 l3 = tr_read<(3 * 16) * VROW + 64 * D0>(vb), h3 = tr_read<(3 * 16 + 4) * VROW + 64 * D0>(vb);
    asm volatile("s_waitcnt lgkmcnt(0)" ::: "memory"); __builtin_amdgcn_sched_barrier(0);
#define AT_PK(Lo, Hi) (bf16x8){Lo[0], Lo[1], Lo[2], Lo[3], Hi[0], Hi[1], Hi[2], Hi[3]}
    od = __builtin_amdgcn_mfma_f32_32x32x16_bf16(pa0, AT_PK(l0, h0), od, 0, 0, 0);
    od = __builtin_amdgcn_mfma_f32_32x32x16_bf16(pa1, AT_PK(l1, h1), od, 0, 0, 0);
    od = __builtin_amdgcn_mfma_f32_32x32x16_bf16(pa2, AT_PK(l2, h2), od, 0, 0, 0);
    od = __builtin_amdgcn_mfma_f32_32x32x16_bf16(pa3, AT_PK(l3, h3), od, 0, 0, 0);
#undef AT_PK
}

template <int DQK, int DV, class Cfg>
DI void attn_unit(const Cfg& cfg, char* lds, const float* tbl) {
    constexpr int KROW = DQK * 2 + 16, VROW = DV * 2 + 16, KCH = DQK / 8, VCH = DV / 8, NKL = 64 * KCH / NTHR, NVL = 64 * VCH / NTHR, ND = DQK / 16, NO = DV / 32;
    static_assert(64 * KCH % NTHR == 0 && 64 * VCH % NTHR == 0, "staging split");
    const int tid = threadIdx.x, lane = tid & 63, r32 = lane & 31, hi = lane >> 5;
    const int wave = __builtin_amdgcn_readfirstlane(tid >> 6);
    char* Ks = lds; char* Vs = lds + 64 * KROW; float* al = (float*)(lds + 64 * KROW + 64 * VROW) + wave * 64;
    bf16x8 qr[ND];
    { const bf16_t* qp = cfg.qrow(wave, r32) + hi * 8;
#pragma unroll
      for (int d0 = 0; d0 < ND; ++d0) qr[d0] = *reinterpret_cast<const bf16x8*>(qp + d0 * 16); }
    f32x16 o[NO];
#pragma unroll
    for (int d = 0; d < NO; ++d)
#pragma unroll
        for (int r = 0; r < 16; ++r) o[d][r] = 0.f;
    float m_reg = cfg.m0(), l_reg = cfg.l0();
    const float C = cfg.cexp();
    const int NT = cfg.ntiles(), ldk = cfg.ldk(), ldv = cfg.ldv();
    bf16x8 kreg[NKL], vreg[NVL];
    const unsigned vb = (unsigned)(uintptr_t)Vs + (unsigned)((8 * hi + ((lane & 15) >> 2)) * VROW + (16 * ((lane >> 4) & 1) + 4 * (lane & 3)) * 2);
#define AT_LOAD(t) do { const bf16_t* kp = cfg.ktile(t); const bf16_t* vp = cfg.vtile(t); \
    _Pragma("unroll") for (int i = 0; i < NKL; ++i) { const int c = tid + NTHR * i, row = c / KCH, cc = c % KCH; kreg[i] = *reinterpret_cast<const bf16x8*>(kp + (long)row * ldk + cc * 8); } \
    _Pragma("unroll") for (int i = 0; i < NVL; ++i) { const int c = tid + NTHR * i, row = c / VCH, cc = c % VCH; vreg[i] = *reinterpret_cast<const bf16x8*>(vp + (long)row * ldv + cc * 8); } } while (0)
    AT_LOAD(0);
    for (int t = 0; t < NT; ++t) {
        __syncthreads();
#pragma unroll
        for (int i = 0; i < NKL; ++i) { const int c = tid + NTHR * i, row = c / KCH, cc = c % KCH; *reinterpret_cast<bf16x8*>(Ks + row * KROW + cc * 16) = kreg[i]; }
#pragma unroll
        for (int i = 0; i < NVL; ++i) { const int c = tid + NTHR * i, row = c / VCH, cc = c % VCH; *reinterpret_cast<bf16x8*>(Vs + row * VROW + cc * 16) = vreg[i]; }
        __syncthreads();
        if (t + 1 < NT) AT_LOAD(t + 1);
        if (cfg.active(t, wave)) {
            f32x16 p0, p1;
            cfg.init(p0, p1, t, wave, r32, hi, tbl);
#pragma unroll
            for (int d0 = 0; d0 < ND; ++d0) {
                const int cb = (d0 * 16 + hi * 8) * 2;
                const bf16x8 b0 = *reinterpret_cast<const bf16x8*>(Ks + r32 * KROW + cb);
                const bf16x8 b1 = *reinterpret_cast<const bf16x8*>(Ks + (32 + r32) * KROW + cb);
                p0 = __builtin_amdgcn_mfma_f32_32x32x16_bf16(b0, qr[d0], p0, 0, 0, 0);
                p1 = __builtin_amdgcn_mfma_f32_32x32x16_bf16(b1, qr[d0], p1, 0, 0, 0);
            }
            cfg.mask(p0, p1, t, wave, r32, hi, tbl);
            float pmax = p0[0];
#pragma unroll
            for (int r = 1; r < 16; ++r) pmax = fmaxf(pmax, p0[r]);
#pragma unroll
            for (int r = 0; r < 16; ++r) pmax = fmaxf(pmax, p1[r]);
            { auto rr = __builtin_amdgcn_permlane32_swap(__float_as_uint(pmax), __float_as_uint(pmax), false, false);
              pmax = fmaxf(__uint_as_float(rr[0]), __uint_as_float(rr[1])); }
            const float mn = fmaxf(m_reg, pmax);
            const float alpha = __builtin_amdgcn_exp2f((m_reg - mn) * C);
            m_reg = mn;
            const float mnC = -mn * C;
            float ps = 0.f;
#pragma unroll
            for (int r = 0; r < 16; ++r) { p0[r] = __builtin_amdgcn_exp2f(fmaf(p0[r], C, mnC)); ps += p0[r]; }
#pragma unroll
            for (int r = 0; r < 16; ++r) { p1[r] = __builtin_amdgcn_exp2f(fmaf(p1[r], C, mnC)); ps += p1[r]; }
            { auto rr = __builtin_amdgcn_permlane32_swap(__float_as_uint(ps), __float_as_uint(ps), false, false);
              ps = __uint_as_float(rr[0]) + __uint_as_float(rr[1]); }
            l_reg = l_reg * alpha + ps;
            if (__any(alpha < 1.f)) {
                if (hi == 0) al[r32] = alpha;
                asm volatile("s_waitcnt lgkmcnt(0)" ::: "memory");
#pragma unroll
                for (int r = 0; r < 16; ++r) { const float a = al[crow(r, hi)];
#pragma unroll
                    for (int d = 0; d < NO; ++d) o[d][r] *= a; }
            }
            bf16x8 pa0, pa1, pa2, pa3;
            AT_PK4(p0, 0, pa0); AT_PK4(p0, 8, pa1); AT_PK4(p1, 0, pa2); AT_PK4(p1, 8, pa3);
            pv_one<DV, VROW, 0>(o[0], vb, pa0, pa1, pa2, pa3);
            pv_one<DV, VROW, 1>(o[1], vb, pa0, pa1, pa2, pa3);
            if constexpr (NO > 2) { pv_one<DV, VROW, 2>(o[2], vb, pa0, pa1, pa2, pa3); pv_one<DV, VROW, 3>(o[3], vb, pa0, pa1, pa2, pa3); }
        }
    }
#undef AT_LOAD
    if (hi == 0) al[32 + r32] = l_reg;
    asm volatile("s_waitcnt lgkmcnt(0)" ::: "memory");
#pragma unroll
    for (int r = 0; r < 16; ++r) {
        const int orow_ = crow(r, hi);
        const float li = 1.0f / al[32 + orow_];
        bf16_t* op = cfg.orow(wave, orow_);
#pragma unroll
        for (int d = 0; d < NO; ++d) { if (WO_FP8) ((unsigned char*)cfg.O + (op - cfg.O))[d * 32 + r32] = fp8_1(o[d][r] * li * 64.f);
            else op[d * 32 + r32] = (bf16_t)(cvt_pk(o[d][r] * li, 0.f) & 0xffffu); }
    }
    __syncthreads();
}
constexpr int attn_lds_bytes(int dqk, int dv) { return 64 * (dqk * 2 + 16) + 64 * (dv * 2 + 16) + 8 * 64 * 4; }
}
namespace at {
struct MlaGeo { static constexpr int KROW = 384, VROW = 256, KB = 64 * KROW, VB = 64 * VROW; };
template <int D0> DI void mla_pv_issue(unsigned vb, s16x4 (&t)[8]) {
    t[0] = tr_read<(0 * 16) * MlaGeo::VROW>(vb); t[1] = tr_read<(0 * 16 + 4) * MlaGeo::VROW>(vb);
    t[2] = tr_read<(1 * 16) * MlaGeo::VROW>(vb); t[3] = tr_read<(1 * 16 + 4) * MlaGeo::VROW>(vb);
    t[4] = tr_read<(2 * 16) * MlaGeo::VROW>(vb); t[5] = tr_read<(2 * 16 + 4) * MlaGeo::VROW>(vb);
    t[6] = tr_read<(3 * 16) * MlaGeo::VROW>(vb); t[7] = tr_read<(3 * 16 + 4) * MlaGeo::VROW>(vb);
}
DI void mla_pv_mma(f32x16& od, const s16x4 (&t)[8], bf16x8 pa0, bf16x8 pa1, bf16x8 pa2, bf16x8 pa3) {
#define AT_PK(Lo, Hi) (bf16x8){Lo[0], Lo[1], Lo[2], Lo[3], Hi[0], Hi[1], Hi[2], Hi[3]}
    od = __builtin_amdgcn_mfma_f32_32x32x16_bf16(pa0, AT_PK(t[0], t[1]), od, 0, 0, 0);
    od = __builtin_amdgcn_mfma_f32_32x32x16_bf16(pa1, AT_PK(t[2], t[3]), od, 0, 0, 0);
    od = __builtin_amdgcn_mfma_f32_32x32x16_bf16(pa2, AT_PK(t[4], t[5]), od, 0, 0, 0);
    od = __builtin_amdgcn_mfma_f32_32x32x16_bf16(pa3, AT_PK(t[6], t[7]), od, 0, 0, 0);
#undef AT_PK
}
template <int PRB>
DI void mla_attn_unit(const bf16_t* __restrict__ qp0, const bf16_t* __restrict__ kp0, const bf16_t* __restrict__ vp0, bf16_t* __restrict__ op0, const int NT, char* lds) {
    constexpr int KROW = MlaGeo::KROW, VROW = MlaGeo::VROW, KB = MlaGeo::KB, VB = MlaGeo::VB, LDK = 1536, LDV = 1024, LDQ = 1536, LDO = 1024;
    const int tid = threadIdx.x, lane = tid & 63, r32 = lane & 31, hi = lane >> 5;
    const int wave = __builtin_amdgcn_readfirstlane(tid >> 6);
    const bool grpB = wave >= 4;
    char* const Kb = lds; char* const Vb = lds + 3 * KB;
    float* al = (float*)(lds + 3 * KB + 3 * VB) + wave * 64;
    const float C = 0.07216878364870322f * 1.4426950408889634f;
    bf16x8 qr[12];
    { const bf16_t* qp = qp0 + (size_t)(32 * wave + r32) * LDQ + hi * 8;
#pragma unroll
      for (int d0 = 0; d0 < 12; ++d0) qr[d0] = *reinterpret_cast<const bf16x8*>(qp + d0 * 16); }
    f32x16 o[4];
#pragma unroll
    for (int d = 0; d < 4; ++d)
#pragma unroll
        for (int r = 0; r < 16; ++r) o[d][r] = 0.f;
    float m_reg = -1e28f, l_reg = 0.f;
    unsigned kg0, kg1, kg2, vg0, vg1;
    { const int pa_ = wave * 64 + lane, pb_ = pa_ + 512, pc_ = pa_ + 1024;
      const int ra = pa_ / 24, sa = pa_ % 24, rb = pb_ / 24, sb = pb_ % 24, rc = pc_ / 24, sc_ = pc_ % 24;
      kg0 = (unsigned)(ra * LDK * 2 + ((sa & ~7) | ((sa & 7) ^ ((ra >> 1) & 7))) * 16);
      kg1 = (unsigned)(rb * LDK * 2 + ((sb & ~7) | ((sb & 7) ^ ((rb >> 1) & 7))) * 16);
      kg2 = (unsigned)(rc * LDK * 2 + ((sc_ & ~7) | ((sc_ & 7) ^ ((rc >> 1) & 7))) * 16);
      const int va = pa_ / 16, wa = pa_ % 16, vb2 = pb_ / 16, wb = pb_ % 16;
      vg0 = (unsigned)(va * LDV * 2 + (wa ^ ((va & 3) << 2)) * 16);
      vg1 = (unsigned)(vb2 * LDV * 2 + (wb ^ ((vb2 & 3) << 2)) * 16); }
    const int wdst = wave * 1024;
    int kx[4];
#pragma unroll
    for (int d = 0; d < 4; ++d) kx[d] = r32 * KROW + (((2 * d + hi) ^ ((r32 >> 1) & 7)) * 16);
    unsigned vx[4];
    { const int q = (lane & 15) >> 2;
#pragma unroll
      for (int d = 0; d < 4; ++d) vx[d] = (unsigned)((8 * hi + q) * VROW + 64 * (d ^ q) + 32 * ((lane >> 4) & 1) + 8 * (lane & 3)); }
#define MLA_STAGE(t) do { const int t_ = (t); if (PRB == 2) break; \
    if (t_ < NT) { const char* kb_ = (const char*)kp0 + (size_t)t_ * (64 * LDK * 2); char* kd_ = Kb + (t_ % 3) * KB + wdst; \
        __builtin_amdgcn_global_load_lds((const unsigned*)(kb_ + kg0), (unsigned*)(kd_), 16, 0, 0); \
        __builtin_amdgcn_global_load_lds((const unsigned*)(kb_ + kg1), (unsigned*)(kd_ + 8192), 16, 0, 0); \
        __builtin_amdgcn_global_load_lds((const unsigned*)(kb_ + kg2), (unsigned*)(kd_ + 16384), 16, 0, 0); } \
    if (t_ >= 1) { const char* vb_ = (const char*)vp0 + (size_t)(t_ - 1) * (64 * LDV * 2); char* vd_ = Vb + ((t_ - 1) % 3) * VB + wdst; \
        __builtin_amdgcn_global_load_lds((const unsigned*)(vb_ + vg0), (unsigned*)(vd_), 16, 0, 0); \
        __builtin_amdgcn_global_load_lds((const unsigned*)(vb_ + vg1), (unsigned*)(vd_ + 8192), 16, 0, 0); } } while (0)
#define MLA_BAR(nyoung) do { const int ny_ = (nyoung); if (ny_ >= 5) asm volatile("s_waitcnt vmcnt(5)" ::: "memory"); else if (ny_ >= 2) asm volatile("s_waitcnt vmcnt(2)" ::: "memory"); \
    else asm volatile("s_waitcnt vmcnt(0)" ::: "memory"); \
    asm volatile("s_waitcnt lgkmcnt(0)" ::: "memory"); __builtin_amdgcn_s_barrier(); asm volatile("" ::: "memory"); } while (0)
#define MLA_NY(j_) ((j_) + 2 < NT ? 5 : ((j_) + 2 == NT ? 2 : 0))
#define MLA_PVALL(VBUF) do { const unsigned v0_ = (unsigned)(uintptr_t)(VBUF); s16x4 ta[8], tb[8]; \
    mla_pv_issue<0>(v0_ + vx[0], ta); mla_pv_issue<1>(v0_ + vx[1], tb); \
    asm volatile("s_waitcnt lgkmcnt(8)" ::: "memory"); __builtin_amdgcn_sched_barrier(0); \
    mla_pv_mma(o[0], ta, pa0, pa1, pa2, pa3); __builtin_amdgcn_sched_barrier(0); \
    mla_pv_issue<2>(v0_ + vx[2], ta); \
    asm volatile("s_waitcnt lgkmcnt(8)" ::: "memory"); __builtin_amdgcn_sched_barrier(0); \
    mla_pv_mma(o[1], tb, pa0, pa1, pa2, pa3); __builtin_amdgcn_sched_barrier(0); \
    mla_pv_issue<3>(v0_ + vx[3], tb); \
    asm volatile("s_waitcnt lgkmcnt(8)" ::: "memory"); __builtin_amdgcn_sched_barrier(0); \
    mla_pv_mma(o[2], ta, pa0, pa1, pa2, pa3); \
    asm volatile("s_waitcnt lgkmcnt(0)" ::: "memory"); __builtin_amdgcn_sched_barrier(0); \
    mla_pv_mma(o[3], tb, pa0, pa1, pa2, pa3); } while (0)
    f32x16 p0, p1; bf16x8 pa0, pa1, pa2, pa3;
    MLA_STAGE(0); MLA_STAGE(1);
    MLA_BAR(0);
    if (grpB) { MLA_STAGE(2); MLA_BAR(NT > 2 ? 5 : 2); }
    for (int j = 0; j < NT; ++j) {
        {
            const char* Ks = Kb + (j % 3) * KB;
            const unsigned v0_ = (unsigned)(uintptr_t)(Vb + ((j + 2) % 3) * VB);
            s16x4 ta[8], tb[8];
#pragma unroll
            for (int r = 0; r < 16; ++r) { p0[r] = 0.f; p1[r] = 0.f; }
            bf16x8 f0[12], f1[12];
#pragma unroll
            for (int d = 0; d < 3; ++d) { f0[d] = *reinterpret_cast<const bf16x8*>(Ks + kx[d & 3] + 128 * (d >> 2)); f1[d] = *reinterpret_cast<const bf16x8*>(Ks + kx[d & 3] + 128 * (d >> 2) + 32 * KROW); }
            __builtin_amdgcn_sched_barrier(0);
            if (!grpB && j + 2 <= NT) MLA_STAGE(j + 2);
            __builtin_amdgcn_sched_barrier(0);
#pragma unroll
            for (int d0 = 0; d0 < 12; ++d0) {
                if (d0 + 3 < 12) { f0[d0 + 3] = *reinterpret_cast<const bf16x8*>(Ks + kx[(d0 + 3) & 3] + 128 * ((d0 + 3) >> 2)); f1[d0 + 3] = *reinterpret_cast<const bf16x8*>(Ks + kx[(d0 + 3) & 3] + 128 * ((d0 + 3) >> 2) + 32 * KROW); }
                if (d0 == 9 && j > 0 && PRB != 4) { mla_pv_issue<0>(v0_ + vx[0], ta); mla_pv_issue<1>(v0_ + vx[1], tb); }
                if (PRB != 3 || d0 == 0) { p0 = __builtin_amdgcn_mfma_f32_32x32x16_bf16(f0[d0], qr[d0], p0, 0, 0, 0);
                p1 = __builtin_amdgcn_mfma_f32_32x32x16_bf16(f1[d0], qr[d0], p1, 0, 0, 0); }
                __builtin_amdgcn_sched_barrier(0);
            }
            if (j > 0 && PRB != 4) {
                asm volatile("s_waitcnt lgkmcnt(8)" ::: "memory"); __builtin_amdgcn_sched_barrier(0);
                mla_pv_mma(o[0], ta, pa0, pa1, pa2, pa3); __builtin_amdgcn_sched_barrier(0);
                mla_pv_issue<2>(v0_ + vx[2], ta);
                asm volatile("s_waitcnt lgkmcnt(8)" ::: "memory"); __builtin_amdgcn_sched_barrier(0);
                mla_pv_mma(o[1], tb, pa0, pa1, pa2, pa3); __builtin_amdgcn_sched_barrier(0);
                mla_pv_issue<3>(v0_ + vx[3], tb);
                asm volatile("s_waitcnt lgkmcnt(8)" ::: "memory"); __builtin_amdgcn_sched_barrier(0);
                mla_pv_mma(o[2], ta, pa0, pa1, pa2, pa3);
                asm volatile("s_waitcnt lgkmcnt(0)" ::: "memory"); __builtin_amdgcn_sched_barrier(0);
                mla_pv_mma(o[3], tb, pa0, pa1, pa2, pa3);
            }
        }
        MLA_BAR(MLA_NY(j));
        if (grpB && j + 3 <= NT) MLA_STAGE(j + 3);
        {
            float pmax = p0[0];
#pragma unroll
            for (int r = 1; r < 16; ++r) pmax = fmaxf(pmax, p0[r]);
#pragma unroll
            for (int r = 0; r < 16; ++r) pmax = fmaxf(pmax, p1[r]);
            { auto rr = __builtin_amdgcn_permlane32_swap(__float_as_uint(pmax), __float_as_uint(pmax), false, false);
              pmax = fmaxf(__uint_as_float(rr[0]), __uint_as_float(rr[1])); }
            const float mn = fmaxf(m_reg, pmax);
            const float alpha = __builtin_amdgcn_exp2f((m_reg - mn) * C);
            m_reg = mn;
            const float mnC = -mn * C;
            float ps = 0.f;
#pragma unroll
            for (int r = 0; r < 16; ++r) { p0[r] = PRB == 1 ? fmaf(p0[r], C, mnC) : __builtin_amdgcn_exp2f(fmaf(p0[r], C, mnC)); ps += p0[r]; }
#pragma unroll
            for (int r = 0; r < 16; ++r) { p1[r] = PRB == 1 ? fmaf(p1[r], C, mnC) : __builtin_amdgcn_exp2f(fmaf(p1[r], C, mnC)); ps += p1[r]; }
            { auto rr = __builtin_amdgcn_permlane32_swap(__float_as_uint(ps), __float_as_uint(ps), false, false);
              ps = __uint_as_float(rr[0]) + __uint_as_float(rr[1]); }
            l_reg = l_reg * alpha + ps;
            if (__any(alpha < 1.f)) {
                if (hi == 0) al[r32] = alpha;
                asm volatile("s_waitcnt lgkmcnt(0)" ::: "memory");
#pragma unroll
                for (int r = 0; r < 16; ++r) { const float a_ = al[crow(r, hi)];
#pragma unroll
                    for (int d = 0; d < 4; ++d) o[d][r] *= a_; }
            }
            AT_PK4(p0, 0, pa0); AT_PK4(p0, 8, pa1); AT_PK4(p1, 0, pa2); AT_PK4(p1, 8, pa3);
        }
        MLA_BAR(MLA_NY(j));
    }
    MLA_PVALL(Vb + ((NT - 1) % 3) * VB);
    if (!grpB) MLA_BAR(0);
    if (hi == 0) al[32 + r32] = l_reg;
    asm volatile("s_waitcnt lgkmcnt(0)" ::: "memory");
#pragma unroll
    for (int r = 0; r < 16; ++r) {
        const int orow_ = crow(r, hi);
        const float li = 1.0f / al[32 + orow_];
        bf16_t* op = op0 + (size_t)(32 * wave + orow_) * LDO;
#pragma unroll
        for (int d = 0; d < 4; ++d) op[d * 32 + r32] = (bf16_t)(cvt_pk(o[d][r] * li, 0.f) & 0xffffu);
    }
    __syncthreads();
#undef MLA_STAGE
#undef MLA_BAR
#undef MLA_NY
#undef MLA_PVALL
}
}
namespace at {
typedef int v8i __attribute__((ext_vector_type(8)));
DI f32x16 mfma8(v8i a, v8i b, f32x16 c, int sa, int sb) { return __builtin_amdgcn_mfma_scale_f32_32x32x64_f8f6f4(a, b, c, 0, 0, 0, sa, 0, sb); }
DI v8i ld_frag(const char* p0, const char* p1) { const u32x4 a = *(const u32x4*)p0, b = *(const u32x4*)p1; return (v8i){(int)a.x, (int)a.y, (int)a.z, (int)a.w, (int)b.x, (int)b.y, (int)b.z, (int)b.w}; }
template <int PRB>
DI void mla_attn_unit_fp8(const unsigned char* __restrict__ qp0, const unsigned char* __restrict__ kp0, const unsigned char* __restrict__ vp0, bf16_t* __restrict__ op0, const int NT, char* lds) {
    constexpr int KB8 = 64 * 256, VB8 = 128 * 64, LDK = 1536, LDO = 1024;
    int tid = threadIdx.x; asm volatile("" : "+v"(tid));
    const int lane = tid & 63, r32 = lane & 31, hi = lane >> 5;
    const int wave = __builtin_amdgcn_readfirstlane(tid >> 6);
    const bool grpB = wave >= 4;
    char* const Kb = lds; char* const Vb = lds + 3 * KB8;
    float* al = (float*)(lds + 3 * KB8 + 3 * VB8) + wave * 64;
    const float C = 0.07216878364870322f * 1.4426950408889634f;
    v8i qf[3];
    { const unsigned char* qp = qp0 + (size_t)(32 * wave + r32) * LDK + 32 * hi;
#pragma unroll
      for (int c = 0; c < 3; ++c) qf[c] = ld_frag((const char*)qp + 64 * c, (const char*)qp + 64 * c + 16); }
    f32x16 o[4];
#pragma unroll
    for (int d = 0; d < 4; ++d)
#pragma unroll
        for (int r = 0; r < 16; ++r) o[d][r] = 0.f;
    float m_reg = -1e28f, l_reg = 0.f;
    int s1 = 0x7f7f7f7f; asm volatile("" : "+v"(s1)); const int sp = s1 & 0x7b7b7b7b;
    unsigned kg0, kg1, vg0;
    { const int pa_ = wave * 64 + lane, pb_ = pa_ + 512;
      const int ra = pa_ >> 4, qa = (pa_ & 15) ^ (2 * (ra & 7) + ((ra >> 3) & 1)), rb = pb_ >> 4, qb = (pb_ & 15) ^ (2 * (rb & 7) + ((rb >> 3) & 1));
      kg0 = (unsigned)(ra * LDK + (qa < 12 ? qa * 16 : 0)); kg1 = (unsigned)(rb * LDK + (qb < 12 ? qb * 16 : 0));
      const int vr = pa_ >> 2, vq = (pa_ & 3) ^ (2 * ((vr >> 2) & 1) + ((vr >> 3) & 1));
      vg0 = (unsigned)((size_t)vr * T + vq * 16); }
    const int wdst = wave * 1024;
    const int hs = (r32 >> 3) & 1, hdl = 16 - 32 * hs;
    int kxa[3];
#pragma unroll
    for (int c = 0; c < 3; ++c) kxa[c] = r32 * 256 + (((2 * c + hi) ^ (r32 & 7)) * 32) + 16 * hs;
    const int vxa = r32 * 64 + ((hi ^ ((r32 >> 2) & 1)) * 32) + 16 * hs;
#define M8_STAGE(t) do { const int t_ = (t); \
    if (t_ < NT) { const char* kb_ = (const char*)kp0 + (size_t)t_ * (64 * LDK); char* kd_ = Kb + (t_ % 3) * KB8 + wdst; \
        __builtin_amdgcn_global_load_lds((const unsigned*)(kb_ + kg0), (unsigned*)(kd_), 16, 0, 0); \
        __builtin_amdgcn_global_load_lds((const unsigned*)(kb_ + kg1), (unsigned*)(kd_ + 8192), 16, 0, 0); } \
    if (t_ >= 1) { const char* vb_ = (const char*)vp0 + (size_t)(t_ - 1) * 64; \
        __builtin_amdgcn_global_load_lds((const unsigned*)(vb_ + vg0), (unsigned*)(Vb + ((t_ - 1) % 3) * VB8 + wdst), 16, 0, 0); } } while (0)
#define M8_BAR(ny) do { const int ny_ = (ny); if (ny_ >= 3) asm volatile("s_waitcnt vmcnt(3)" ::: "memory"); else if (ny_ >= 1) asm volatile("s_waitcnt vmcnt(1)" ::: "memory"); \
    else asm volatile("s_waitcnt vmcnt(0)" ::: "memory"); \
    asm volatile("s_waitcnt lgkmcnt(0)" ::: "memory"); __builtin_amdgcn_s_barrier(); asm volatile("" ::: "memory"); } while (0)
#define M8_NY(j_) ((j_) + 2 < NT ? 3 : ((j_) + 2 == NT ? 1 : 0))
    f32x16 p0, p1; v8i pf;
#define M8_MMA(acc, a, b, sa, sb) do { if constexpr ((PRB & 2) != 0) asm volatile("" :: "v"(a), "v"(b)); else acc = mfma8(a, b, acc, sa, sb); } while (0)
#define M8_SB() __builtin_amdgcn_sched_barrier(0)
#define M8_KF(c, kb) ((PRB & 4) ? qf[c] : ld_frag(Ks + kxa[c] + (kb) * 32 * 256, Ks + kxa[c] + hdl + (kb) * 32 * 256))
#define M8_VF(d) ((PRB & 4) ? qf[(d) % 3] : ld_frag(Vs + vxa + (d) * 2048, Vs + vxa + hdl + (d) * 2048))
#define M8_X(jj, QK, PV) do { const int j_ = (jj); const char* Ks = Kb + (j_ % 3) * KB8; const char* Vs = Vb + ((j_ + 2) % 3) * VB8; \
        v8i fa, fb, fc, fd; \
        if (QK) { fa = M8_KF(0, 0); fb = M8_KF(0, 1); fc = M8_KF(1, 0); fd = M8_KF(1, 1); } \
        M8_SB(); if (!grpB && j_ + 2 <= NT) M8_STAGE(j_ + 2); M8_SB(); \
        if (QK) { \
            _Pragma("unroll") for (int r = 0; r < 16; ++r) { p0[r] = 0.f; p1[r] = 0.f; } \
            M8_MMA(p0, fa, qf[0], s1, s1); M8_MMA(p1, fb, qf[0], s1, s1); M8_SB(); \
            fa = M8_KF(2, 0); fb = M8_KF(2, 1); M8_SB(); \
            M8_MMA(p0, fc, qf[1], s1, s1); M8_MMA(p1, fd, qf[1], s1, s1); M8_SB(); \
            if (PV) { fc = M8_VF(0); fd = M8_VF(1); } M8_SB(); \
            M8_MMA(p0, fa, qf[2], s1, s1); M8_MMA(p1, fb, qf[2], s1, s1); M8_SB(); \
        } else { fc = M8_VF(0); fd = M8_VF(1); } \
        if (PV) { fa = M8_VF(2); fb = M8_VF(3); M8_SB(); \
            M8_MMA(o[0], pf, fc, sp, s1); M8_MMA(o[1], pf, fd, sp, s1); M8_SB();     \
            M8_MMA(o[2], pf, fa, sp, s1); M8_MMA(o[3], pf, fb, sp, s1); } } while (0)
    bool pend = false;
#define M8_Y(jj) do { const int j_ = (jj); if (grpB && j_ + 3 <= NT) M8_STAGE(j_ + 3); \
        if constexpr ((PRB & 8) == 0) { \
            float pmax = p0[0]; \
            _Pragma("unroll") for (int r = 1; r < 16; ++r) pmax = fmaxf(pmax, p0[r]); \
            _Pragma("unroll") for (int r = 0; r < 16; ++r) pmax = fmaxf(pmax, p1[r]); \
            { auto rr = __builtin_amdgcn_permlane32_swap(__float_as_uint(pmax), __float_as_uint(pmax), false, false); \
              pmax = fmaxf(__uint_as_float(rr[0]), __uint_as_float(rr[1])); } \
            if (__any(pmax - m_reg > 3.0f / 0.07216878364870322f)) { \
                const float mn = fmaxf(m_reg, pmax); \
                const float alpha = __builtin_amdgcn_exp2f((m_reg - mn) * C); \
                m_reg = mn; l_reg *= alpha; \
                if (hi == 0) al[r32] = alpha; \
                pend = true; \
            } \
            const float mnC = 4.0f - m_reg * C;                     \
            float ps = 0.f; \
            _Pragma("unroll") for (int r = 0; r < 16; ++r) { p0[r] = (PRB & 1) ? fmaf(p0[r], C, mnC) : __builtin_amdgcn_exp2f((PRB & 32) ? p0[r] : fmaf(p0[r], C, mnC)); if (!(PRB & 16)) ps += p0[r]; } \
            _Pragma("unroll") for (int r = 0; r < 16; ++r) { p1[r] = (PRB & 1) ? fmaf(p1[r], C, mnC) : __builtin_amdgcn_exp2f((PRB & 32) ? p1[r] : fmaf(p1[r], C, mnC)); if (!(PRB & 16)) ps += p1[r]; } \
            { auto rr = __builtin_amdgcn_permlane32_swap(__float_as_uint(ps), __float_as_uint(ps), false, false); \
              ps = __uint_as_float(rr[0]) + __uint_as_float(rr[1]); } \
            l_reg += ps * (1.0f / 16.0f); \
              \
            _Pragma("unroll") for (int a = 0; a < 4; ++a) { \
                const unsigned w0 = pk4_fp8o(p0[4 * a], p0[4 * a + 1], p0[4 * a + 2], p0[4 * a + 3]), w1 = pk4_fp8o(p1[4 * a], p1[4 * a + 1], p1[4 * a + 2], p1[4 * a + 3]); \
                auto rr = __builtin_amdgcn_permlane32_swap(w0, w1, false, false); \
                pf[2 * a] = (int)rr[0]; pf[2 * a + 1] = (int)rr[1]; \
            } \
        } } while (0)
    M8_STAGE(0); M8_STAGE(1);
    M8_BAR(0);
    if (grpB) { M8_STAGE(2); M8_BAR(NT > 2 ? 3 : 1); }
    M8_X(0, true, false); M8_BAR(M8_NY(0)); M8_Y(0); M8_BAR(M8_NY(0));
    int j = 1;
    for (;;) {
        if (pend) {
            pend = false;
#pragma unroll
            for (int r = 0; r < 16; ++r) { const float a_ = al[crow(r, hi)];
#pragma unroll
                for (int d = 0; d < 4; ++d) o[d][r] *= a_; }
        }
#pragma unroll 1
        for (; j < NT; ++j) {
            M8_X(j, true, true); M8_BAR(M8_NY(j)); M8_Y(j); M8_BAR(M8_NY(j));
            if (pend) { ++j; break; }
        }
        if (!pend) break;
    }
    M8_X(NT, false, true);
#undef M8_KF
#undef M8_VF
#undef M8_X
#undef M8_Y
#undef M8_SB
    if (!grpB) M8_BAR(0);
    if (hi == 0) al[32 + r32] = l_reg;
    asm volatile("s_waitcnt lgkmcnt(0)" ::: "memory");
#pragma unroll
    for (int r = 0; r < 16; ++r) {
        const int orow_ = crow(r, hi);
        const float li = 1.0f / al[32 + orow_];
        bf16_t* op = op0 + (size_t)(32 * wave + orow_) * LDO;
#pragma unroll
        for (int d = 0; d < 4; ++d) { if (WO_FP8) ((unsigned char*)op0)[(size_t)(32 * wave + orow_) * LDO + d * 32 + r32] = fp8_1(o[d][r] * li * 64.f); else op[d * 32 + r32] = (bf16_t)(cvt_pk(o[d][r] * li, 0.f) & 0xffffu); }
    }
    __syncthreads();
#undef M8_STAGE
#undef M8_BAR
#undef M8_NY
#undef M8_MMA
}
}
struct Params { const float* in[31]; float* out; unsigned char* ws; int ph_lo, ph_hi; };
enum { I_X = 0, I_C, I_CTX, I_CCTX, I_MODW, I_MODB, I_N1G, I_N2G, I_DQ, I_GQ, I_UQ, I_DKV, I_GKV, I_UKV, I_MWO, I_FWO, I_FBO, I_NQKV, I_RPB, I_NWO,
       I_SQKV, I_SINK, I_SWO, I_WGRP, I_BGRP, I_WRT, I_BRT, I_WGATE, I_WUP, I_WDOWN, I_FG };
struct Frame {
    const float* const __attribute__((address_space(4)))* in;
    float* out; unsigned char* ws; char* lds;
    int tid, lane, wave, G, vcu;
    DI bf16_t* wt(size_t el) const { return (bf16_t*)(ws + WS_WT) + el; }
    DI bf16_t* scr(size_t byte) const { return (bf16_t*)(ws + WS_SCR + byte); }
    DI float* moda(int layer, int v, int which) const { return (float*)(ws + WS_MODA) + ((size_t)(layer * 3 + v) * 2 + which) * 1024; }
    DI float* modv(int layer, int v, int part) const { return (float*)(ws + WS_MODV) + ((size_t)(layer * 3 + v) * 6 + part) * 1024; }
};
DI int row_batch(int row) { return row >= TB ? 1 : 0; }
DI int row_modv(int row) { const int b = row_batch(row), rr = row - b * TB; return rr < NCTX ? 0 : 1 + b; }
DI int tile_modv(int pm) { const int b = pm / 65; return (pm % 65 == 0) ? 0 : 1 + b; }
DI int swap45(int c) { return ((c & 16) << 1) | ((c & 32) >> 1) | (c & 15); }

DI int dst_row(int kind, int n) {
    if (kind == 1) return n < 256 ? n : 256 + swap45(n - 256);
    if (kind == 2) { const int h = n / 192, c = n - h * 192; return c < 128 ? n : h * 192 + 128 + swap45(c - 128); }
    if (kind == 3) return n < 1280 ? (n & ~63) + swap45(n & 63) : n;
    return n;
}
DI void cvt_tile(const Frame& F, const float* __restrict__ src, int N, bf16_t* __restrict__ dst, int ldd, int k0, int n0, int kind, const float* __restrict__ kscale, bool f8) {
    float* tl = (float*)F.lds;
    const int tid = F.tid;
    { const int kr = tid >> 3, c8 = (tid & 7) * 8;
      const float sc = kscale ? kscale[k0 + kr] : 1.0f;
      const f32x4 a = *(const f32x4*)(src + (size_t)(k0 + kr) * N + n0 + c8), b = *(const f32x4*)(src + (size_t)(k0 + kr) * N + n0 + c8 + 4);
#pragma unroll
      for (int j = 0; j < 4; ++j) { tl[kr * 65 + c8 + j] = a[j] * sc; tl[kr * 65 + c8 + 4 + j] = b[j] * sc; } }
    __syncthreads();
    { const int nr = tid >> 3, k8 = (tid & 7) * 8;
      float v[8];
#pragma unroll
      for (int j = 0; j < 8; ++j) v[j] = tl[(k8 + j) * 65 + nr];
      if (f8) { u32x2 w; w.x = pk4_fp8(v[0] * 64.f, v[1] * 64.f, v[2] * 64.f, v[3] * 64.f); w.y = pk4_fp8(v[4] * 64.f, v[5] * 64.f, v[6] * 64.f, v[7] * 64.f);
          *(u32x2*)((unsigned char*)dst + (size_t)dst_row(kind, n0 + nr) * ldd + k0 + k8) = w; }
      else { u32x4 w; w.x = cvt_pk(v[0], v[1]); w.y = cvt_pk(v[2], v[3]); w.z = cvt_pk(v[4], v[5]); w.w = cvt_pk(v[6], v[7]);
          *(u32x4*)(dst + (size_t)dst_row(kind, n0 + nr) * ldd + k0 + k8) = w; } }
    __syncthreads();
}
DI void cvt_tile4(const Frame& F, const float* __restrict__ src, int N, unsigned char* __restrict__ dst, int ldd, int k0, int n0) {
    float* tl = (float*)F.lds;
    int tid = threadIdx.x; asm volatile("" : "+v"(tid));
    { const int kr = tid >> 3, c8 = (tid & 7) * 8;
      f32x4 a[4], b[4];
#pragma unroll
      for (int q = 0; q < 4; ++q) { a[q] = __builtin_nontemporal_load((const f32x4*)(src + (size_t)(k0 + kr) * N + n0 + 64 * q + c8)); b[q] = __builtin_nontemporal_load((const f32x4*)(src + (size_t)(k0 + kr) * N + n0 + 64 * q + c8 + 4)); }
#pragma unroll
      for (int q = 0; q < 4; ++q)
#pragma unroll
          for (int j = 0; j < 4; ++j) { tl[q * 4160 + kr * 65 + c8 + j] = a[q][j]; tl[q * 4160 + kr * 65 + c8 + 4 + j] = b[q][j]; } }
    __syncthreads();
    { const int nr = tid >> 3, k8 = (tid & 7) * 8;
#pragma unroll
      for (int q = 0; q < 4; ++q) {
          float v[8];
#pragma unroll
          for (int j = 0; j < 8; ++j) v[j] = tl[q * 4160 + (k8 + j) * 65 + nr] * 64.0f;
          u32x2 w; w.x = pk4_fp8(v[0], v[1], v[2], v[3]); w.y = pk4_fp8(v[4], v[5], v[6], v[7]);
          *(u32x2*)(dst + (size_t)(n0 + 64 * q + nr) * ldd + k0 + k8) = w; } }
    __syncthreads();
}
DI void cvt_moe_range(const Frame& F, int layer, int b0, int b1, int rank, int nr) {
    unsigned char* mw = F.ws + WS_MOEW;
    const float* wg = F.in[I_WGATE] + (size_t)layer * 32 * 1024 * 512;
    const float* wu = F.in[I_WUP] + (size_t)layer * 32 * 1024 * 512;
    const float* wd = F.in[I_WDOWN] + (size_t)layer * 32 * 512 * 1024;
    for (int u = b0 + rank; u < b1; u += nr) {
        const int mat = u / 32, tl = u % 32, which = mat / 32, e = mat % 32;
        if (which < 2) { const int kt = tl / 2, nq = tl % 2;
            cvt_tile4(F, (which ? wu : wg) + (size_t)e * 1024 * 512, 512, mw + (which ? MOEW_U : MOEW_G) + (size_t)e * 512 * 1024, 1024, kt * 64, nq * 256);
        } else { const int kt = tl / 4, nq = tl % 4;
            cvt_tile4(F, wd + (size_t)e * 512 * 1024, 1024, mw + MOEW_D + (size_t)e * 1024 * 512, 512, kt * 64, nq * 256);
        }
    }
}
DI void tail_cvt(const Frame& F, int NU, int layer, int b0, int b1) {
    const int rem = NU % F.G;
    if (rem == 0) { cvt_moe_range(F, layer, b0, b1, F.vcu, F.G); return; }
    if (F.vcu < rem) return;
    cvt_moe_range(F, layer, b0, b1, F.vcu - rem, F.G - rem);
}
struct CvtJob { const float* src; const float* ks; bf16_t* dst; int K, N, ldd, kind; bool f8; };
DI CvtJob cvt_job(const Frame& F, int j) {
    CvtJob J; J.ks = nullptr; J.kind = 0; J.f8 = false;
    switch (j) {
        case 0: J.src = F.in[I_DQ]; J.K = 1024; J.N = 512; J.dst = F.wt(WT_P1); J.ldd = 1024; J.f8 = GEMM_FP8; break;
        case 1: J.src = F.in[I_DKV]; J.K = 1024; J.N = 320; J.dst = GEMM_FP8 ? (bf16_t*)((unsigned char*)F.wt(WT_P1) + (size_t)512 * 1024) : F.wt(WT_P1 + (size_t)512 * 1024); J.ldd = 1024; J.kind = 1; J.f8 = GEMM_FP8; break;
        case 2: J.src = F.in[I_UQ]; J.K = 512; J.N = 1536; J.dst = F.wt(WT_UQ); J.ldd = 512; J.kind = 2; J.ks = F.in[I_GQ]; break;
        case 3: J.src = F.in[I_UKV]; J.K = 256; J.N = 2048; J.dst = F.wt(WT_UKV); J.ldd = 256; J.ks = F.in[I_GKV]; break;
        case 4: J.src = F.in[I_MWO]; J.K = 1024; J.N = 1024; J.dst = F.wt(WT_WO0); J.ldd = 1024; J.f8 = WO_FP8; break;
        case 5: J.src = F.in[I_FWO]; J.K = 1024; J.N = 1024; J.dst = F.wt(WT_WO1); J.ldd = 1024; break;
        case 6: J.src = F.in[I_NQKV]; J.K = 1024; J.N = 3072; J.dst = F.wt(WT_NAQKV); J.ldd = 1024; J.f8 = GEMM_FP8; break;
        case 7: J.src = F.in[I_NWO]; J.K = 1024; J.N = 1024; J.dst = F.wt(WT_WO2); J.ldd = 1024; J.f8 = WO_FP8; break;
        case 8: J.src = F.in[I_SQKV]; J.K = 1024; J.N = 1536; J.dst = F.wt(WT_SWQKV); J.ldd = 1024; J.kind = 3; J.f8 = GEMM_FP8; break;
        default: J.src = F.in[I_SWO]; J.K = 1024; J.N = 1024; J.dst = F.wt(WT_WO3); J.ldd = 1024; J.f8 = WO_FP8; break;
    }
    return J;
}

DI void ph_prologue(const Frame& F) {
    for (int u = F.vcu; u < 256; u += F.G) {
        const int layer = u >> 6, kc = (u >> 2) & 15, nq = u & 3;
        const float* mw = F.in[I_MODW] + ((size_t)layer * 1024 + kc * 64) * 6144 + nq * 1536 + F.tid;
        float acc[3][3];
#pragma unroll
        for (int j = 0; j < 3; ++j) { acc[j][0] = 0.f; acc[j][1] = 0.f; acc[j][2] = 0.f; }
#pragma unroll 8
        for (int k = 0; k < 64; ++k) {
            const int kk = kc * 64 + k;
            const float a0 = silu_f(F.in[I_CCTX][kk]), a1 = silu_f(F.in[I_C][kk]), a2 = silu_f(F.in[I_C][1024 + kk]);
#pragma unroll
            for (int j = 0; j < 3; ++j) { const float w = mw[(size_t)k * 6144 + j * 512]; acc[j][0] += a0 * w; acc[j][1] += a1 * w; acc[j][2] += a2 * w; }
        }
        float* mp = (float*)(F.ws + WS_MODP) + ((size_t)(kc * 4 + layer) * 3) * 6144 + nq * 1536 + F.tid;
#pragma unroll
        for (int j = 0; j < 3; ++j) { mp[j * 512] = acc[j][0]; mp[6144 + j * 512] = acc[j][1]; mp[2 * 6144 + j * 512] = acc[j][2]; }
    }
    {
        const int ntile[10] = {128, 80, 192, 128, 256, 256, 768, 256, 384, 256};
        int total = 0;
#pragma unroll
        for (int j = 0; j < 10; ++j) total += ntile[j];
        for (int u = F.vcu; u < total; u += F.G) {
            int j = 0, rem = u;
#pragma unroll
            for (int q = 0; q < 9; ++q) { if (j == q && rem >= ntile[q]) { rem -= ntile[q]; j = q + 1; } }
            const CvtJob J = cvt_job(F, j);
            const int nn = J.N / 64, kt = rem / nn, nt = rem % nn;
            cvt_tile(F, J.src, J.N, J.dst, J.ldd, kt * 64, nt * 64, J.kind, J.ks, J.f8);
        }
    }
    {
        const int gt = F.vcu * NTHR + F.tid, gs = F.G * NTHR;
        bf16_t* A = F.wt(WT_DFTA); bf16_t* D1 = F.wt(WT_DFT1); bf16_t* D2 = F.wt(WT_DFT2); bf16_t* DC = F.wt(WT_DFTC);
        for (int i = gt; i < 512 * 256; i += gs) {
            const int r = i >> 8, c = i & 255, kc = r & 255, ph = (c * kc) & 255; const float x = (float)ph * (1.0f / 128.0f);
            const float v = (r < 256 ? cospif(x) : -sinpif(x)) * 0.0625f;
            A[i] = (bf16_t)(cvt_pk(v, 0.f) & 0xffffu);
        }
        const float s128 = 0.08838834764831845f;
        for (int i = gt; i < 256 * 256; i += gs) {
            const int r = i >> 8, c = i & 255, kb = r & 127, n1 = c & 127, ph = (kb * n1) & 127; const float x = (float)ph * (1.0f / 64.0f);
            const float cs = cospif(x) * s128, sn = sinpif(x) * s128;
            const float v1 = (r < 128) ? (c < 128 ? cs : sn) : (c < 128 ? -sn : cs);
            D1[i] = (bf16_t)(cvt_pk(v1, 0.f) & 0xffffu);
            const float v2 = (r < 128) ? (c < 128 ? cs : sn) : 0.f;
            D2[i] = (bf16_t)(cvt_pk(v2, 0.f) & 0xffffu);
        }
        for (int i = gt; i < 256 * 512; i += gs) {
            const int r = i >> 9, c = i & 511, n = c & 255, ph = (r * n) & 255; const float x = (float)ph * (1.0f / 128.0f);
            const float v = (c < 256 ? cospif(x) : sinpif(x)) * 0.0625f;
            DC[i] = (bf16_t)(cvt_pk(v, 0.f) & 0xffffu);
        }
        float* rope = (float*)(F.ws + WS_ROPE);
        for (int i = gt; i < 256 * 16; i += gs) {
            const int v = i >> 4, m = i & 15;
            const float inv = powf(10000.0f, -(float)m / 16.0f);
            const float ang = (float)v * inv;
            rope[2 * i] = cosf(ang); rope[2 * i + 1] = sinf(ang);
        }
    }
    {
        for (int i = F.vcu * NTHR + F.tid; i < 4 * 36 * 1024; i += F.G * NTHR) {
            const int layer = i / (36 * 1024), r = i % (36 * 1024), n = r >> 10, k = r & 1023;
            const float w = n < 32 ? F.in[I_WRT][((size_t)layer * 1024 + k) * 32 + n] : F.in[I_WGRP][((size_t)layer * 1024 + k) * 4 + (n - 32)];
            const unsigned hi = cvt_pk(w, 0.f) & 0xffffu; const float lo = w - bflo(hi);
            unsigned char* img = F.ws + WS_RW + (size_t)layer * 2 * RW_HALF + (size_t)n * RW_PITCH + 2 * k;
            *(bf16_t*)img = (bf16_t)hi; *(bf16_t*)(img + RW_HALF) = (bf16_t)(cvt_pk(lo, 0.f) & 0xffffu);
        }
    }
}
DI void ph_modreduce(const Frame& F) {
    for (int i = F.vcu * NTHR + F.tid; i < 4 * 3 * 6144; i += F.G * NTHR) {
        const int layer = i / (3 * 6144), r = i % (3 * 6144), v = r / 6144, n = r % 6144;
        const float* mp = (const float*)(F.ws + WS_MODP) + (size_t)layer * 3 * 6144 + r;
        float s = F.in[I_MODB][layer * 6144 + n];
#pragma unroll
        for (int kc = 0; kc < 16; ++kc) s += mp[(size_t)kc * 4 * 3 * 6144];
        ((float*)(F.ws + WS_MODV))[i] = s;
        const int part = n >> 10, col = n & 1023;
        if (part == 1) F.moda(layer, v, 0)[col] = F.in[I_N1G][layer * D + col] * (1.0f + s);
        if (part == 4) F.moda(layer, v, 1)[col] = F.in[I_N2G][layer * D + col] * (1.0f + s);
    }
}

template <int LAYER>
DI void ph_norm1(const Frame& F, bool dry = false) {
    bf16_t* xres = (bf16_t*)(F.ws + WS_XRES);
    bf16_t* xdst = dry ? (bf16_t*)(F.ws + WS_END) : xres;
    bf16_t* hb = dry ? (bf16_t*)(F.ws + WS_END + (size_t)T * D * 4) : (bf16_t*)(F.ws + WS_H);
    const int* slot = (const int*)(F.ws + WS_SLOT);
    const float* gw = (const float*)(F.ws + WS_GW);
    const bf16_t* yb = F.scr(SM_Y);
    const int c0 = 4 * F.lane;
    const int step = F.G * 8;
    u32x2 nxa[4], nya[4], nyc[4]; float ng0 = 0.f, ng1 = 0.f;
    int ps0 = 0, ps1 = 0; float pg0 = 0.f, pg1 = 0.f;
    auto valid = [&](int r) { return r < T && !(LAYER == 4 && (r - row_batch(r) * TB) < NCTX); };
    auto fetch_sg = [&](int r) { if (LAYER != 0 && valid(r)) { ps0 = slot[2 * r]; ps1 = slot[2 * r + 1]; pg0 = gw[2 * r]; pg1 = gw[2 * r + 1]; } };
    auto issue = [&](int r) { if (LAYER != 0 && valid(r)) { const bf16_t* src = xres + (size_t)r * D; ng0 = pg0; ng1 = pg1;
#pragma unroll
            for (int i = 0; i < 4; ++i) { nxa[i] = *(const u32x2*)(src + c0 + 256 * i); nya[i] = __builtin_nontemporal_load((const u32x2*)(yb + (size_t)ps0 * D + c0 + 256 * i)); nyc[i] = __builtin_nontemporal_load((const u32x2*)(yb + (size_t)ps1 * D + c0 + 256 * i)); } } };
    { const int r0 = F.vcu * 8 + F.wave; fetch_sg(r0); issue(r0); fetch_sg(r0 + step); }
    for (int row = F.vcu * 8 + F.wave; row < T; row += step) {
        const int b = row_batch(row), rr = row - b * TB, v = rr < NCTX ? 0 : 1 + b;
        u32x2 xa[4], ya[4], yc[4]; const float g0 = ng0, g1 = ng1;
        if (LAYER != 0) {
#pragma unroll
            for (int i = 0; i < 4; ++i) { xa[i] = nxa[i]; ya[i] = nya[i]; yc[i] = nyc[i]; }
            issue(row + step); fetch_sg(row + 2 * step);
        }
        if (LAYER == 4 && rr < NCTX) continue;
        f32x4 x[4];
        if (LAYER == 0) {
            const float* src = rr < NCTX ? F.in[I_CTX] + ((size_t)b * NCTX + rr) * D : F.in[I_X] + ((size_t)b * SEQ + (rr - NCTX)) * D;
#pragma unroll
            for (int i = 0; i < 4; ++i) x[i] = *(const f32x4*)(src + c0 + 256 * i);
        } else {
            const float* g2 = F.modv(LAYER - 1, v, 5);
#pragma unroll
            for (int i = 0; i < 4; ++i) {
                const f32x4 gg = *(const f32x4*)(g2 + c0 + 256 * i);
                x[i][0] = bflo(xa[i].x) + gg[0] * (g0 * bflo(ya[i].x) + g1 * bflo(yc[i].x)); x[i][1] = bfhi(xa[i].x) + gg[1] * (g0 * bfhi(ya[i].x) + g1 * bfhi(yc[i].x));
                x[i][2] = bflo(xa[i].y) + gg[2] * (g0 * bflo(ya[i].y) + g1 * bflo(yc[i].y)); x[i][3] = bfhi(xa[i].y) + gg[3] * (g0 * bfhi(ya[i].y) + g1 * bfhi(yc[i].y));
            }
        }
        float ss = 0.f;
#pragma unroll
        for (int i = 0; i < 4; ++i) ss += x[i][0] * x[i][0] + x[i][1] * x[i][1] + x[i][2] * x[i][2] + x[i][3] * x[i][3];
        ss = wave_sum(ss);
        const float rstd = rsqrtf(ss * (1.0f / D) + EPS);
        if (LAYER == 4) {
            float* op = (dry ? (float*)(F.ws + WS_END) : F.out) + ((size_t)b * SEQ + (rr - NCTX)) * D;
#pragma unroll
            for (int i = 0; i < 4; ++i) { const f32x4 g = *(const f32x4*)(F.in[I_FG] + c0 + 256 * i); f32x4 y;
#pragma unroll
                for (int j = 0; j < 4; ++j) y[j] = x[i][j] * rstd * g[j];
#ifdef MLA_CHECK
                { const float* chk = (const float*)(F.ws + WS_CTL + 32768); if (!(chk[1] > 0.f && chk[0] > 0.f && chk[0] <= MLA_CHECK_TOL * chk[1])) { y[0] = y[1] = y[2] = y[3] = __builtin_nanf(""); } }
#endif
                *(f32x4*)(op + c0 + 256 * i) = y; }
        } else {
            constexpr int LY = LAYER < 4 ? LAYER : 0;
            const float* na = F.moda(LY, v, 0); const float* sh = F.modv(LY, v, 0);
            bf16_t* xo = xdst + (size_t)row * D; bf16_t* ho = hb + (size_t)row * D;
#pragma unroll
            for (int i = 0; i < 4; ++i) {
                const f32x4 g = *(const f32x4*)(na + c0 + 256 * i), s0v = *(const f32x4*)(sh + c0 + 256 * i);
                f32x4 y;
#pragma unroll
                for (int j = 0; j < 4; ++j) y[j] = x[i][j] * rstd * g[j] + s0v[j];
                st_bf4(xo + c0 + 256 * i, x[i]);
                if (GEMM_FP8 && LAYER != 1) st_fp8x4((unsigned char*)hb + (size_t)row * D + c0 + 256 * i, y); else st_bf4(ho + c0 + 256 * i, y);
            }
        }
    }
}

template <int LAYER>
DI void ph_norm2_router(const Frame& F, bool dry = false) {
    if (!dry) { if (LAYER == 0) cvt_moe_range(F, 0, 2960, 3072, F.vcu, F.G); if (LAYER == 3) cvt_moe_range(F, 3, 1952, 3072, F.vcu, F.G); }
    char* Wl = F.lds;
    int* hist = (int*)(F.lds + LDS_MISC + 64);
    int* basee = hist + 32;
    { const u32x4* src = (const u32x4*)(F.ws + WS_RW + (size_t)LAYER * 2 * RW_HALF); u32x4* dst = (u32x4*)Wl;
      constexpr int NCH = 2 * RW_HALF / 16, NIT = (NCH + NTHR - 1) / NTHR;
      u32x4 tmp[NIT];
#pragma unroll
      for (int k = 0; k < NIT; ++k) { const int i = F.tid + k * NTHR; if (i < NCH) tmp[k] = src[i]; }
#pragma unroll
      for (int k = 0; k < NIT; ++k) { const int i = F.tid + k * NTHR; if (i < NCH) dst[i] = tmp[k]; } }
    if (F.tid < 32) hist[F.tid] = 0;
    __syncthreads();
    const bf16_t* xres = (const bf16_t*)(F.ws + WS_XRES);
    bf16_t* hb = (bf16_t*)(F.ws + WS_H);
    const size_t dofs = dry ? (WS_END - WS_EID) : 0;
    int* eid = (int*)(F.ws + WS_EID + dofs); float* gw = (float*)(F.ws + WS_GW + dofs); int* pos = (int*)(F.ws + WS_POS + dofs);
    const float* bg = F.in[I_BGRP] + LAYER * 4; const float* br = F.in[I_BRT] + LAYER * 32;
    const int fr = F.lane & 15, fq = F.lane >> 4;
    const char* w0 = Wl + fr * RW_PITCH + 16 * fq;
    const char* w1 = w0 + 16 * RW_PITCH;
    const char* w2 = Wl + (32 + (fr & 3)) * RW_PITCH + 16 * fq;
    auto run = [&](const int g16, const int s0, const bool whole, f32x4& acc0, f32x4& acc1, f32x4& acc2) __attribute__((always_inline)) {
        const int row = 16 * g16 + fr, v = row_modv(16 * g16);
        const bf16_t* __restrict__ xp = xres + (size_t)row * D + 8 * fq;
        float ss;
        { const f32x4 q4 = *(const f32x4*)((const float*)(F.ws + WS_SQX) + (size_t)row * 4); ss = q4[0] + q4[1] + q4[2] + q4[3]; }
        const float rstd = rsqrtf(ss * (1.0f / D) + EPS);
        const float* __restrict__ na = F.moda(LAYER, v, 1) + 8 * fq; const float* __restrict__ sh = F.modv(LAYER, v, 3) + 8 * fq;
        unsigned char* __restrict__ h8 = (unsigned char*)hb + (size_t)row * D + 8 * fq;

        if (whole) {
            struct StepIn { u32x4 xw; f32x4 ga, gb, ha, hb_; };
            auto ld = [&](const int s, StepIn& I) __attribute__((always_inline)) { I.xw = *(const u32x4*)(xp + 32 * s); I.ga = *(const f32x4*)(na + 32 * s); I.gb = *(const f32x4*)(na + 32 * s + 4); I.ha = *(const f32x4*)(sh + 32 * s); I.hb_ = *(const f32x4*)(sh + 32 * s + 4); };
            auto stp = [&](const int s, const StepIn& I) __attribute__((always_inline)) {
            float h[8];
            { const u32x4 xw = I.xw;
              const f32x4 a = {bflo(xw.x), bfhi(xw.x), bflo(xw.y), bfhi(xw.y)}, b = {bflo(xw.z), bfhi(xw.z), bflo(xw.w), bfhi(xw.w)};
              const f32x4 ga = I.ga, gb = I.gb;
              const f32x4 ha = I.ha, hbv = I.hb_;
#pragma unroll
              for (int j = 0; j < 4; ++j) { h[j] = a[j] * rstd * ga[j] + ha[j]; h[4 + j] = b[j] * rstd * gb[j] + hbv[j]; } }
            u32x4 hi, lo;
            hi.x = cvt_pk(h[0], h[1]); hi.y = cvt_pk(h[2], h[3]); hi.z = cvt_pk(h[4], h[5]); hi.w = cvt_pk(h[6], h[7]);
            { u32x2 w8; w8.x = pk4_fp8(h[0], h[1], h[2], h[3]); w8.y = pk4_fp8(h[4], h[5], h[6], h[7]); *(u32x2*)(h8 + 32 * s) = w8; }
            lo.x = cvt_pk(h[0] - bflo(hi.x), h[1] - bfhi(hi.x)); lo.y = cvt_pk(h[2] - bflo(hi.y), h[3] - bfhi(hi.y));
            lo.z = cvt_pk(h[4] - bflo(hi.z), h[5] - bfhi(hi.z)); lo.w = cvt_pk(h[6] - bflo(hi.w), h[7] - bfhi(hi.w));
            const bf16x8 ah = __builtin_bit_cast(bf16x8, hi), alo = __builtin_bit_cast(bf16x8, lo);
            const bf16x8 w0h = *(const bf16x8*)(w0 + 64 * s), w0l = *(const bf16x8*)(w0 + RW_HALF + 64 * s);
            const bf16x8 w1h = *(const bf16x8*)(w1 + 64 * s), w1l = *(const bf16x8*)(w1 + RW_HALF + 64 * s);
            const bf16x8 w2h = *(const bf16x8*)(w2 + 64 * s), w2l = *(const bf16x8*)(w2 + RW_HALF + 64 * s);
            acc0 = __builtin_amdgcn_mfma_f32_16x16x32_bf16(w0h, ah, acc0, 0, 0, 0); acc0 = __builtin_amdgcn_mfma_f32_16x16x32_bf16(w0h, alo, acc0, 0, 0, 0); acc0 = __builtin_amdgcn_mfma_f32_16x16x32_bf16(w0l, ah, acc0, 0, 0, 0);
            acc1 = __builtin_amdgcn_mfma_f32_16x16x32_bf16(w1h, ah, acc1, 0, 0, 0); acc1 = __builtin_amdgcn_mfma_f32_16x16x32_bf16(w1h, alo, acc1, 0, 0, 0); acc1 = __builtin_amdgcn_mfma_f32_16x16x32_bf16(w1l, ah, acc1, 0, 0, 0);
            acc2 = __builtin_amdgcn_mfma_f32_16x16x32_bf16(w2h, ah, acc2, 0, 0, 0); acc2 = __builtin_amdgcn_mfma_f32_16x16x32_bf16(w2h, alo, acc2, 0, 0, 0); acc2 = __builtin_amdgcn_mfma_f32_16x16x32_bf16(w2l, ah, acc2, 0, 0, 0);
            };
            StepIn ba[4], bb[4];
#pragma unroll
            for (int k_ = 0; k_ < 4; ++k_) ld(k_, ba[k_]);
#pragma unroll 1
            for (int sb = 0; sb < 32; sb += 8) {
#pragma unroll
                for (int k_ = 0; k_ < 4; ++k_) ld(sb + 4 + k_, bb[k_]);
#pragma unroll
                for (int k_ = 0; k_ < 4; ++k_) stp(sb + k_, ba[k_]);
                if (sb + 8 < 32) {
#pragma unroll
                    for (int k_ = 0; k_ < 4; ++k_) ld(sb + 8 + k_, ba[k_]);
                }
#pragma unroll
                for (int k_ = 0; k_ < 4; ++k_) stp(sb + 4 + k_, bb[k_]);
            }
        } else {
#pragma unroll
            for (int k_ = 0; k_ < 4; ++k_) { const int s = s0 + k_;
            float h[8];
            { const u32x4 xw = *(const u32x4*)(xp + 32 * s);
              const f32x4 a = {bflo(xw.x), bfhi(xw.x), bflo(xw.y), bfhi(xw.y)}, b = {bflo(xw.z), bfhi(xw.z), bflo(xw.w), bfhi(xw.w)};
              const f32x4 ga = *(const f32x4*)(na + 32 * s), gb = *(const f32x4*)(na + 32 * s + 4);
              const f32x4 ha = *(const f32x4*)(sh + 32 * s), hbv = *(const f32x4*)(sh + 32 * s + 4);
#pragma unroll
              for (int j = 0; j < 4; ++j) { h[j] = a[j] * rstd * ga[j] + ha[j]; h[4 + j] = b[j] * rstd * gb[j] + hbv[j]; } }
            u32x4 hi, lo;
            hi.x = cvt_pk(h[0], h[1]); hi.y = cvt_pk(h[2], h[3]); hi.z = cvt_pk(h[4], h[5]); hi.w = cvt_pk(h[6], h[7]);
            { u32x2 w8; w8.x = pk4_fp8(h[0], h[1], h[2], h[3]); w8.y = pk4_fp8(h[4], h[5], h[6], h[7]); *(u32x2*)(h8 + 32 * s) = w8; }
            lo.x = cvt_pk(h[0] - bflo(hi.x), h[1] - bfhi(hi.x)); lo.y = cvt_pk(h[2] - bflo(hi.y), h[3] - bfhi(hi.y));
            lo.z = cvt_pk(h[4] - bflo(hi.z), h[5] - bfhi(hi.z)); lo.w = cvt_pk(h[6] - bflo(hi.w), h[7] - bfhi(hi.w));
            const bf16x8 ah = __builtin_bit_cast(bf16x8, hi), alo = __builtin_bit_cast(bf16x8, lo);
            const bf16x8 w0h = *(const bf16x8*)(w0 + 64 * s), w0l = *(const bf16x8*)(w0 + RW_HALF + 64 * s);
            const bf16x8 w1h = *(const bf16x8*)(w1 + 64 * s), w1l = *(const bf16x8*)(w1 + RW_HALF + 64 * s);
            const bf16x8 w2h = *(const bf16x8*)(w2 + 64 * s), w2l = *(const bf16x8*)(w2 + RW_HALF + 64 * s);
            acc0 = __builtin_amdgcn_mfma_f32_16x16x32_bf16(w0h, ah, acc0, 0, 0, 0); acc0 = __builtin_amdgcn_mfma_f32_16x16x32_bf16(w0h, alo, acc0, 0, 0, 0); acc0 = __builtin_amdgcn_mfma_f32_16x16x32_bf16(w0l, ah, acc0, 0, 0, 0);
            acc1 = __builtin_amdgcn_mfma_f32_16x16x32_bf16(w1h, ah, acc1, 0, 0, 0); acc1 = __builtin_amdgcn_mfma_f32_16x16x32_bf16(w1h, alo, acc1, 0, 0, 0); acc1 = __builtin_amdgcn_mfma_f32_16x16x32_bf16(w1l, ah, acc1, 0, 0, 0);
            acc2 = __builtin_amdgcn_mfma_f32_16x16x32_bf16(w2h, ah, acc2, 0, 0, 0); acc2 = __builtin_amdgcn_mfma_f32_16x16x32_bf16(w2h, alo, acc2, 0, 0, 0); acc2 = __builtin_amdgcn_mfma_f32_16x16x32_bf16(w2l, ah, acc2, 0, 0, 0);
            }
        }
    };
    auto decide = [&](const int g16, const f32x4 acc0, const f32x4 acc1, const f32x4 acc2) __attribute__((always_inline)) {
        const int row = 16 * g16 + fr;
        const float l0 = acc2[0] + bg[0], l1 = acc2[1] + bg[1], l2 = acc2[2] + bg[2], l3 = acc2[3] + bg[3];
        int g = 0; float gm = l0;
        if (l1 > gm) { gm = l1; g = 1; }
        if (l2 > gm) { gm = l2; g = 2; }
        if (l3 > gm) { gm = l3; g = 3; }
        const float wgp = 1.0f / (__expf(l0 - gm) + __expf(l1 - gm) + __expf(l2 - gm) + __expf(l3 - gm));
        const f32x4 cnd = (g >> 1) ? acc1 : acc0;
        const int srcl = fr + 32 * (g & 1);
        float le[8];
#pragma unroll
        for (int j = 0; j < 8; ++j) le[j] = __shfl(cnd[j & 3], srcl + 16 * (j >> 2));
        { const f32x4 ba = *(const f32x4*)(br + 8 * g), bb = *(const f32x4*)(br + 8 * g + 4);
#pragma unroll
          for (int j = 0; j < 4; ++j) { le[j] += ba[j]; le[4 + j] += bb[j]; } }
        int e1 = 0; float m1 = le[0];
#pragma unroll
        for (int j = 1; j < 8; ++j) if (le[j] > m1) { m1 = le[j]; e1 = j; }
        int e2 = -1; float m2 = -3.0e38f;
#pragma unroll
        for (int j = 0; j < 8; ++j) if (j != e1 && le[j] > m2) { m2 = le[j]; e2 = j; }
        const float w1g = 1.0f / (1.0f + __expf(m2 - m1)), w2g = 1.0f - w1g;
        if (fq == 0) {
            const int ea = g * 8 + e1, eb = g * 8 + e2;
            eid[2 * row] = ea; eid[2 * row + 1] = eb;
            gw[2 * row] = wgp * w1g; gw[2 * row + 1] = wgp * w2g;
            pos[2 * row] = atomicAdd(&hist[ea], 1); pos[2 * row + 1] = atomicAdd(&hist[eb], 1);
        }
    };
    const int wi = F.vcu * 8 + F.wave;
    const int gmain = LAYER == 3 ? (wi < 1024 ? 16 + wi : 1056 + (wi - 1024)) : wi;
    { f32x4 a0 = {0.f, 0.f, 0.f, 0.f}, a1 = a0, a2 = a0; run(gmain, 0, true, a0, a1, a2); decide(gmain, a0, a1, a2); }
    const bool coop = LAYER != 3 && (F.vcu & 7) == 0;
    const int gextra = 2048 + (F.vcu >> 3);
    if (coop) {
        f32x4 a0 = {0.f, 0.f, 0.f, 0.f}, a1 = a0, a2 = a0; run(gextra, 4 * F.wave, false, a0, a1, a2);
        float* xb = (float*)F.scr(SM_Y) + (dry ? ((size_t)1 << 20) : 0) + (size_t)(F.vcu >> 3) * (8 * 64 * 12);
        if (F.wave != 0) { float* q = xb + (F.wave * 64 + F.lane) * 12; *(f32x4*)q = a0; *(f32x4*)(q + 4) = a1; *(f32x4*)(q + 8) = a2; }
        __builtin_amdgcn_fence(__ATOMIC_RELEASE, "agent");
        __syncthreads();
        if (F.wave == 0) {
            __builtin_amdgcn_fence(__ATOMIC_ACQUIRE, "agent");
            for (int w = 1; w < 8; ++w) { const float* q = xb + (w * 64 + F.lane) * 12; a0 += *(const f32x4*)q; a1 += *(const f32x4*)(q + 4); a2 += *(const f32x4*)(q + 8); }
            decide(gextra, a0, a1, a2);
        }
    }
    __syncthreads();
    unsigned* counts = (unsigned*)(F.ws + WS_CTL + CTL_COUNTS) + (LAYER + (dry ? 4 : 0)) * 32;
    int t2 = threadIdx.x; asm volatile("" : "+v"(t2));
    if (t2 < 32) basee[t2] = (int)atomicAdd(&counts[t2], (unsigned)hist[t2]);
    __syncthreads();
    if ((t2 & 63) < 16) {
        const int wi2 = F.vcu * 8 + (t2 >> 6), gm2 = LAYER == 3 ? (wi2 < 1024 ? 16 + wi2 : 1056 + (wi2 - 1024)) : wi2;
        { const int row = 16 * gm2 + (t2 & 15); pos[2 * row] += basee[eid[2 * row]]; pos[2 * row + 1] += basee[eid[2 * row + 1]]; }
        if (LAYER != 3 && (F.vcu & 7) == 0 && (t2 >> 6) == 0) { const int row = 16 * (2048 + (F.vcu >> 3)) + (t2 & 15); pos[2 * row] += basee[eid[2 * row]]; pos[2 * row + 1] += basee[eid[2 * row + 1]]; }
    }
    __syncthreads();
}
DI void moe_pstart(const Frame& F, int layer, int* pst) {
    const unsigned* counts = (const unsigned*)(F.ws + WS_CTL + CTL_COUNTS) + layer * 32;
    if (F.tid == 0) { int a = 0; for (int e = 0; e < 32; ++e) { pst[e] = a; a += ((int)counts[e] + 255) / 256 * 256; } pst[32] = a; }
    __syncthreads();
}
template <int LAYER>
DI void ph_scatter(const Frame& F) {
    int* pst = (int*)(F.lds + LDS_MISC + 512);
    moe_pstart(F, LAYER, pst);
    const int* eid = (const int*)(F.ws + WS_EID); const int* pos = (const int*)(F.ws + WS_POS);
    int* slot = (int*)(F.ws + WS_SLOT); int* btok = (int*)(F.ws + WS_BTOK);
    for (int i = F.vcu * NTHR + F.tid; i < 2 * T; i += F.G * NTHR) {
        if (LAYER == 3 && row_modv(i >> 1) == 0) continue;
        const int s = pst[eid[i]] + pos[i];
        slot[i] = s; btok[s] = i >> 1;
    }
    const unsigned* counts = (const unsigned*)(F.ws + WS_CTL + CTL_COUNTS) + LAYER * 32;
    for (int e = F.vcu; e < 32; e += F.G) {
        const int c = (int)counts[e], pc = pst[e + 1] - pst[e];
        for (int p = c + F.tid; p < pc; p += NTHR) btok[pst[e] + p] = 0;
    }
    __syncthreads();
}
DI void tile_rowsumsq(const g8::Acc& acc, const LaneC& L, char* lds, float* out, int stride) {
    float* tb = (float*)lds;
#pragma unroll
    for (int ai = 0; ai < 2; ++ai)
#pragma unroll
        for (int m = 0; m < 4; ++m) {
            float s = 0.f;
#pragma unroll
            for (int bj = 0; bj < 2; ++bj)
#pragma unroll
                for (int n = 0; n < 2; ++n) { const f32x4 v = acc[ai][bj][m][n]; s += v[0] * v[0] + v[1] * v[1] + v[2] * v[2] + v[3] * v[3]; }
            s += __shfl_xor(s, 16); s += __shfl_xor(s, 32);
            if (L.fq == 0) tb[EPI_R(ai, m) * 4 + L.wc] = s;
        }
    __syncthreads();
    int t_ = threadIdx.x; asm volatile("" : "+v"(t_));
    if (t_ < 256) { const f32x4 v = *(const f32x4*)(tb + t_ * 4); out[(size_t)t_ * stride] = v[0] + v[1] + v[2] + v[3]; }
    __syncthreads();
}
DI void rope_cs(const float* rope, int row, int g, int fq, f32x4& c, f32x4& s) {
    const int b = row_batch(row), rr = row - b * TB;
    if (rr < NCTX) { c = (f32x4){1.f, 1.f, 1.f, 1.f}; s = (f32x4){0.f, 0.f, 0.f, 0.f}; return; }
    const int p = rr - NCTX, v = g == 0 ? (p >> 6) : (p & 63);
    const f32x4 a = *(const f32x4*)(rope + (v * 16 + 4 * fq) * 2), bq = *(const f32x4*)(rope + (v * 16 + 4 * fq) * 2 + 4);
    c = (f32x4){a[0], a[2], bq[0], bq[2]}; s = (f32x4){a[1], a[3], bq[1], bq[3]};
}

template <bool KROPE>
DI void ph_mla_proj1(const Frame& F) {
    const bf16_t* hb = (const bf16_t*)(F.ws + WS_H); const bf16_t* W = F.wt(WT_P1);
    bf16_t* cq = F.scr(SC_CQ); bf16_t* ckv = F.scr(SC_CKV); bf16_t* Kb = F.scr(SC_K);
    float* sqq = (float*)(F.ws + WS_SQQ); float* sqkv = (float*)(F.ws + WS_SQKV);
    const float* rope = (const float*)(F.ws + WS_ROPE);
    for (int u = F.vcu; u < 130 * (KROPE ? 1 : 3); u += F.G) {
        const int pm = KROPE ? u : u / 3, pn = KROPE ? 3 : u % 3, R0 = pm * 256;
        g8::Acc acc;
#if GEMM_FP8
        g8::gemm_unit<false, false, true, 124>(g8::opnd(as_h((const unsigned char*)hb + (size_t)R0 * 1024), 512), g8::opnd(as_h((const unsigned char*)W + (size_t)pn * 256 * 1024), 512), 512, F.lds, acc);
#else
        g8::gemm_unit<false>(g8::opnd(hb + (size_t)R0 * 1024, 1024), g8::opnd(W + (size_t)pn * 256 * 1024, 1024), 1024, F.lds, acc);
#endif
        const LaneC L = lane_coords();
        if (pn < 3) {
            bf16_t* dst = pn < 2 ? cq + (size_t)R0 * 512 + pn * 256 : ckv + (size_t)R0 * 256;
            const int ldd = pn < 2 ? 512 : 256;
#pragma unroll
            for (int ai = 0; ai < 2; ++ai)
#pragma unroll
                for (int m = 0; m < 4; ++m)
#pragma unroll
                    for (int bj = 0; bj < 2; ++bj)
#pragma unroll
                        for (int n = 0; n < 2; ++n) { st_bf4(dst + (size_t)EPI_R(ai, m) * ldd + EPI_S(bj, n), acc[ai][bj][m][n]); if (n == 1 && bj == 1) __builtin_amdgcn_sched_barrier(0); }
            if (pn < 2) tile_rowsumsq(acc, L, F.lds, sqq + (size_t)R0 * 2 + pn, 2);
            else tile_rowsumsq(acc, L, F.lds, sqkv + R0, 1);
        } else if (L.wc < 2) {
#pragma unroll
            for (int ai = 0; ai < 2; ++ai)
#pragma unroll
                for (int m = 0; m < 4; ++m) {
                    const int row = R0 + EPI_R(ai, m);
                    f32x4 c, s; rope_cs(rope, row, L.wc & 1, L.fq, c, s);
                    const f32x4 x1 = acc[ai][0][m][0], x2 = acc[ai][0][m][1];
                    const f32x4 o1 = x1 * c - x2 * s, o2 = x1 * s + x2 * c;
#if MLA_KEEP_BF16
                    bf16_t* kp = Kb + (size_t)row * 1536 + 128 + 16 * (L.wc & 1) + 4 * L.fq;
#pragma unroll
                    for (int hh = 0; hh < 8; ++hh) { st_bf4(kp + hh * 192, o1); st_bf4(kp + hh * 192 + 32, o2); }
#endif
#if MLA_FP8
                    { unsigned char* k8 = (unsigned char*)F.scr(SC_K8) + (size_t)row * 1536 + 128 + 16 * (L.wc & 1) + 4 * L.fq;
                      const unsigned w1 = pk4_fp8(o1[0], o1[1], o1[2], o1[3]), w2 = pk4_fp8(o2[0], o2[1], o2[2], o2[3]);
#pragma unroll
                      for (int hh = 0; hh < 8; ++hh) { *(unsigned*)(k8 + hh * 192) = w1; *(unsigned*)(k8 + hh * 192 + 32) = w2; } }
#endif
                }
        }
    }
    if (!KROPE) tail_cvt(F, 390, 0, 0, 976);
}
DI void ph_mla_proj2(const Frame& F) {
    ph_mla_proj1<true>(F);
    const bf16_t* cq = F.scr(SC_CQ); const bf16_t* ckv = F.scr(SC_CKV);
    bf16_t* Qb = F.scr(SC_Q); bf16_t* Kb = F.scr(SC_K); bf16_t* Vb = F.scr(SC_V);
    unsigned char* Q8 = (unsigned char*)F.scr(SC_Q8); unsigned char* K8 = (unsigned char*)F.scr(SC_K8); unsigned char* V8T = (unsigned char*)F.scr(SC_V8T);
    const float* sqq = (const float*)(F.ws + WS_SQQ); const float* sqkv = (const float*)(F.ws + WS_SQKV);
    const float* rope = (const float*)(F.ws + WS_ROPE);
    for (int u0 = F.vcu; u0 < 130 * 14 + 130; u0 += F.G) {
        const int u = u0 - 130;
        if (u < 0) continue;
        const int pm = u / 14, pq = u % 14, R0 = pm * 256;
        g8::Acc acc;
        if (pq < 6) {
            const int pn = pq;
            g8::gemm_unit<false>(g8::opnd(cq + (size_t)R0 * 512, 512), g8::opnd(F.wt(WT_UQ) + (size_t)pn * 256 * 512, 512), 512, F.lds, acc); const LaneC L = lane_coords();
#pragma unroll
            for (int ai = 0; ai < 2; ++ai)
#pragma unroll
                for (int m = 0; m < 4; ++m) {
                    const int row = R0 + EPI_R(ai, m);
                    const float rs = rsqrtf((sqq[2 * row] + sqq[2 * row + 1]) * (1.0f / 512.0f) + EPS);
                    bf16_t* qp = Qb + (size_t)row * 1536 + pn * 256; unsigned char* q8 = Q8 + (size_t)row * 1536 + pn * 256;
#pragma unroll
                    for (int bj = 0; bj < 2; ++bj) {
                        const int seg = 4 * pn + 2 * bj + (L.wc >> 1);
                        if (seg % 3 == 2) {
                            f32x4 c, s; rope_cs(rope, row, L.wc & 1, L.fq, c, s);
                            const f32x4 x1 = acc[ai][bj][m][0] * rs, x2 = acc[ai][bj][m][1] * rs;
                            const int co = bj * 128 + (L.wc >> 1) * 64 + 16 * (L.wc & 1) + 4 * L.fq;
                            const f32x4 y1 = x1 * c - x2 * s, y2 = x1 * s + x2 * c;
#if MLA_KEEP_BF16
                            st_bf4(qp + co, y1); st_bf4(qp + co + 32, y2);
#endif
#if MLA_FP8
                            st_fp8x4(q8 + co, y1); st_fp8x4(q8 + co + 32, y2);
#endif
                        } else {
#pragma unroll
                            for (int n = 0; n < 2; ++n) {
#if MLA_KEEP_BF16
                                st_bf4(qp + EPI_S(bj, n), acc[ai][bj][m][n] * rs);
#endif
#if MLA_FP8
                                st_fp8x4(q8 + EPI_S(bj, n), acc[ai][bj][m][n] * rs);
#endif
                            }
                        }
                    }
                }
        } else if (pq < 10) {
            const int hp = pq - 6;
            const bf16_t* w0 = F.wt(WT_UKV) + (size_t)(2 * hp) * 256 * 256;
            g8::gemm_unit<false>(g8::opnd(ckv + (size_t)R0 * 256, 256), g8::opnd(w0, w0 + 256 * 256, 256), 256, F.lds, acc); const LaneC L = lane_coords();
#pragma unroll
            for (int ai = 0; ai < 2; ++ai)
#pragma unroll
                for (int m = 0; m < 4; ++m) {
                    const int row = R0 + EPI_R(ai, m);
                    const float rs = rsqrtf(sqkv[row] * (1.0f / 256.0f) + EPS);
#pragma unroll
                    for (int bj = 0; bj < 2; ++bj)
#pragma unroll
                        for (int n = 0; n < 2; ++n) {
                            const int co = (2 * hp + bj) * 192 + EPI_S(0, n);
#if MLA_KEEP_BF16
                            st_bf4(Kb + (size_t)row * 1536 + co, acc[ai][bj][m][n] * rs);
#endif
#if MLA_FP8
                            st_fp8x4(K8 + (size_t)row * 1536 + co, acc[ai][bj][m][n] * rs);
#endif
                        }
                }
        } else {
            const int hp = pq - 10;
            const bf16_t* w0 = F.wt(WT_UKV) + ((size_t)(2 * hp) * 256 + 128) * 256;
            g8::gemm_unit<false>(g8::opnd(w0, w0 + 256 * 256, 256), g8::opnd(ckv + (size_t)R0 * 256, 256), 256, F.lds, acc); const LaneC L = lane_coords();
#pragma unroll
            for (int bj = 0; bj < 2; ++bj)
#pragma unroll
                for (int n = 0; n < 2; ++n) {
                    const int s = EPI_S(bj, n), tok = R0 + s;
                    const f32x4 q4 = *(const f32x4*)(sqkv + tok);
                    f32x4 rs;
#pragma unroll
                    for (int j = 0; j < 4; ++j) rs[j] = rsqrtf(q4[j] * (1.0f / 256.0f) + EPS);
#pragma unroll
                    for (int ai = 0; ai < 2; ++ai)
#pragma unroll
                        for (int m = 0; m < 4; ++m) {
                            const int hd = 2 * hp + ai, dv = L.wr * 64 + m * 16 + L.fr;
                            const f32x4 v = acc[ai][bj][m][n] * rs;
#if MLA_FP8
                            st_fp8x4(V8T + (size_t)(hd * 128 + dv) * T + tok, v);
#endif
#if MLA_KEEP_BF16
#pragma unroll
                            for (int j = 0; j < 4; ++j) Vb[(size_t)(tok + j) * 1024 + hd * 128 + dv] = (bf16_t)(cvt_pk(v[j], 0.f) & 0xffffu);
#endif
                        }
                }
        }
    }
}
template <bool F8>
DI void ph_wo(const Frame& F, const bf16_t* A, const bf16_t* W, const float* bias, int layer, bool dry = false) {
    bf16_t* xres = (bf16_t*)(F.ws + WS_XRES);
    bf16_t* xdst = dry ? (bf16_t*)(F.ws + WS_END) : xres;
    const int ntm = layer == 3 ? 128 : 130;
    for (int u = F.vcu; u < ntm * 4; u += F.G) {
        int pm = u >> 2; const int pn = u & 3;
        if (layer == 3) pm = pm + 1 + (pm >= 64 ? 1 : 0);
        const int R0 = pm * 256;
        g8::Acc acc;
        if (F8) g8::gemm_unit<false, false, true, 121>(g8::opnd(as_h((const unsigned char*)A + (size_t)R0 * 1024), 512), g8::opnd(as_h((const unsigned char*)W + (size_t)pn * 256 * 1024), 512), 512, F.lds, acc);
        else g8::gemm_unit<false>(g8::opnd(A + (size_t)R0 * 1024, 1024), g8::opnd(W + (size_t)pn * 256 * 1024, 1024), 1024, F.lds, acc);
        const LaneC L = lane_coords();
        const float* g1 = F.modv(layer, tile_modv(pm), 2) + pn * 256;
        float ssq[2][4];
#pragma unroll
        for (int ai = 0; ai < 2; ++ai)
#pragma unroll
            for (int m = 0; m < 4; ++m) ssq[ai][m] = 0.f;
#pragma unroll
        for (int bj = 0; bj < 2; ++bj)
#pragma unroll
            for (int n = 0; n < 2; ++n) {
                const int s = EPI_S(bj, n);
                const f32x4 g = *(const f32x4*)(g1 + s);
                f32x4 bv = (f32x4){0.f, 0.f, 0.f, 0.f};
                if (bias) bv = *(const f32x4*)(bias + pn * 256 + s);
#pragma unroll
                for (int ai = 0; ai < 2; ++ai)
#pragma unroll
                    for (int m = 0; m < 4; ++m) {
                        bf16_t* xp = xres + (size_t)(R0 + EPI_R(ai, m)) * D + pn * 256 + s;
                        const u32x2 xw = *(const u32x2*)xp;
                        f32x4 x = {bflo(xw.x), bfhi(xw.x), bflo(xw.y), bfhi(xw.y)};
                        x += g * (acc[ai][bj][m][n] + bv);
                        st_bf4(xdst + (xp - xres), x);
                        ssq[ai][m] += x[0] * x[0] + x[1] * x[1] + x[2] * x[2] + x[3] * x[3];
                    }
                __builtin_amdgcn_sched_barrier(0);
            }
        {
            float* tb = (float*)F.lds;
#pragma unroll
            for (int ai = 0; ai < 2; ++ai)
#pragma unroll
                for (int m = 0; m < 4; ++m) {
                    float s = ssq[ai][m];
                    s += __shfl_xor(s, 16); s += __shfl_xor(s, 32);
                    if (L.fq == 0) tb[EPI_R(ai, m) * 4 + L.wc] = s;
                }
            __syncthreads();
            int t_ = threadIdx.x; asm volatile("" : "+v"(t_));
            if (t_ < 256) { const f32x4 v = *(const f32x4*)(tb + t_ * 4);
                ((float*)(F.ws + WS_SQX))[(size_t)(R0 + t_) * 4 + pn] = v[0] + v[1] + v[2] + v[3]; }
            __syncthreads();
        }
    }
    if (!dry) {
        if (layer == 0) tail_cvt(F, 520, 0, 976, 2960);
        if (layer == 1) tail_cvt(F, 520, 1, 1464, 3072);
        if (layer == 2) tail_cvt(F, 520, 2, 1500, 3072);
    }
}
DI void ph_na_qkv(const Frame& F) {
    const bf16_t* hb = (const bf16_t*)(F.ws + WS_H);
    for (int u = F.vcu; u < 130 * 12; u += F.G) {
        const int pm = u / 12, pn = u % 12, R0 = pm * 256;
        g8::Acc acc;
#if GEMM_FP8
        g8::gemm_unit<false, false, true, 124>(g8::opnd(as_h((const unsigned char*)hb + (size_t)R0 * 1024), 512), g8::opnd(as_h((const unsigned char*)F.wt(WT_NAQKV) + (size_t)pn * 256 * 1024), 512), 512, F.lds, acc);
#else
        g8::gemm_unit<false>(g8::opnd(hb + (size_t)R0 * 1024, 1024), g8::opnd(F.wt(WT_NAQKV) + (size_t)pn * 256 * 1024, 1024), 1024, F.lds, acc);
#endif
        const LaneC L = lane_coords();
        bf16_t* dst = F.scr(pn < 4 ? SN_Q : (pn < 8 ? SN_K : SN_V)) + (size_t)R0 * 1024 + (pn & 3) * 256;
#pragma unroll
        for (int ai = 0; ai < 2; ++ai)
#pragma unroll
            for (int m = 0; m < 4; ++m)
#pragma unroll
                for (int bj = 0; bj < 2; ++bj)
#pragma unroll
                    for (int n = 0; n < 2; ++n) st_bf4(dst + (size_t)EPI_R(ai, m) * 1024 + EPI_S(bj, n), acc[ai][bj][m][n]);
    }
    tail_cvt(F, 130 * 12, 2, 0, 1500);
}
DI void ph_swa_qkv(const Frame& F) {
    const bf16_t* hb = (const bf16_t*)(F.ws + WS_H);
    const float* rope = (const float*)(F.ws + WS_ROPE);
    for (int u = F.vcu; u < 130 * 6; u += F.G) {
        const int pm = u / 6, pn = u % 6, R0 = pm * 256;
        g8::Acc acc;
#if GEMM_FP8
        g8::gemm_unit<false, false, true, 124>(g8::opnd(as_h((const unsigned char*)hb + (size_t)R0 * 1024), 512), g8::opnd(as_h((const unsigned char*)F.wt(WT_SWQKV) + (size_t)pn * 256 * 1024), 512), 512, F.lds, acc);
#else
        g8::gemm_unit<false>(g8::opnd(hb + (size_t)R0 * 1024, 1024), g8::opnd(F.wt(WT_SWQKV) + (size_t)pn * 256 * 1024, 1024), 1024, F.lds, acc);
#endif
        const LaneC L = lane_coords();
        if (pn < 5) {
            bf16_t* dst = pn < 4 ? F.scr(SS_Q) + (size_t)R0 * 1024 + pn * 256 : F.scr(SS_K) + (size_t)R0 * 256;
            const int ldd = pn < 4 ? 1024 : 256;
#pragma unroll
            for (int ai = 0; ai < 2; ++ai)
#pragma unroll
                for (int m = 0; m < 4; ++m) {
                    const int rl = EPI_R(ai, m);
                    f32x4 c, s; rope_cs(rope, R0 + rl, L.wc & 1, L.fq, c, s);
#pragma unroll
                    for (int bj = 0; bj < 2; ++bj) {
                        const f32x4 x1 = acc[ai][bj][m][0], x2 = acc[ai][bj][m][1];
                        bf16_t* p = dst + (size_t)rl * ldd + bj * 128 + (L.wc >> 1) * 64 + 16 * (L.wc & 1) + 4 * L.fq;
                        st_bf4(p, x1 * c - x2 * s); st_bf4(p + 32, x1 * s + x2 * c);
                    }
                }
        } else {
            bf16_t* dst = F.scr(SS_V) + (size_t)R0 * 256;
#pragma unroll
            for (int ai = 0; ai < 2; ++ai)
#pragma unroll
                for (int m = 0; m < 4; ++m)
#pragma unroll
                    for (int bj = 0; bj < 2; ++bj)
#pragma unroll
                        for (int n = 0; n < 2; ++n) st_bf4(dst + (size_t)EPI_R(ai, m) * 256 + EPI_S(bj, n), acc[ai][bj][m][n]);
        }
    }
    tail_cvt(F, 130 * 6, 3, 0, 1952);
}
DI int moe_expert_of(const int* pst, int slot0) { int e = 0;
#pragma unroll 1
    for (int q = 1; q < 32; ++q) if (pst[q] <= slot0) e = q; return e; }
constexpr int MOE_WS = 124;
template <int LAYER>
DI void ph_moe1(const Frame& F) {
    int* pst = (int*)(F.lds + LDS_MISC + 512);
    moe_pstart(F, LAYER, pst);
    const int MT = pst[32] >> 8, NU = MT * 4, NFULL = (NU / F.G) * F.G, NH = 2 * (NU - NFULL);
    const unsigned char* h8 = F.ws + WS_H; const unsigned char* mw = F.ws + WS_MOEW;
    const int* btok = (const int*)(F.ws + WS_BTOK);
    unsigned char* act = (unsigned char*)F.scr(SM_ACT);
    for (int u = F.vcu; u < NFULL; u += F.G) {
        const int mt = u >> 2, pn = u & 3, e = moe_expert_of(pst, mt * 256);
        g8::Acc acc;
        g8::gemm_unit<true, false, true, MOE_WS>(g8::Opnd{as_h(h8), as_h(h8), 512, btok + mt * 256},
                      g8::opnd(as_h(mw + MOEW_G + (size_t)(e * 512 + pn * 128) * 1024), as_h(mw + MOEW_U + (size_t)(e * 512 + pn * 128) * 1024), 512), 512, F.lds, acc); const LaneC L = lane_coords();
#pragma unroll
        for (int ai = 0; ai < 2; ++ai)
#pragma unroll
            for (int m = 0; m < 4; ++m)
#pragma unroll
                for (int n = 0; n < 2; ++n) {
                    const f32x4 g = acc[ai][0][m][n], up = acc[ai][1][m][n];
                    f32x4 r;
#pragma unroll
                    for (int j = 0; j < 4; ++j) r[j] = silu_f(g[j]) * up[j];
                    st_fp8x4(act + (size_t)(mt * 256 + EPI_R(ai, m)) * 512 + pn * 128 + EPI_S(0, n), r);
                }
    }
    for (int hu = F.vcu; hu < NH; hu += F.G) {
        const int u = NFULL + (hu >> 1), half = hu & 1, mt = u >> 2, pn = u & 3, e = moe_expert_of(pst, mt * 256);
        g8::Acc acc;
        g8::gemm_unit<true, true, true, MOE_WS>(g8::Opnd{as_h(h8), as_h(h8), 512, btok + mt * 256 + 128 * half},
                      g8::opnd(as_h(mw + MOEW_G + (size_t)(e * 512 + pn * 128) * 1024), as_h(mw + MOEW_U + (size_t)(e * 512 + pn * 128) * 1024), 512), 512, F.lds, acc); const LaneC L = lane_coords();
#pragma unroll
        for (int m = 0; m < 4; ++m)
#pragma unroll
            for (int n = 0; n < 2; ++n) {
                const f32x4 g = acc[0][0][m][n], up = acc[0][1][m][n];
                f32x4 r;
#pragma unroll
                for (int j = 0; j < 4; ++j) r[j] = silu_f(g[j]) * up[j];
                st_fp8x4(act + (size_t)(mt * 256 + 128 * half + EPI_R(0, m)) * 512 + pn * 128 + EPI_S(0, n), r);
            }
    }
}
template <bool HALFX>
DI void epi_tile_bf16(g8::Acc& acc, char* lds, bf16_t* __restrict__ dst, const int ldd) {
    constexpr int P = 528, NR = HALFX ? 128 : 256;
    { const LaneC L = lane_coords();
#pragma unroll
      for (int ai = 0; ai < (HALFX ? 1 : 2); ++ai)
#pragma unroll
        for (int m = 0; m < 4; ++m)
#pragma unroll
            for (int bj = 0; bj < 2; ++bj)
#pragma unroll
                for (int n = 0; n < 2; ++n) { const f32x4 v = acc[ai][bj][m][n]; u32x2 w; w.x = cvt_pk(v[0], v[1]); w.y = cvt_pk(v[2], v[3]);
                    *reinterpret_cast<u32x2*>(lds + EPI_R(ai, m) * P + EPI_S(bj, n) * 2) = w; } }
    __syncthreads();
    { int tid = threadIdx.x; asm volatile("" : "+v"(tid));
      const int wave = tid >> 6, lane = tid & 63, sub = lane >> 5, c16 = lane & 31;
#pragma unroll
      for (int i = 0; i < NR / 16; ++i) { const int row = wave * (NR / 8) + 2 * i + sub;
          const u32x4 v = *reinterpret_cast<const u32x4*>(lds + row * P + c16 * 16);
          __builtin_nontemporal_store(v, reinterpret_cast<u32x4*>(dst + (size_t)row * ldd + c16 * 8)); } }
    __syncthreads();
}
template <int LAYER>
DI void ph_moe2(const Frame& F) {
    int* pst = (int*)(F.lds + LDS_MISC + 512);
    moe_pstart(F, LAYER, pst);
    const int MT = pst[32] >> 8, NU = MT * 4, NFULL = (NU / F.G) * F.G, NH = 2 * (NU - NFULL);
    const unsigned char* mw = F.ws + WS_MOEW;
    const unsigned char* act = (const unsigned char*)F.scr(SM_ACT); bf16_t* yb = F.scr(SM_Y);
    for (int u = F.vcu; u < NFULL; u += F.G) {
        const int mt = u >> 2, pn = u & 3, e = moe_expert_of(pst, mt * 256);
        g8::Acc acc;
        g8::gemm_unit<false, false, true, MOE_WS, true, false>(g8::opnd(as_h(act + (size_t)mt * 256 * 512), 256), g8::opnd(as_h(mw + MOEW_D + (size_t)(e * 1024 + pn * 256) * 512), 256), 256, F.lds, acc);
        epi_tile_bf16<false>(acc, F.lds, yb + (size_t)(mt * 256) * D + pn * 256, D);
    }
    for (int hu = F.vcu; hu < NH; hu += F.G) {
        const int u = NFULL + (hu >> 1), half = hu & 1, mt = u >> 2, pn = u & 3, e = moe_expert_of(pst, mt * 256);
        g8::Acc acc;
        const bf16_t* xa = as_h(act + (size_t)(mt * 256 + 128 * half) * 512);
        g8::gemm_unit<false, true, true, MOE_WS, true, false>(g8::opnd(xa, xa, 256), g8::opnd(as_h(mw + MOEW_D + (size_t)(e * 1024 + pn * 256) * 512), 256), 256, F.lds, acc);
        epi_tile_bf16<true>(acc, F.lds, yb + (size_t)(mt * 256 + 128 * half) * D + pn * 256, D);
    }
}
DI void ph_dft_a(const Frame& F) {
    const bf16_t* hb = (const bf16_t*)(F.ws + WS_H);
    bf16_t* Z = F.scr(SF_Z); bf16_t* Zc = F.scr(SF_ZC);
    for (int u = F.vcu; u < 1024 + 16; u += F.G) {
        g8::Acc acc;
        if (u < 1024) {
            const int st = u & 63, rt = (u >> 6) & 1, g = (u >> 7) & 3, b = u >> 9, bg = b * 4 + g;
            { const bf16_t* yb0 = hb + (size_t)(b * TB + NCTX + 2 * st) * 1024 + g * 256;
              g8::gemm_unit<false>(g8::opnd(F.wt(WT_DFTA) + (size_t)rt * 256 * 256, 256), g8::opnd(yb0, yb0 + 1024, 128 * 1024), 256, F.lds, acc); }
            const LaneC L = lane_coords();
#pragma unroll
            for (int ai = 0; ai < 2; ++ai)
#pragma unroll
                for (int m = 0; m < 4; ++m)
#pragma unroll
                    for (int bj = 0; bj < 2; ++bj)
#pragma unroll
                        for (int n = 0; n < 2; ++n) {
                            const int kc = EPI_R(ai, m), n2 = 2 * st + bj, n1 = L.wc * 32 + n * 16 + 4 * L.fq;
                            st_bf4(Z + ((((size_t)bg * 256 + kc) * 128 + n2) * 2 + rt) * 128 + n1, acc[ai][bj][m][n]);
                        }
        } else {
            const int q = u - 1024, rt = q & 1, g = (q >> 1) & 3, b = q >> 3, bg = b * 4 + g;
            g8::gemm_unit<false>(g8::opnd(F.wt(WT_DFTA) + (size_t)rt * 256 * 256, 256), g8::opnd(hb + (size_t)b * TB * 1024 + g * 256, 1024), 256, F.lds, acc); const LaneC L = lane_coords();
#pragma unroll
            for (int ai = 0; ai < 2; ++ai)
#pragma unroll
                for (int m = 0; m < 4; ++m)
#pragma unroll
                    for (int bj = 0; bj < 2; ++bj)
#pragma unroll
                        for (int n = 0; n < 2; ++n)
                            st_bf4(Zc + (((size_t)bg * 256 + EPI_R(ai, m)) * 2 + rt) * 256 + EPI_S(bj, n), acc[ai][bj][m][n]);
        }
    }
    tail_cvt(F, 1040, 1, 0, 720);
}
DI void ph_dft_1(const Frame& F) {
    const bf16_t* Z = F.scr(SF_Z); const bf16_t* Zc = F.scr(SF_ZC); bf16_t* A1 = F.scr(SF_A1); bf16_t* YF = F.scr(SF_YF);
    for (int u = F.vcu; u < 1024 + 8; u += F.G) {
        g8::Acc acc;
        if (u < 1024) {
            g8::gemm_unit<false>(g8::opnd(F.wt(WT_DFT1), 256), g8::opnd(Z + (size_t)u * 256 * 256, 256), 256, F.lds, acc); const LaneC L = lane_coords();
#pragma unroll
            for (int m = 0; m < 4; ++m) {
                const int kb = L.wr * 64 + m * 16 + L.fr;
#pragma unroll
                for (int bj = 0; bj < 2; ++bj)
#pragma unroll
                    for (int n = 0; n < 2; ++n) {
                        const int n2 = L.wc * 32 + n * 16 + 4 * L.fq, bgkc = 2 * u + bj;
                        const f32x4 re = acc[0][bj][m][n], im = acc[1][bj][m][n];
                        f32x4 ro, io;
#pragma unroll
                        for (int j = 0; j < 4; ++j) {
                            const float th = (float)((n2 + j) * kb) * (1.0f / 16384.0f);
                            const float c = __builtin_amdgcn_cosf(th), s = __builtin_amdgcn_sinf(th);
                            ro[j] = re[j] * c + im[j] * s; io[j] = im[j] * c - re[j] * s;
                        }
                        bf16_t* p = A1 + (((size_t)bgkc * 128 + kb) * 2) * 128 + n2;
                        st_bf4(p, ro); st_bf4(p + 128, io);
                        __builtin_amdgcn_sched_barrier(0);
                    }
            }
        } else {
            const int bg = u - 1024, b = bg >> 2, g = bg & 3;
            g8::gemm_unit<false>(g8::opnd(F.wt(WT_DFTC), 512), g8::opnd(Zc + (size_t)bg * 256 * 512, 512), 512, F.lds, acc); const LaneC L = lane_coords();
#pragma unroll
            for (int ai = 0; ai < 2; ++ai)
#pragma unroll
                for (int m = 0; m < 4; ++m)
#pragma unroll
                    for (int bj = 0; bj < 2; ++bj)
#pragma unroll
                        for (int n = 0; n < 2; ++n)
                            st_bf4(YF + (size_t)(b * TB + EPI_R(ai, m)) * 1024 + g * 256 + EPI_S(bj, n), acc[ai][bj][m][n]);
        }
    }
    tail_cvt(F, 1032, 1, 720, 1464);
}
DI void ph_dft_2(const Frame& F) {
    const bf16_t* A1 = F.scr(SF_A1); bf16_t* YF = F.scr(SF_YF);
    for (int u = F.vcu; u < 1024; u += F.G) {
        const int kb = u & 127, bg = u >> 7, b = bg >> 2, g = bg & 3;
        g8::Acc acc;
        g8::gemm_unit<false>(g8::opnd(F.wt(WT_DFT2), 256), g8::opnd(A1 + ((size_t)bg * 256 * 128 + kb) * 256, 128 * 256), 256, F.lds, acc); const LaneC L = lane_coords();
#pragma unroll
        for (int m = 0; m < 4; ++m) {
            const int ka = L.wr * 64 + m * 16 + L.fr;
#pragma unroll
            for (int bj = 0; bj < 2; ++bj)
#pragma unroll
                for (int n = 0; n < 2; ++n)
                    st_bf4(YF + (size_t)(b * TB + NCTX + 128 * ka + kb) * 1024 + g * 256 + EPI_S(bj, n), acc[0][bj][m][n]);
        }
    }
}
constexpr float LOG2E = 1.4426950408889634f;
struct MlaCfg {
    const bf16_t* Q; const bf16_t* K; const bf16_t* V; bf16_t* O; int qrow0, krow0, nt, head;
    DI const bf16_t* qrow(int w, int r) const { return Q + (size_t)(qrow0 + 32 * w + r) * 1536 + head * 192; }
    DI bf16_t* orow(int w, int r) const { return O + (size_t)(qrow0 + 32 * w + r) * 1024 + head * 128; }
    DI int ntiles() const { return nt; }
    DI const bf16_t* ktile(int t) const { return K + (size_t)(krow0 + 64 * t) * 1536 + head * 192; }
    DI const bf16_t* vtile(int t) const { return V + (size_t)(krow0 + 64 * t) * 1024 + head * 128; }
    DI int ldk() const { return 1536; } DI int ldv() const { return 1024; }
    DI bool active(int, int) const { return true; }
    DI void mask(f32x16&, f32x16&, int, int, int, int, const float*) const {}
    DI void init(f32x16& p0, f32x16& p1, int, int, int, int, const float*) const { _Pragma("unroll") for (int r = 0; r < 16; ++r) { p0[r] = 0.f; p1[r] = 0.f; } }
    DI float m0() const { return -1e28f; } DI float l0() const { return 0.f; }
    DI float cexp() const { return 0.07216878364870322f * LOG2E; }
};
template <int PRB>
DI void ph_mla_attn(const Frame& F) {
    for (int u = F.vcu; u < 1024 + 16; u += F.G) {
        MlaCfg c; c.Q = F.scr(SC_Q); c.K = F.scr(SC_K); c.V = F.scr(SC_V); c.O = PRB ? (bf16_t*)(F.ws + WS_END) : F.scr(SC_O);
        if (u < 1024) { const int b = u >> 9, head = (u >> 6) & 7, qb = u & 63; c.qrow0 = b * TB + NCTX + 256 * qb; c.krow0 = b * TB; c.nt = TB / 64; c.head = head; }
        else { const int q = u - 1024, b = q >> 3; c.head = q & 7; c.qrow0 = b * TB; c.krow0 = b * TB; c.nt = NCTX / 64; }
#if MLA_FP8
        at::mla_attn_unit_fp8<PRB>((const unsigned char*)F.scr(SC_Q8) + (size_t)c.qrow0 * 1536 + c.head * 192, (const unsigned char*)F.scr(SC_K8) + (size_t)c.krow0 * 1536 + c.head * 192,
                              (const unsigned char*)F.scr(SC_V8T) + (size_t)(c.head * 128) * T + c.krow0,
                              WO_FP8 ? (bf16_t*)((unsigned char*)c.O + (size_t)c.qrow0 * 1024 + c.head * 128) : c.O + (size_t)c.qrow0 * 1024 + c.head * 128, c.nt, F.lds);
#else
        at::mla_attn_unit<PRB>(c.Q + (size_t)c.qrow0 * 1536 + c.head * 192, c.K + (size_t)c.krow0 * 1536 + c.head * 192, c.V + (size_t)c.krow0 * 1024 + c.head * 128,
                          c.O + (size_t)c.qrow0 * 1024 + c.head * 128, c.nt, F.lds);
#endif
    }
}
#ifdef MLA_CHECK
DI void ph_mla_attn_ref(const Frame& F) {
    for (int u = F.vcu; u < 1024 + 16; u += F.G) {
        MlaCfg c; c.Q = F.scr(SC_Q); c.K = F.scr(SC_K); c.V = F.scr(SC_V); c.O = (bf16_t*)(F.ws + WS_END);
        if (u < 1024) { const int b = u >> 9, head = (u >> 6) & 7, qb = u & 63; c.qrow0 = b * TB + NCTX + 256 * qb; c.krow0 = b * TB; c.nt = TB / 64; c.head = head; }
        else { const int q = u - 1024, b = q >> 3; c.head = q & 7; c.qrow0 = b * TB; c.krow0 = b * TB; c.nt = NCTX / 64; }
        at::attn_unit<192, 128>(c, F.lds, nullptr);
    }
}
DI void ph_mla_compare(const Frame& F) {
    const bf16_t* a = F.scr(SC_O); const bf16_t* b = (const bf16_t*)(F.ws + WS_END);
    float num = 0.f, den = 0.f;
    for (size_t i = (size_t)F.vcu * NTHR + F.tid; i < (size_t)T * 1024; i += (size_t)F.G * NTHR) { const float x = bf2f(a[i]), y = bf2f(b[i]); num += (x - y) * (x - y); den += y * y; }
    num = wave_sum(num); den = wave_sum(den);
    float* acc = (float*)(F.ws + WS_CTL + 32768);
    if (F.lane == 0) { atomicAdd(acc, num); atomicAdd(acc + 1, den); }
}
#endif
struct NaCfg {
    const bf16_t* Q; const bf16_t* K; const bf16_t* V; bf16_t* O; int qrow0, b, head, rg, rs_lo, nt; bool ctxq;
    DI const bf16_t* qrow(int w, int r) const { return Q + (size_t)(qrow0 + 32 * w + r) * 1024 + head * 64; }
    DI bf16_t* orow(int w, int r) const { return O + (size_t)(qrow0 + 32 * w + r) * 1024 + head * 64; }
    DI int ntiles() const { return nt; }
    DI int krow(int t) const { return t < 4 ? b * TB + 64 * t : b * TB + NCTX + 64 * (rs_lo + t - 4); }
    DI const bf16_t* ktile(int t) const { return K + (size_t)krow(t) * 1024 + head * 64; }
    DI const bf16_t* vtile(int t) const { return V + (size_t)krow(t) * 1024 + head * 64; }
    DI int ldk() const { return 1024; } DI int ldv() const { return 1024; }
    DI static int clampi(int x, int lo, int hi) { return x < lo ? lo : (x > hi ? hi : x); }
    DI bool active(int t, int w) const { if (t < 4) return true; const int qr = 4 * rg + (w >> 1), rs = clampi(qr - 4, 0, 248), kr = rs_lo + t - 4; return kr >= rs && kr < rs + 8; }
    DI void init(f32x16& p0, f32x16& p1, int t, int w, int r32, int hi, const float* tbl) const {
        if (t < 4) {
#pragma unroll
            for (int r = 0; r < 16; ++r) { p0[r] = 0.f; p1[r] = 0.f; }
            return;
        }
        const int qr = 4 * rg + (w >> 1), kr = rs_lo + t - 4, qc = (w & 1) * 32 + r32;
        const float* tb = tbl + (kr - qr + 7) * 31 + 15 - qc;
#pragma unroll
        for (int r = 0; r < 16; ++r) { const int k0 = at::crow(r, hi); p0[r] = tb[k0]; p1[r] = tb[32 + k0]; }
    }
    DI void mask(f32x16& p0, f32x16& p1, int t, int w, int r32, int hi, const float*) const {
        if (t < 4) return;
        const int qc = (w & 1) * 32 + r32, cs = clampi(qc - 8, 0, 48);
#pragma unroll
        for (int r = 0; r < 16; ++r) {
            const int k0 = at::crow(r, hi), k1 = 32 + k0;
            p0[r] = (k0 >= cs && k0 < cs + 16) ? p0[r] : -1e30f;
            p1[r] = (k1 >= cs && k1 < cs + 16) ? p1[r] : -1e30f;
        }
    }
    DI float m0() const { return -1e28f; } DI float l0() const { return 0.f; }
    DI float cexp() const { return 0.125f * LOG2E; }
};
DI void ph_na_attn(const Frame& F) {
    float* tbl = (float*)(F.lds + 24576);
    for (int u = F.vcu; u < 2048 + 32; u += F.G) {
        NaCfg c; c.Q = F.scr(SN_Q); c.K = F.scr(SN_K); c.V = F.scr(SN_V); c.O = F.scr(SN_O);
        if (u < 2048) {
            const int b = u >> 10, head = (u >> 6) & 15, rg = u & 63;
            c.b = b; c.head = head; c.rg = rg; c.qrow0 = b * TB + NCTX + 256 * rg; c.ctxq = false;
            c.rs_lo = NaCfg::clampi(4 * rg - 4, 0, 248);
            const int last = NaCfg::clampi(4 * rg + 3 - 4, 0, 248) + 7;
            c.nt = 4 + last - c.rs_lo + 1;
        } else { const int q = u - 2048; c.b = q >> 4; c.head = q & 15; c.rg = 0; c.rs_lo = 0; c.qrow0 = c.b * TB; c.nt = 4; c.ctxq = true; }
        const float* rpb = F.in[I_RPB] + c.head * 465;
        for (int i = F.tid; i < 465; i += NTHR) tbl[i] = rpb[i] * 8.0f;
        at::attn_unit<64, 64>(c, F.lds, tbl);
    }
}
struct SwaCfg {
    const bf16_t* Q; const bf16_t* K; const bf16_t* V; bf16_t* O; int qrow0, b, head, qb, klo, nt; float sink;
    DI const bf16_t* qrow(int w, int r) const { return Q + (size_t)(qrow0 + 32 * w + r) * 1024 + head * 64; }
    DI bf16_t* orow(int w, int r) const { return O + (size_t)(qrow0 + 32 * w + r) * 1024 + head * 64; }
    DI int ntiles() const { return nt; }
    DI int krow(int t) const { return t < 4 ? b * TB + 64 * t : b * TB + NCTX + 64 * (klo + t - 4); }
    DI const bf16_t* ktile(int t) const { return K + (size_t)krow(t) * 256 + (head >> 2) * 64; }
    DI const bf16_t* vtile(int t) const { return V + (size_t)krow(t) * 256 + (head >> 2) * 64; }
    DI int ldk() const { return 256; } DI int ldv() const { return 256; }
    DI bool active(int t, int w) const { if (t < 4) return true; const int qlo = 256 * qb + 32 * w, k0 = 64 * (klo + t - 4); return k0 + 63 >= qlo - 128 && k0 <= qlo + 31 + 128; }
    DI void mask(f32x16& p0, f32x16& p1, int t, int w, int r32, int hi, const float*) const {
        if (t < 4) return;
        const int d0 = 64 * (klo + t - 4) - (256 * qb + 32 * w + r32);
#pragma unroll
        for (int r = 0; r < 16; ++r) {
            const int da = d0 + at::crow(r, hi), db = da + 32;
            p0[r] = (da >= -128 && da <= 128) ? p0[r] : -1e30f;
            p1[r] = (db >= -128 && db <= 128) ? p1[r] : -1e30f;
        }
    }
    DI void init(f32x16& p0, f32x16& p1, int, int, int, int, const float*) const { _Pragma("unroll") for (int r = 0; r < 16; ++r) { p0[r] = 0.f; p1[r] = 0.f; } }
    DI float m0() const { return sink * 8.0f; } DI float l0() const { return 1.f; }
    DI float cexp() const { return 0.125f * LOG2E; }
};
DI void ph_swa_attn(const Frame& F) {
    for (int u = F.vcu; u < 2048; u += F.G) {
        SwaCfg c; c.Q = F.scr(SS_Q); c.K = F.scr(SS_K); c.V = F.scr(SS_V); c.O = F.scr(SS_O);
        const int b = u >> 10, head = (u >> 6) & 15, qb = u & 63;
        c.b = b; c.head = head; c.qb = qb; c.qrow0 = b * TB + NCTX + 256 * qb;
        c.klo = 4 * qb - 2 < 0 ? 0 : 4 * qb - 2;
        const int khi = 4 * qb + 5 > 255 ? 255 : 4 * qb + 5;
        c.nt = 4 + khi - c.klo + 1;
        c.sink = F.in[I_SINK][head];
        at::attn_unit<64, 64>(c, F.lds, nullptr);
    }
}

#ifdef MLA_CHECK
constexpr int N_PHASES = 39;
#else
constexpr int N_PHASES = 37;
#endif
__global__ void __launch_bounds__(NTHR, 2) mk_fwd(Params P) {
    extern __shared__ __attribute__((aligned(16))) char lds[];
    Frame F;
    F.in = (const float* const __attribute__((address_space(4)))*)__builtin_amdgcn_kernarg_segment_ptr(); F.out = P.out; F.ws = P.ws; F.lds = lds;
    F.tid = threadIdx.x; F.lane = F.tid & 63; F.wave = __builtin_amdgcn_readfirstlane(F.tid >> 6);
    F.G = gridDim.x; { const int bx = blockIdx.x; F.vcu = (F.G % 8 == 0) ? (bx % 8) * (F.G / 8) + bx / 8 : bx; }
    const int lo = P.ph_lo, hi = P.ph_hi;
    volatile LAS unsigned* stw = (volatile LAS unsigned*)(lds + LDS_MISC);
    if (F.tid < 4) stw[F.tid] = 0u;
    __syncthreads();
    XcdBarrier bar; bar.bar = (unsigned*)(P.ws + WS_CTL); bar.x = 0; bar.st = stw;
    if (hi - lo > 1) bar = xcd_barrier_post((unsigned*)(P.ws + WS_CTL), stw);
    int ph = 0;
#ifndef REP_MASK
#define REP_MASK 0ull
#endif
#ifndef ONLY_PHASE
#define ONLY_PHASE (-1)
#endif
#define PHASE(body) do { if (lo <= ph && ph < hi && (ONLY_PHASE < 0 || ph == ONLY_PHASE)) { { int t_ = threadIdx.x; asm volatile("" : "+v"(t_)); F.tid = t_; F.lane = t_ & 63; } body; \
    if ((REP_MASK >> ph) & 1ull) { if (hi - lo > 1) xcd_barrier(bar); body; } if (ph + 1 < hi) xcd_barrier(bar); } ++ph; } while (0)
#define PHASE2(body, drybody) do { if (lo <= ph && ph < hi && (ONLY_PHASE < 0 || ph == ONLY_PHASE)) { { int t_ = threadIdx.x; asm volatile("" : "+v"(t_)); F.tid = t_; F.lane = t_ & 63; } body; \
    if ((REP_MASK >> ph) & 1ull) { if (hi - lo > 1) xcd_barrier(bar); drybody; } if (ph + 1 < hi) xcd_barrier(bar); } ++ph; } while (0)
    PHASE(ph_prologue(F));
    PHASE(ph_modreduce(F));
    PHASE2(ph_norm1<0>(F), ph_norm1<0>(F, true));
    PHASE(ph_mla_proj1<false>(F));
    PHASE(ph_mla_proj2(F));
#ifndef MLA_PRB
#define MLA_PRB 0
#endif
    PHASE2(ph_mla_attn<0>(F), ph_mla_attn<MLA_PRB>(F));
#ifdef MLA_CHECK
    PHASE(ph_mla_attn_ref(F));
    PHASE(ph_mla_compare(F));
#endif
    PHASE2(ph_wo<WO_FP8>(F, F.scr(SC_O), F.wt(WT_WO0), nullptr, 0), ph_wo<WO_FP8>(F, F.scr(SC_O), F.wt(WT_WO0), nullptr, 0, true));
    PHASE2(ph_norm2_router<0>(F), ph_norm2_router<0>(F, true));
    PHASE(ph_scatter<0>(F));
    PHASE(ph_moe1<0>(F));
#ifndef MOE2_EPRB
#define MOE2_EPRB 0
#endif
    PHASE(ph_moe2<0>(F));
    PHASE2(ph_norm1<1>(F), ph_norm1<1>(F, true));
    PHASE(ph_dft_a(F));
    PHASE(ph_dft_1(F));
    PHASE(ph_dft_2(F));
    PHASE2(ph_wo<false>(F, F.scr(SF_YF), F.wt(WT_WO1), F.in[I_FBO], 1), ph_wo<false>(F, F.scr(SF_YF), F.wt(WT_WO1), F.in[I_FBO], 1, true));
    PHASE2(ph_norm2_router<1>(F), ph_norm2_router<1>(F, true));
    PHASE(ph_scatter<1>(F));
    PHASE(ph_moe1<1>(F));
    PHASE(ph_moe2<1>(F));
    PHASE2(ph_norm1<2>(F), ph_norm1<2>(F, true));
    PHASE(ph_na_qkv(F));
    PHASE(ph_na_attn(F));
    PHASE2(ph_wo<WO_FP8>(F, F.scr(SN_O), F.wt(WT_WO2), nullptr, 2), ph_wo<WO_FP8>(F, F.scr(SN_O), F.wt(WT_WO2), nullptr, 2, true));
    PHASE2(ph_norm2_router<2>(F), ph_norm2_router<2>(F, true));
    PHASE(ph_scatter<2>(F));
    PHASE(ph_moe1<2>(F));
    PHASE(ph_moe2<2>(F));
    PHASE2(ph_norm1<3>(F), ph_norm1<3>(F, true));
    PHASE(ph_swa_qkv(F));
    PHASE(ph_swa_attn(F));
    PHASE2(ph_wo<WO_FP8>(F, F.scr(SS_O), F.wt(WT_WO3), nullptr, 3), ph_wo<WO_FP8>(F, F.scr(SS_O), F.wt(WT_WO3), nullptr, 3, true));
    PHASE2(ph_norm2_router<3>(F), ph_norm2_router<3>(F, true));
    PHASE(ph_scatter<3>(F));
    PHASE(ph_moe1<3>(F));
    PHASE(ph_moe2<3>(F));
    PHASE2(ph_norm1<4>(F), ph_norm1<4>(F, true));
#undef PHASE
}

extern "C" void kernel_launch(void* const* d_in, const int* in_sizes, int n_in, void* d_out, int out_size, void* d_ws, size_t ws_size, hipStream_t stream) {
    static int grid = 0;
    if (grid == 0) {
        if (n_in != 31 || ws_size < WS_END) { fprintf(stderr, "kernel_launch: n_in %d ws %zu (need %zu)\n", n_in, ws_size, (size_t)WS_END); grid = -1; return; }
        int dev = 0, cus = 0, per_cu = 0;
        if (hipGetDevice(&dev) != hipSuccess || hipDeviceGetAttribute(&cus, hipDeviceAttributeMultiprocessorCount, dev) != hipSuccess) { grid = -1; return; }
        if (hipFuncSetAttribute((const void*)mk_fwd, hipFuncAttributeMaxDynamicSharedMemorySize, LDS_BYTES) != hipSuccess) { fprintf(stderr, "kernel_launch: hipFuncSetAttribute failed\n"); grid = -1; return; }
        if (hipOccupancyMaxActiveBlocksPerMultiprocessor(&per_cu, (const void*)mk_fwd, NTHR, LDS_BYTES) != hipSuccess || per_cu < 1) { fprintf(stderr, "kernel_launch: occupancy query says %d\n", per_cu); (void)hipGetLastError(); per_cu = 1; }
        grid = cus;
    }
    if (grid < 0) return;
    (void)hipMemsetAsync((char*)d_ws + WS_CTL, 0, CTL_BYTES, stream);
    Params p; memset(&p, 0, sizeof(p));
    for (int i = 0; i < 31; ++i) p.in[i] = (const float*)d_in[i];
    p.out = (float*)d_out; p.ws = (unsigned char*)d_ws;
#if MK_ONE_LAUNCH
    p.ph_lo = 0; p.ph_hi = N_PHASES;
    hipLaunchKernelGGL(mk_fwd, dim3(grid), dim3(NTHR), LDS_BYTES, stream, p);
#else
    for (int k = 0; k < N_PHASES; ++k) { p.ph_lo = k; p.ph_hi = k + 1; hipLaunchKernelGGL(mk_fwd, dim3(grid), dim3(NTHR), LDS_BYTES, stream, p); }
#endif
    const hipError_t le = hipPeekAtLastError();
    if (le != hipSuccess) fprintf(stderr, "kernel_launch: launch failed: %s\n", hipGetErrorName(le));
}
```

```cpp
#include <hip/hip_runtime.h>
#include <stdint.h>
#include <stdio.h>
#include <string.h>

#define DI __device__ __forceinline__
#define LAS __attribute__((address_space(3)))
typedef unsigned short bf16_t;
typedef short bf16x8 __attribute__((ext_vector_type(8)));
typedef short s16x4 __attribute__((ext_vector_type(4)));
typedef float f32x4 __attribute__((ext_vector_type(4)));
typedef float f32x16 __attribute__((ext_vector_type(16)));
typedef unsigned u32x4 __attribute__((ext_vector_type(4)));
typedef unsigned u32x2 __attribute__((ext_vector_type(2)));

#ifndef MLA_FP8
#define MLA_FP8 1
#endif
#if defined(MLA_CHECK) || !MLA_FP8
#define MLA_KEEP_BF16 1
#else
#define MLA_KEEP_BF16 0
#endif
#ifndef GEMM_FP8
#if defined(MLA_CHECK)
#define GEMM_FP8 0
#else
#define GEMM_FP8 1
#endif
#endif
#ifndef WO_FP8
#define WO_FP8 GEMM_FP8
#endif
#ifndef MK_ONE_LAUNCH
#define MK_ONE_LAUNCH 1
#endif

constexpr int D = 1024, SEQ = 16384, NCTX = 256, TB = SEQ + NCTX  , T = 2 * TB  ;
constexpr int NTHR = 512;
constexpr int MOE_MAXT = 292;
constexpr int MOE_SLOTS = MOE_MAXT * 256;
constexpr float EPS = 1e-6f;

constexpr size_t al256(size_t x) { return (x + 255) / 256 * 256; }
constexpr size_t WS_CTL = 0;
constexpr size_t CTL_BYTES = 65536;
constexpr size_t CTL_COUNTS = 16384;
constexpr size_t WS_MODP = WS_CTL + CTL_BYTES;
constexpr size_t WS_MODV = WS_MODP + (size_t)16 * 4 * 3 * 6144 * 4;
constexpr size_t WS_MODA = WS_MODV + (size_t)4 * 3 * 6144 * 4;
constexpr size_t WS_ROPE = WS_MODA + (size_t)4 * 3 * 2 * 1024 * 4;
constexpr size_t WS_EID = WS_ROPE + 256 * 16 * 2 * 4;
constexpr size_t WS_GW = WS_EID + (size_t)T * 8;
constexpr size_t WS_POS = WS_GW + (size_t)T * 8;
constexpr size_t WS_SLOT = WS_POS + (size_t)T * 8;
constexpr size_t WS_BTOK = WS_SLOT + (size_t)T * 8;
constexpr size_t WS_SQQ = al256(WS_BTOK + (size_t)MOE_SLOTS * 4);
constexpr size_t WS_SQKV = WS_SQQ + (size_t)T * 8;
constexpr size_t WS_SQX = WS_SQKV + (size_t)T * 4;
constexpr int RW_PITCH = 2064, RW_HALF = 36 * RW_PITCH;
constexpr size_t WS_RW = al256(WS_SQX + (size_t)T * 16);
constexpr size_t WS_WT = al256(WS_RW + (size_t)4 * 2 * RW_HALF);
constexpr size_t WT_P1 = 0;
constexpr size_t WT_UQ = WT_P1 + (size_t)1024 * 1024;
constexpr size_t WT_UKV = WT_UQ + (size_t)1536 * 512;
constexpr size_t WT_WO0 = WT_UKV + (size_t)2048 * 256;
constexpr size_t WT_WO1 = WT_WO0 + (size_t)1024 * 1024;
constexpr size_t WT_NAQKV = WT_WO1 + (size_t)1024 * 1024;
constexpr size_t WT_WO2 = WT_NAQKV + (size_t)3072 * 1024;
constexpr size_t WT_SWQKV = WT_WO2 + (size_t)1024 * 1024;
constexpr size_t WT_WO3 = WT_SWQKV + (size_t)1536 * 1024;
constexpr size_t WT_DFTA = WT_WO3 + (size_t)1024 * 1024;
constexpr size_t WT_DFT1 = WT_DFTA + (size_t)512 * 256;
constexpr size_t WT_DFT2 = WT_DFT1 + (size_t)256 * 256;
constexpr size_t WT_DFTC = WT_DFT2 + (size_t)256 * 256;
constexpr size_t WT_END = WT_DFTC + (size_t)256 * 512;
constexpr size_t WS_MOEW = al256(WS_WT + WT_END * 2);
constexpr size_t MOEW_G = 0, MOEW_U = (size_t)32 * 512 * 1024, MOEW_D = (size_t)2 * 32 * 512 * 1024, MOEW_EL = (size_t)3 * 32 * 512 * 1024;
constexpr size_t WS_XRES = al256(WS_MOEW + MOEW_EL * 2);
constexpr size_t WS_H = WS_XRES + (size_t)T * D * 4;
constexpr size_t WS_SCR = WS_H + (size_t)T * D * 2;
constexpr size_t SC_CQ = 0;
constexpr size_t SC_CKV = SC_CQ + (size_t)T * 512 * 2;
constexpr size_t SC_Q = SC_CKV + (size_t)T * 256 * 2;
constexpr size_t SC_K = SC_Q + (size_t)T * 1536 * 2;
constexpr size_t SC_V = SC_K + (size_t)T * 1536 * 2;
constexpr size_t SC_O = SC_V + (size_t)T * 1024 * 2;
constexpr size_t SC_Q8 = SC_O + (size_t)T * 1024 * 2;
constexpr size_t SC_K8 = SC_Q8 + (size_t)T * 1536;
constexpr size_t SC_V8T = SC_K8 + (size_t)T * 1536;
constexpr size_t SC_END_MLA = SC_V8T + (size_t)T * 1024;
constexpr size_t SF_Z = 0;
constexpr size_t SF_ZC = SF_Z + (size_t)2048 * 128 * 256 * 2;
constexpr size_t SF_A1 = SF_ZC + (size_t)2048 * 512 * 2;
constexpr size_t SF_YF = SF_A1 + (size_t)2048 * 128 * 256 * 2;
constexpr size_t SN_Q = 0, SN_K = (size_t)T * 2048, SN_V = (size_t)T * 4096, SN_O = (size_t)T * 6144;
constexpr size_t SS_Q = 0, SS_K = (size_t)T * 2048, SS_V = SS_K + (size_t)T * 512, SS_O = SS_V + (size_t)T * 512;
constexpr size_t SM_ACT = 0;
constexpr size_t SM_Y = (size_t)MOE_SLOTS * 1024;
constexpr size_t SM_END = SM_Y + (size_t)MOE_SLOTS * 2048;
constexpr size_t SCR_BYTES = SC_END_MLA > SM_END ? SC_END_MLA : SM_END;
constexpr size_t WS_END = WS_SCR + SCR_BYTES;

constexpr int LDS_MISC = 152 * 1024;
constexpr int LDS_BYTES = 156 * 1024;

DI unsigned cvt_pk(float lo, float hi) { unsigned r; asm volatile("v_cvt_pk_bf16_f32 %0, %1, %2" : "=v"(r) : "v"(lo), "v"(hi)); return r; }
DI float bf2f(bf16_t x) { return __uint_as_float((unsigned)x << 16); }
DI float bflo(unsigned w) { return __uint_as_float(w << 16); }
DI float bfhi(unsigned w) { return __uint_as_float(w & 0xffff0000u); }
DI float silu_f(float x) { return x / (1.0f + __expf(-x)); }
DI float wave_sum(float v) {
#pragma unroll
    for (int o = 32; o >= 1; o >>= 1) v += __shfl_xor(v, o);
    return v;
}

#define XB_TMO      128
#define XB_XCNT(j)  (256  + 64 * (j))
#define XB_XSUB(j)  (1280 + 64 * (j))
#define XB_XGEN(j)  (2304 + 64 * (j))
#define XB_TOP      3328
#define XB_TOPGEN   3392
#define XCD_BAR_WORDS 3456
#define XB_SPIN_CAP (1u << 18)

__device__ __forceinline__ unsigned xb_ld(unsigned* p)              { return __hip_atomic_load(p, __ATOMIC_RELAXED, __HIP_MEMORY_SCOPE_AGENT); }
__device__ __forceinline__ unsigned xb_add(unsigned* p, unsigned v) { return __hip_atomic_fetch_add(p, v, __ATOMIC_RELAXED, __HIP_MEMORY_SCOPE_AGENT); }
__device__ __forceinline__ unsigned xb_xcc_id() { return (unsigned)__builtin_amdgcn_s_getreg((3 << 11) | 20) & 0xFu; }
#define XB_SPIN(cond, bar) do { unsigned _sp = 0; while (cond) { __builtin_amdgcn_s_sleep(1); \
    if ((++_sp & 255u) == 0u) { if (xb_ld(&(bar)[XB_TMO])) break; if (_sp > XB_SPIN_CAP) { atomicAdd(&(bar)[XB_TMO], 1u); break; } } } } while (0)

struct XcdBarrier {
    unsigned* bar; unsigned x;
    volatile LAS unsigned* st;
};
__device__ __forceinline__ XcdBarrier xcd_barrier_post(unsigned* bar, volatile LAS unsigned* st) {
    XcdBarrier b; b.bar = bar; b.x = xb_xcc_id(); b.st = st;
    if (threadIdx.x == 0) (void)xb_add(&bar[XB_XCNT(b.x)], 1u);
    return b;
}
__device__ __forceinline__ void xcd_barrier_complete(unsigned* bar, unsigned x, unsigned& nloc, unsigned& nx) {
    const unsigned G = gridDim.x * gridDim.y * gridDim.z;
    unsigned sum, cnt, mine, sp = 0u;
    for (;;) {
        sum = 0u; cnt = 0u; mine = 0u;
#pragma unroll
        for (unsigned j = 0; j < 16; ++j) { const unsigned c = xb_ld(&bar[XB_XCNT(j)]); sum += c; cnt += (c > 0u) ? 1u : 0u; mine = (j == x) ? c : mine; }
        if (sum == G) break;
        __builtin_amdgcn_s_sleep(1);
        if ((++sp & 255u) == 0u) { if (xb_ld(&bar[XB_TMO])) break; if (sp > XB_SPIN_CAP) { atomicAdd(&bar[XB_TMO], 1u); break; } }
    }
    nloc = mine > 0u ? mine : 1u; nx = cnt > 0u ? cnt : 1u;
}
__device__ __forceinline__ void xcd_barrier(const XcdBarrier& b) {
    asm volatile("s_waitcnt vmcnt(0)" ::: "memory");
    __syncthreads();
    if (threadIdx.x == 0) {
        unsigned* bar = b.bar;
        __builtin_amdgcn_s_waitcnt(0);
        unsigned nloc = b.st[0], nx = b.st[1];
        if (nloc == 0u) { xcd_barrier_complete(bar, b.x, nloc, nx); b.st[0] = nloc; b.st[1] = nx; }
        const unsigned old = xb_add(&bar[XB_XSUB(b.x)], 1u);
        const unsigned gen = old / nloc;
        if (old + 1u == (gen + 1u) * nloc) {
            __builtin_amdgcn_fence(__ATOMIC_RELEASE, "agent");
            asm volatile("s_waitcnt vmcnt(0)" ::: "memory");
            const unsigned og = xb_add(&bar[XB_TOP], 1u);
            const unsigned tg = og / nx;
            if (og + 1u == (tg + 1u) * nx) xb_add(&bar[XB_TOPGEN], 1u);
            else XB_SPIN(xb_ld(&bar[XB_TOPGEN]) == tg, bar);
            __builtin_amdgcn_fence(__ATOMIC_ACQUIRE, "agent");
            xb_add(&bar[XB_XGEN(b.x)], 1u);
            asm volatile("s_waitcnt vmcnt(0)" ::: "memory");
        } else {
            XB_SPIN(xb_ld(&bar[XB_XGEN(b.x)]) == gen, bar);
            __builtin_amdgcn_fence(__ATOMIC_ACQUIRE, "agent");
            asm volatile("s_waitcnt vmcnt(0)" ::: "memory");
        }
    }
    __syncthreads();
}

namespace g8 {
#ifndef PIN8
#define PIN8 1
#endif
#ifndef G8_MERGE
#define G8_MERGE 0
#endif
constexpr int HTB = 128 * 64 * 2;
constexpr int STAGE_BYTES = 8 * HTB;
DI int lds_byte(int r, int c) { const int st = (r >> 4) * 2 + (c >> 5), rr = r & 15, cc = c & 31, ob = rr * 64 + cc * 2; return st * 1024 + (ob ^ (((ob >> 9) & 1) << 5)); }
DI void stage_rc(int b, int& R, int& C) { const int st = b / 1024, sb = b % 1024, swz = sb ^ (((sb >> 9) & 1) << 5); R = (st >> 1) * 16 + swz / 64; C = (st & 1) * 32 + (swz % 64) / 2; }

typedef f32x4 Acc[2][2][4][2];
typedef int v8i_t __attribute__((ext_vector_type(8)));
DI v8i_t ld8_2x16(const char* p) { const u32x4 a = *reinterpret_cast<const u32x4*>(p), b = *reinterpret_cast<const u32x4*>(p + 16); return (v8i_t){(int)a.x, (int)a.y, (int)a.z, (int)a.w, (int)b.x, (int)b.y, (int)b.z, (int)b.w}; }

struct Opnd { const bf16_t* b0; const bf16_t* b1; int ld; const int* idx; };
DI Opnd opnd(const bf16_t* b0, const bf16_t* b1, int ld) { return Opnd{b0, b1, ld, nullptr}; }
DI Opnd opnd(const bf16_t* b0, int ld) { return Opnd{b0, b0 + (size_t)128 * ld, ld, nullptr}; }
template <bool GATHER, bool HALFX = false, bool FP8 = false, int YSCALE = 127, bool LD16 = true, bool MERGE = (G8_MERGE != 0)>
DI void gemm_unit(const Opnd X, const Opnd Y, const int K, char* lds, Acc& acc) {
    int tid = threadIdx.x; asm volatile("" : "+v"(tid));
    int r0, c0; stage_rc(tid * 16, r0, c0);
    unsigned vx0, vx1, vx2, vx3;
    if (GATHER) { vx0 = (unsigned)(X.idx[r0] * X.ld + c0) * 2u; vx1 = (unsigned)(X.idx[r0 + 64] * X.ld + c0) * 2u;
                  if (HALFX) { vx2 = vx0; vx3 = vx1; } else { vx2 = (unsigned)(X.idx[128 + r0] * X.ld + c0) * 2u; vx3 = (unsigned)(X.idx[192 + r0] * X.ld + c0) * 2u; } }
    else { vx0 = (unsigned)(r0 * X.ld + c0) * 2u; vx1 = vx0; vx2 = vx0; vx3 = vx0; }
    const unsigned vy0 = (unsigned)(r0 * Y.ld + c0) * 2u;
    const size_t xd64 = GATHER ? 0 : (size_t)128 * X.ld, yd64 = (size_t)128 * Y.ld;
    const char* const XB0 = (const char*)X.b0; const char* const XB1 = GATHER ? (const char*)X.b0 : (const char*)X.b1;
    const char* const YB0 = (const char*)Y.b0; const char* const YB1 = (const char*)Y.b1;
    const int wid = tid >> 6, lane = tid & 63, wr = wid >> 2, wc = wid & 3, fr = lane & 15, fq = lane >> 4;
    const int wbase = __builtin_amdgcn_readfirstlane(tid >> 6) * 1024;
    const int swz_ = (fr * 64 + fq * 16) ^ ((((fr * 64 + fq * 16) >> 9) & 1) << 5);
    const char* const abase = lds + wr * 8192 + swz_;
    const char* const bbase = lds + 4 * HTB + wc * 4096 + swz_;
    const int swz8_ = (fr * 64 + (fq & 1) * 32) ^ ((((fr * 64 + (fq & 1) * 32) >> 9) & 1) << 5);
    const char* const abase8 = lds + wr * 8192 + (fq >> 1) * 1024 + swz8_;
    const char* const bbase8 = lds + 4 * HTB + wc * 4096 + (fq >> 1) * 1024 + swz8_;
#define SA(b, h) (lds + ((b) * 2 + (h)) * HTB)
#define SB(b, h) (lds + (4 + (b) * 2 + (h)) * HTB)
#define STG(P, BASE, DELTA, o0, o1, kt) do { const char* _s = (BASE) + (size_t)(kt) * 128; unsigned o0_ = (o0), o1_ = (o1); \
    if (FP8) asm volatile("" : "+v"(o0_), "+v"(o1_));     \
    __builtin_amdgcn_global_load_lds((const unsigned*)(_s + o0_), (unsigned*)((P) + wbase), 16, 0, 0); \
    __builtin_amdgcn_global_load_lds((const unsigned*)(_s + (DELTA) + o1_), (unsigned*)((P) + wbase + 8192), 16, 0, 0); } while (0)
#define STGA(b, h, kt) do { if ((h) == 0) STG(SA(b, 0), XB0, xd64, vx0, vx1, kt); else STG(SA(b, 1), XB1, xd64, vx2, vx3, kt); } while (0)
#define STGB(b, h, kt) do { if ((h) == 0) STG(SB(b, 0), YB0, yd64, vy0, vy0, kt); else STG(SB(b, 1), YB1, yd64, vy0, vy0, kt); } while (0)
#define LD8(P) (LD16 ? ld8_2x16(P) : *reinterpret_cast<const v8i_t*>(P))
#define LDA(dst, b, h) do { if (FP8) { _Pragma("unroll") for (int m = 0; m < 4; ++m) dst##8[m] = LD8(abase8 + (((b) * 2 + (h)) * HTB + m * 2048)); } \
    else { _Pragma("unroll") for (int m = 0; m < 4; ++m) _Pragma("unroll") for (int k = 0; k < 2; ++k) dst[m][k] = *reinterpret_cast<const bf16x8*>(abase + (((b) * 2 + (h)) * HTB + m * 2048 + k * 1024)); } } while (0)
#define LDB(dst, b, h) do { if (FP8) { _Pragma("unroll") for (int n = 0; n < 2; ++n) dst##8[n] = LD8(bbase8 + (((b) * 2 + (h)) * HTB + n * 2048)); } \
    else { _Pragma("unroll") for (int n = 0; n < 2; ++n) _Pragma("unroll") for (int k = 0; k < 2; ++k) dst[n][k] = *reinterpret_cast<const bf16x8*>(bbase + (((b) * 2 + (h)) * HTB + n * 2048 + k * 1024)); } } while (0)
#define MMA(ai, bj, At, Bt) do { if (FP8 && HALFX && (ai) == 1) break; if (FP8) __builtin_amdgcn_sched_barrier(0); __builtin_amdgcn_s_setprio(1); \
    if (FP8) { _Pragma("unroll") for (int m = 0; m < 4; ++m) _Pragma("unroll") for (int n = 0; n < 2; ++n) \
      acc[ai][bj][m][n] = __builtin_amdgcn_mfma_scale_f32_16x16x128_f8f6f4(Bt##8[n], At##8[m], acc[ai][bj][m][n], 0, 0, 0, sc_y, 0, sc_x); } \
    else { _Pragma("unroll") for (int m = 0; m < 4; ++m) _Pragma("unroll") for (int n = 0; n < 2; ++n) _Pragma("unroll") for (int k = 0; k < 2; ++k) \
      acc[ai][bj][m][n] = __builtin_amdgcn_mfma_f32_16x16x32_bf16(Bt[n][k], At[m][k], acc[ai][bj][m][n], 0, 0, 0); } \
    __builtin_amdgcn_s_setprio(0); \
    if (FP8 && PIN8) { asm volatile("" :: "v"(acc[ai][bj][0][0]), "v"(acc[ai][bj][0][1]), "v"(acc[ai][bj][1][0]), "v"(acc[ai][bj][1][1]), "v"(acc[ai][bj][2][0]), "v"(acc[ai][bj][2][1]), "v"(acc[ai][bj][3][0]), "v"(acc[ai][bj][3][1])); \
               __builtin_amdgcn_sched_barrier(0); } } while (0)
#define WAIT_V(n) asm volatile("s_waitcnt vmcnt(" #n ")" ::: "memory")
#define WAIT_L(n) asm volatile("s_waitcnt lgkmcnt(" #n ")" ::: "memory")
#define BAR __builtin_amdgcn_s_barrier()
#define SCHED __builtin_amdgcn_sched_barrier(0)
#pragma unroll
    for (int a = 0; a < 2; ++a)
#pragma unroll
        for (int b = 0; b < 2; ++b)
#pragma unroll
            for (int m = 0; m < 4; ++m)
#pragma unroll
                for (int n = 0; n < 2; ++n) acc[a][b][m][n] = (f32x4){0.f, 0.f, 0.f, 0.f};
    bf16x8 At[4][2], B0[2][2], B1[2][2];
    v8i_t At8[4], B08[2], B18[2];
    int sc_y = YSCALE * 0x01010101; if (FP8) asm volatile("" : "+v"(sc_y));
    const int sc_x = sc_y;
    int nt = K / 64; if (FP8) asm volatile("" : "+s"(nt));
    STGB(0, 0, 0); STGA(0, 0, 0); STGB(0, 1, 0); STGA(0, 1, 0);
    if constexpr (FP8 && MERGE) { STGB(1, 0, 1); STGA(1, 0, 1); STGB(1, 1, 1); WAIT_V(6); BAR; if (wr == 1) BAR; }
    else {
    if (wr == 1) BAR;
    WAIT_V(4); BAR;
    STGB(1, 0, 1); STGA(1, 0, 1); STGB(1, 1, 1);
    WAIT_V(6); BAR;
    }
    if constexpr (FP8 && MERGE) {
#pragma unroll 1
    for (int t = 0; t < nt - 2; t += 2) {
        LDB(B0, 0, 0); LDB(B1, 0, 1); SCHED; LDA(At, 0, 0); SCHED; STGA(1, 1, t + 1);
        WAIT_L(0); BAR; MMA(0, 0, At, B0); MMA(0, 1, At, B1); BAR; SCHED;
        LDA(At, 0, 1); SCHED; STGB(0, 0, t + 2); STGA(0, 0, t + 2); STGB(0, 1, t + 2);
        WAIT_V(6); WAIT_L(0); BAR; MMA(1, 0, At, B0); MMA(1, 1, At, B1); BAR; SCHED;
        LDB(B0, 1, 0); LDB(B1, 1, 1); SCHED; LDA(At, 1, 0); SCHED; STGA(0, 1, t + 2);
        WAIT_L(0); BAR; MMA(0, 0, At, B0); MMA(0, 1, At, B1); BAR; SCHED;
        LDA(At, 1, 1); SCHED; STGB(1, 0, t + 3); STGA(1, 0, t + 3); STGB(1, 1, t + 3);
        WAIT_V(6); WAIT_L(0); BAR; MMA(1, 0, At, B0); MMA(1, 1, At, B1); BAR; SCHED;
    }
    { LDB(B0, 0, 0); LDB(B1, 0, 1); SCHED; LDA(At, 0, 0); SCHED; STGA(1, 1, nt - 1);
      WAIT_L(0); BAR; MMA(0, 0, At, B0); MMA(0, 1, At, B1); BAR; SCHED;
      LDA(At, 0, 1); WAIT_V(0); WAIT_L(0); BAR; MMA(1, 0, At, B0); MMA(1, 1, At, B1); BAR; SCHED; }
    { LDB(B0, 1, 0); LDB(B1, 1, 1); SCHED; LDA(At, 1, 0);
      WAIT_L(0); BAR; MMA(0, 0, At, B0); MMA(0, 1, At, B1); BAR; SCHED;
      LDA(At, 1, 1); WAIT_L(0); BAR; MMA(1, 0, At, B0); MMA(1, 1, At, B1); BAR; }
    } else {
#pragma unroll 1
    for (int t = 0; t < nt - 2; t += 2) {
        LDB(B0, 0, 0); SCHED; LDA(At, 0, 0); STGA(1, 1, t + 1);
        WAIT_L(8); BAR; WAIT_L(0); MMA(0, 0, At, B0); BAR; SCHED;
        LDB(B1, 0, 1); STGB(0, 0, t + 2);
        BAR; WAIT_L(0); MMA(0, 1, At, B1); BAR;
        LDA(At, 0, 1); STGA(0, 0, t + 2);
        BAR; WAIT_L(0); MMA(1, 0, At, B0); BAR; SCHED;
        STGB(0, 1, t + 2);
        WAIT_V(6); BAR; MMA(1, 1, At, B1); BAR;
        LDB(B0, 1, 0); SCHED; LDA(At, 1, 0); STGA(0, 1, t + 2);
        WAIT_L(8); BAR; WAIT_L(0); MMA(0, 0, At, B0); BAR; SCHED;
        LDB(B1, 1, 1); STGB(1, 0, t + 3);
        BAR; WAIT_L(0); MMA(0, 1, At, B1); BAR;
        LDA(At, 1, 1); STGA(1, 0, t + 3);
        BAR; WAIT_L(0); MMA(1, 0, At, B0); BAR; SCHED;
        STGB(1, 1, t + 3);
        WAIT_V(6); BAR; MMA(1, 1, At, B1); BAR;
    }
    { LDB(B0, 0, 0); WAIT_V(0); LDA(At, 0, 0); STGA(1, 1, nt - 1);
      BAR; WAIT_L(0); MMA(0, 0, At, B0); BAR;
      LDB(B1, 0, 1); BAR; WAIT_L(0); MMA(0, 1, At, B1); BAR;
      LDA(At, 0, 1); WAIT_V(4); BAR; WAIT_L(0); MMA(1, 0, At, B0); MMA(1, 1, At, B1); BAR; }
    { LDB(B0, 1, 0); LDA(At, 1, 0); WAIT_V(2); BAR; WAIT_L(0); MMA(0, 0, At, B0); BAR;
      LDB(B1, 1, 1); WAIT_V(0); BAR; WAIT_L(0); MMA(0, 1, At, B1); BAR;
      LDA(At, 1, 1); BAR; WAIT_L(0); MMA(1, 0, At, B0); MMA(1, 1, At, B1); BAR; }
    }
    if (wr == 0) BAR;
#undef SA
#undef SB
#undef STG
#undef STGA
#undef STGB
#undef LDA
#undef LDB
#undef MMA
#undef LD8
}
}

struct LaneC { int wr, wc, fr, fq; };
DI LaneC lane_coords() { int tid = threadIdx.x; asm volatile("" : "+v"(tid)); const int wid = tid >> 6, lane = tid & 63; return LaneC{wid >> 2, wid & 3, lane & 15, lane >> 4}; }
#define EPI_R(ai, m) ((ai) * 128 + L.wr * 64 + (m) * 16 + L.fr)
#define EPI_S(bj, n) ((bj) * 128 + L.wc * 32 + (n) * 16 + 4 * L.fq)
DI void st_bf4(bf16_t* p, f32x4 v) { u32x2 w; w.x = cvt_pk(v[0], v[1]); w.y = cvt_pk(v[2], v[3]); *(u32x2*)p = w; }
DI unsigned pk4_fp8(float a, float b, float c, float d) { int w = __builtin_amdgcn_cvt_pk_fp8_f32(a, b, 0, false); w = __builtin_amdgcn_cvt_pk_fp8_f32(c, d, w, true); return (unsigned)w; }
DI unsigned pk4_fp8o(float a, float b, float c, float d) { int w = __builtin_amdgcn_cvt_pk_fp8_f32(a, b, (int)__float_as_uint(a), false); w = __builtin_amdgcn_cvt_pk_fp8_f32(c, d, w, true); return (unsigned)w; }
DI void st_fp8x4(unsigned char* p, f32x4 v) { *(unsigned*)p = pk4_fp8(v[0], v[1], v[2], v[3]); }
DI unsigned char fp8_1(float x) { return (unsigned char)(__builtin_amdgcn_cvt_pk_fp8_f32(x, 0.f, 0, false) & 0xff); }
DI const bf16_t* as_h(const unsigned char* p) { return (const bf16_t*)p; }
namespace at {
DI int crow(int r, int hi) { return (r & 3) + 8 * (r >> 2) + 4 * hi; }
template <int OFF> DI s16x4 tr_read(unsigned a) { s16x4 r; asm volatile("ds_read_b64_tr_b16 %0, %1 offset:%2" : "=&v"(r) : "v"(a), "i"(OFF) : "memory"); return r; }
#define AT_PK4(P, BASE, OUT) do { unsigned a0 = cvt_pk(P[BASE + 0], P[BASE + 1]), a1 = cvt_pk(P[BASE + 2], P[BASE + 3]); \
    unsigned b0 = cvt_pk(P[BASE + 4], P[BASE + 5]), b1 = cvt_pk(P[BASE + 6], P[BASE + 7]); \
    auto r0 = __builtin_amdgcn_permlane32_swap(a0, b0, false, false); auto r1 = __builtin_amdgcn_permlane32_swap(a1, b1, false, false); \
    u32x4 w = {r0[0], r1[0], r0[1], r1[1]}; OUT = __builtin_bit_cast(bf16x8, w); } while (0)

template <int DV, int VROW, int D0> DI void pv_one(f32x16& od, unsigned vb, bf16x8 pa0, bf16x8 pa1, bf16x8 pa2, bf16x8 pa3) {
    const s16x4 l0 = tr_read<(0 * 16) * VROW + 64 * D0>(vb), h0 = tr_read<(0 * 16 + 4) * VROW + 64 * D0>(vb);
    const s16x4 l1 = tr_read<(1 * 16) * VROW + 64 * D0>(vb), h1 = tr_read<(1 * 16 + 4) * VROW + 64 * D0>(vb);
    const s16x4 l2 = tr_read<(2 * 16) * VROW + 64 * D0>(vb), h2 = tr_read<(2 * 16 + 4) * VROW + 64 * D0>(vb);
    const s16x4 l3 = tr_read<(3 * 16) * VROW + 64 * D0>(vb), h3 = tr_read<(3 * 16 + 4) * VROW + 64 * D0>(vb);
    asm volatile("s_waitcnt lgkmcnt(0)" ::: "memory"); __builtin_amdgcn_sched_barrier(0);
#define AT_PK(Lo, Hi) (bf16x8){Lo[0], Lo[1], Lo[2], Lo[3], Hi[0], Hi[1], Hi[2], Hi[3]}
    od = __builtin_amdgcn_mfma_f32_32x32x16_bf16(pa0, AT_PK(l0, h0), od, 0, 0, 0);
    od = __builtin_amdgcn_mfma_f32_32x32x16_bf16(pa1, AT_PK(l1, h1), od, 0, 0, 0);
    od = __builtin_amdgcn_mfma_f32_32x32x16_bf16(pa2, AT_PK(l2, h2), od, 0, 0, 0);
    od = __builtin_amdgcn_mfma_f32_32x32x16_bf16(pa3, AT_PK(l3, h3), od, 0, 0, 0);
#undef AT_PK
}

template <int DQK, int DV, class Cfg>
DI void attn_unit(const Cfg& cfg, char* lds, const float* tbl) {
    constexpr int KROW = DQK * 2 + 16, VROW = DV * 2 + 16, KCH = DQK / 8, VCH = DV / 8, NKL = 64 * KCH / NTHR, NVL = 64 * VCH / NTHR, ND = DQK / 16, NO = DV / 32;
    static_assert(64 * KCH % NTHR == 0 && 64 * VCH % NTHR == 0, "staging split");
    const int tid = threadIdx.x, lane = tid & 63, r32 = lane & 31, hi = lane >> 5;
    const int wave = __builtin_amdgcn_readfirstlane(tid >> 6);
    char* Ks = lds; char* Vs = lds + 64 * KROW; float* al = (float*)(lds + 64 * KROW + 64 * VROW) + wave * 64;
    bf16x8 qr[ND];
    { const bf16_t* qp = cfg.qrow(wave, r32) + hi * 8;
#pragma unroll
      for (int d0 = 0; d0 < ND; ++d0) qr[d0] = *reinterpret_cast<const bf16x8*>(qp + d0 * 16); }
    f32x16 o[NO];
#pragma unroll
    for (int d = 0; d < NO; ++d)
#pragma unroll
        for (int r = 0; r < 16; ++r) o[d][r] = 0.f;
    float m_reg = cfg.m0(), l_reg = cfg.l0();
    const float C = cfg.cexp();
    const int NT = cfg.ntiles(), ldk = cfg.ldk(), ldv = cfg.ldv();
    bf16x8 kreg[NKL], vreg[NVL];
    const unsigned vb = (unsigned)(uintptr_t)Vs + (unsigned)((8 * hi + ((lane & 15) >> 2)) * VROW + (16 * ((lane >> 4) & 1) + 4 * (lane & 3)) * 2);
#define AT_LOAD(t) do { const bf16_t* kp = cfg.ktile(t); const bf16_t* vp = cfg.vtile(t); \
    _Pragma("unroll") for (int i = 0; i < NKL; ++i) { const int c = tid + NTHR * i, row = c / KCH, cc = c % KCH; kreg[i] = *reinterpret_cast<const bf16x8*>(kp + (long)row * ldk + cc * 8); } \
    _Pragma("unroll") for (int i = 0; i < NVL; ++i) { const int c = tid + NTHR * i, row = c / VCH, cc = c % VCH; vreg[i] = *reinterpret_cast<const bf16x8*>(vp + (long)row * ldv + cc * 8); } } while (0)
    AT_LOAD(0);
    for (int t = 0; t < NT; ++t) {
        __syncthreads();
#pragma unroll
        for (int i = 0; i < NKL; ++i) { const int c = tid + NTHR * i, row = c / KCH, cc = c % KCH; *reinterpret_cast<bf16x8*>(Ks + row * KROW + cc * 16) = kreg[i]; }
#pragma unroll
        for (int i = 0; i < NVL; ++i) { const int c = tid + NTHR * i, row = c / VCH, cc = c % VCH; *reinterpret_cast<bf16x8*>(Vs + row * VROW + cc * 16) = vreg[i]; }
        __syncthreads();
        if (t + 1 < NT) AT_LOAD(t + 1);
        if (cfg.active(t, wave)) {
            f32x16 p0, p1;
            cfg.init(p0, p1, t, wave, r32, hi, tbl);
#pragma unroll
            for (int d0 = 0; d0 < ND; ++d0) {
                const int cb = (d0 * 16 + hi * 8) * 2;
                const bf16x8 b0 = *reinterpret_cast<const bf16x8*>(Ks + r32 * KROW + cb);
                const bf16x8 b1 = *reinterpret_cast<const bf16x8*>(Ks + (32 + r32) * KROW + cb);
                p0 = __builtin_amdgcn_mfma_f32_32x32x16_bf16(b0, qr[d0], p0, 0, 0, 0);
                p1 = __builtin_amdgcn_mfma_f32_32x32x16_bf16(b1, qr[d0], p1, 0, 0, 0);
            }
            cfg.mask(p0, p1, t, wave, r32, hi, tbl);
            float pmax = p0[0];
#pragma unroll
            for (int r = 1; r < 16; ++r) pmax = fmaxf(pmax, p0[r]);
#pragma unroll
            for (int r = 0; r < 16; ++r) pmax = fmaxf(pmax, p1[r]);
            { auto rr = __builtin_amdgcn_permlane32_swap(__float_as_uint(pmax), __float_as_uint(pmax), false, false);
              pmax = fmaxf(__uint_as_float(rr[0]), __uint_as_float(rr[1])); }
            const float mn = fmaxf(m_reg, pmax);
            const float alpha = __builtin_amdgcn_exp2f((m_reg - mn) * C);
            m_reg = mn;
            const float mnC = -mn * C;
            float ps = 0.f;
#pragma unroll
            for (int r = 0; r < 16; ++r) { p0[r] = __builtin_amdgcn_exp2f(fmaf(p0[r], C, mnC)); ps += p0[r]; }
#pragma unroll
            for (int r = 0; r < 16; ++r) { p1[r] = __builtin_amdgcn_exp2f(fmaf(p1[r], C, mnC)); ps += p1[r]; }
            { auto rr = __builtin_amdgcn_permlane32_swap(__float_as_uint(ps), __float_as_uint(ps), false, false);
              ps = __uint_as_float(rr[0]) + __uint_as_float(rr[1]); }
            l_reg = l_reg * alpha + ps;
            if (__any(alpha < 1.f)) {
                if (hi == 0) al[r32] = alpha;
                asm volatile("s_waitcnt lgkmcnt(0)" ::: "memory");
#pragma unroll
                for (int r = 0; r < 16; ++r) { const float a = al[crow(r, hi)];
#pragma unroll
                    for (int d = 0; d < NO; ++d) o[d][r] *= a; }
            }
            bf16x8 pa0, pa1, pa2, pa3;
            AT_PK4(p0, 0, pa0); AT_PK4(p0, 8, pa1); AT_PK4(p1, 0, pa2); AT_PK4(p1, 8, pa3);
            pv_one<DV, VROW, 0>(o[0], vb, pa0, pa1, pa2, pa3);
            pv_one<DV, VROW, 1>(o[1], vb, pa0, pa1, pa2, pa3);
            if constexpr (NO > 2) { pv_one<DV, VROW, 2>(o[2], vb, pa0, pa1, pa2, pa3); pv_one<DV, VROW, 3>(o[3], vb, pa0, pa1, pa2, pa3); }
        }
    }
#undef AT_LOAD
    if (hi == 0) al[32 + r32] = l_reg;
    asm volatile("s_waitcnt lgkmcnt(0)" ::: "memory");
#pragma unroll
    for (int r = 0; r < 16; ++r) {
        const int orow_ = crow(r, hi);
        const float li = 1.0f / al[32 + orow_];
        bf16_t* op = cfg.orow(wave, orow_);
#pragma unroll
        for (int d = 0; d < NO; ++d) { if (WO_FP8) ((unsigned char*)cfg.O + (op - cfg.O))[d * 32 + r32] = fp8_1(o[d][r] * li * 64.f);
            else op[d * 32 + r32] = (bf16_t)(cvt_pk(o[d][r] * li, 0.f) & 0xffffu); }
    }
    __syncthreads();
}
constexpr int attn_lds_bytes(int dqk, int dv) { return 64 * (dqk * 2 + 16) + 64 * (dv * 2 + 16) + 8 * 64 * 4; }
}
namespace at {
struct MlaGeo { static constexpr int KROW = 384, VROW = 256, KB = 64 * KROW, VB = 64 * VROW; };
template <int D0> DI void mla_pv_issue(unsigned vb, s16x4 (&t)[8]) {
    t[0] = tr_read<(0 * 16) * MlaGeo::VROW>(vb); t[1] = tr_read<(0 * 16 + 4) * MlaGeo::VROW>(vb);
    t[2] = tr_read<(1 * 16) * MlaGeo::VROW>(vb); t[3] = tr_read<(1 * 16 + 4) * MlaGeo::VROW>(vb);
    t[4] = tr_read<(2 * 16) * MlaGeo::VROW>(vb); t[5] = tr_read<(2 * 16 + 4) * MlaGeo::VROW>(vb);
    t[6] = tr_read<(3 * 16) * MlaGeo::VROW>(vb); t[7] = tr_read<(3 * 16 + 4) * MlaGeo::VROW>(vb);
}
DI void mla_pv_mma(f32x16& od, const s16x4 (&t)[8], bf16x8 pa0, bf16x8 pa1, bf16x8 pa2, bf16x8 pa3) {
#define AT_PK(Lo, Hi) (bf16x8){Lo[0], Lo[1], Lo[2], Lo[3], Hi[0], Hi[1], Hi[2], Hi[3]}
    od = __builtin_amdgcn_mfma_f32_32x32x16_bf16(pa0, AT_PK(t[0], t[1]), od, 0, 0, 0);
    od = __builtin_amdgcn_mfma_f32_32x32x16_bf16(pa1, AT_PK(t[2], t[3]), od, 0, 0, 0);
    od = __builtin_amdgcn_mfma_f32_32x32x16_bf16(pa2, AT_PK(t[4], t[5]), od, 0, 0, 0);
    od = __builtin_amdgcn_mfma_f32_32x32x16_bf16(pa3, AT_PK(t[6], t[7]), od, 0, 0, 0);
#undef AT_PK
}
template <int PRB>
DI void mla_attn_unit(const bf16_t* __restrict__ qp0, const bf16_t* __restrict__ kp0, const bf16_t* __restrict__ vp0, bf16_t* __restrict__ op0, const int NT, char* lds) {
    constexpr int KROW = MlaGeo::KROW, VROW = MlaGeo::VROW, KB = MlaGeo::KB, VB = MlaGeo::VB, LDK = 1536, LDV = 1024, LDQ = 1536, LDO = 1024;
    const int tid = threadIdx.x, lane = tid & 63, r32 = lane & 31, hi = lane >> 5;
    const int wave = __builtin_amdgcn_readfirstlane(tid >> 6);
    const bool grpB = wave >= 4;
    char* const Kb = lds; char* const Vb = lds + 3 * KB;
    float* al = (float*)(lds + 3 * KB + 3 * VB) + wave * 64;
    const float C = 0.07216878364870322f * 1.4426950408889634f;
    bf16x8 qr[12];
    { const bf16_t* qp = qp0 + (size_t)(32 * wave + r32) * LDQ + hi * 8;
#pragma unroll
      for (int d0 = 0; d0 < 12; ++d0) qr[d0] = *reinterpret_cast<const bf16x8*>(qp + d0 * 16); }
    f32x16 o[4];
#pragma unroll
    for (int d = 0; d < 4; ++d)
#pragma unroll
        for (int r = 0; r < 16; ++r) o[d][r] = 0.f;
    float m_reg = -1e28f, l_reg = 0.f;
    unsigned kg0, kg1, kg2, vg0, vg1;
    { const int pa_ = wave * 64 + lane, pb_ = pa_ + 512, pc_ = pa_ + 1024;
      const int ra = pa_ / 24, sa = pa_ % 24, rb = pb_ / 24, sb = pb_ % 24, rc = pc_ / 24, sc_ = pc_ % 24;
      kg0 = (unsigned)(ra * LDK * 2 + ((sa & ~7) | ((sa & 7) ^ ((ra >> 1) & 7))) * 16);
      kg1 = (unsigned)(rb * LDK * 2 + ((sb & ~7) | ((sb & 7) ^ ((rb >> 1) & 7))) * 16);
      kg2 = (unsigned)(rc * LDK * 2 + ((sc_ & ~7) | ((sc_ & 7) ^ ((rc >> 1) & 7))) * 16);
      const int va = pa_ / 16, wa = pa_ % 16, vb2 = pb_ / 16, wb = pb_ % 16;
      vg0 = (unsigned)(va * LDV * 2 + (wa ^ ((va & 3) << 2)) * 16);
      vg1 = (unsigned)(vb2 * LDV * 2 + (wb ^ ((vb2 & 3) << 2)) * 16); }
    const int wdst = wave * 1024;
    int kx[4];
#pragma unroll
    for (int d = 0; d < 4; ++d) kx[d] = r32 * KROW + (((2 * d + hi) ^ ((r32 >> 1) & 7)) * 16);
    unsigned vx[4];
    { const int q = (lane & 15) >> 2;
#pragma unroll
      for (int d = 0; d < 4; ++d) vx[d] = (unsigned)((8 * hi + q) * VROW + 64 * (d ^ q) + 32 * ((lane >> 4) & 1) + 8 * (lane & 3)); }
#define MLA_STAGE(t) do { const int t_ = (t); if (PRB == 2) break; \
    if (t_ < NT) { const char* kb_ = (const char*)kp0 + (size_t)t_ * (64 * LDK * 2); char* kd_ = Kb + (t_ % 3) * KB + wdst; \
        __builtin_amdgcn_global_load_lds((const unsigned*)(kb_ + kg0), (unsigned*)(kd_), 16, 0, 0); \
        __builtin_amdgcn_global_load_lds((const unsigned*)(kb_ + kg1), (unsigned*)(kd_ + 8192), 16, 0, 0); \
        __builtin_amdgcn_global_load_lds((const unsigned*)(kb_ + kg2), (unsigned*)(kd_ + 16384), 16, 0, 0); } \
    if (t_ >= 1) { const char* vb_ = (const char*)vp0 + (size_t)(t_ - 1) * (64 * LDV * 2); char* vd_ = Vb + ((t_ - 1) % 3) * VB + wdst; \
        __builtin_amdgcn_global_load_lds((const unsigned*)(vb_ + vg0), (unsigned*)(vd_), 16, 0, 0); \
        __builtin_amdgcn_global_load_lds((const unsigned*)(vb_ + vg1), (unsigned*)(vd_ + 8192), 16, 0, 0); } } while (0)
#define MLA_BAR(nyoung) do { const int ny_ = (nyoung); if (ny_ >= 5) asm volatile("s_waitcnt vmcnt(5)" ::: "memory"); else if (ny_ >= 2) asm volatile("s_waitcnt vmcnt(2)" ::: "memory"); \
    else asm volatile("s_waitcnt vmcnt(0)" ::: "memory"); \
    asm volatile("s_waitcnt lgkmcnt(0)" ::: "memory"); __builtin_amdgcn_s_barrier(); asm volatile("" ::: "memory"); } while (0)
#define MLA_NY(j_) ((j_) + 2 < NT ? 5 : ((j_) + 2 == NT ? 2 : 0))
#define MLA_PVALL(VBUF) do { const unsigned v0_ = (unsigned)(uintptr_t)(VBUF); s16x4 ta[8], tb[8]; \
    mla_pv_issue<0>(v0_ + vx[0], ta); mla_pv_issue<1>(v0_ + vx[1], tb); \
    asm volatile("s_waitcnt lgkmcnt(8)" ::: "memory"); __builtin_amdgcn_sched_barrier(0); \
    mla_pv_mma(o[0], ta, pa0, pa1, pa2, pa3); __builtin_amdgcn_sched_barrier(0); \
    mla_pv_issue<2>(v0_ + vx[2], ta); \
    asm volatile("s_waitcnt lgkmcnt(8)" ::: "memory"); __builtin_amdgcn_sched_barrier(0); \
    mla_pv_mma(o[1], tb, pa0, pa1, pa2, pa3); __builtin_amdgcn_sched_barrier(0); \
    mla_pv_issue<3>(v0_ + vx[3], tb); \
    asm volatile("s_waitcnt lgkmcnt(8)" ::: "memory"); __builtin_amdgcn_sched_barrier(0); \
    mla_pv_mma(o[2], ta, pa0, pa1, pa2, pa3); \
    asm volatile("s_waitcnt lgkmcnt(0)" ::: "memory"); __builtin_amdgcn_sched_barrier(0); \
    mla_pv_mma(o[3], tb, pa0, pa1, pa2, pa3); } while (0)
    f32x16 p0, p1; bf16x8 pa0, pa1, pa2, pa3;
    MLA_STAGE(0); MLA_STAGE(1);
    MLA_BAR(0);
    if (grpB) { MLA_STAGE(2); MLA_BAR(NT > 2 ? 5 : 2); }
    for (int j = 0; j < NT; ++j) {
        {
            const char* Ks = Kb + (j % 3) * KB;
            const unsigned v0_ = (unsigned)(uintptr_t)(Vb + ((j + 2) % 3) * VB);
            s16x4 ta[8], tb[8];
#pragma unroll
            for (int r = 0; r < 16; ++r) { p0[r] = 0.f; p1[r] = 0.f; }
            bf16x8 f0[12], f1[12];
#pragma unroll
            for (int d = 0; d < 3; ++d) { f0[d] = *reinterpret_cast<const bf16x8*>(Ks + kx[d & 3] + 128 * (d >> 2)); f1[d] = *reinterpret_cast<const bf16x8*>(Ks + kx[d & 3] + 128 * (d >> 2) + 32 * KROW); }
            __builtin_amdgcn_sched_barrier(0);
            if (!grpB && j + 2 <= NT) MLA_STAGE(j + 2);
            __builtin_amdgcn_sched_barrier(0);
#pragma unroll
            for (int d0 = 0; d0 < 12; ++d0) {
                if (d0 + 3 < 12) { f0[d0 + 3] = *reinterpret_cast<const bf16x8*>(Ks + kx[(d0 + 3) & 3] + 128 * ((d0 + 3) >> 2)); f1[d0 + 3] = *reinterpret_cast<const bf16x8*>(Ks + kx[(d0 + 3) & 3] + 128 * ((d0 + 3) >> 2) + 32 * KROW); }
                if (d0 == 9 && j > 0 && PRB != 4) { mla_pv_issue<0>(v0_ + vx[0], ta); mla_pv_issue<1>(v0_ + vx[1], tb); }
                if (PRB != 3 || d0 == 0) { p0 = __builtin_amdgcn_mfma_f32_32x32x16_bf16(f0[d0], qr[d0], p0, 0, 0, 0);
                p1 = __builtin_amdgcn_mfma_f32_32x32x16_bf16(f1[d0], qr[d0], p1, 0, 0, 0); }
                __builtin_amdgcn_sched_barrier(0);
            }
            if (j > 0 && PRB != 4) {
                asm volatile("s_waitcnt lgkmcnt(8)" ::: "memory"); __builtin_amdgcn_sched_barrier(0);
                mla_pv_mma(o[0], ta, pa0, pa1, pa2, pa3); __builtin_amdgcn_sched_barrier(0);
                mla_pv_issue<2>(v0_ + vx[2], ta);
                asm volatile("s_waitcnt lgkmcnt(8)" ::: "memory"); __builtin_amdgcn_sched_barrier(0);
                mla_pv_mma(o[1], tb, pa0, pa1, pa2, pa3); __builtin_amdgcn_sched_barrier(0);
                mla_pv_issue<3>(v0_ + vx[3], tb);
                asm volatile("s_waitcnt lgkmcnt(8)" ::: "memory"); __builtin_amdgcn_sched_barrier(0);
                mla_pv_mma(o[2], ta, pa0, pa1, pa2, pa3);
                asm volatile("s_waitcnt lgkmcnt(0)" ::: "memory"); __builtin_amdgcn_sched_barrier(0);
                mla_pv_mma(o[3], tb, pa0, pa1, pa2, pa3);
            }
        }
        MLA_BAR(MLA_NY(j));
        if (grpB && j + 3 <= NT) MLA_STAGE(j + 3);
        {
            float pmax = p0[0];
#pragma unroll
            for (int r = 1; r < 16; ++r) pmax = fmaxf(pmax, p0[r]);
#pragma unroll
            for (int r = 0; r < 16; ++r) pmax = fmaxf(pmax, p1[r]);
            { auto rr = __builtin_amdgcn_permlane32_swap(__float_as_uint(pmax), __float_as_uint(pmax), false, false);
              pmax = fmaxf(__uint_as_float(rr[0]), __uint_as_float(rr[1])); }
            const float mn = fmaxf(m_reg, pmax);
            const float alpha = __builtin_amdgcn_exp2f((m_reg - mn) * C);
            m_reg = mn;
            const float mnC = -mn * C;
            float ps = 0.f;
#pragma unroll
            for (int r = 0; r < 16; ++r) { p0[r] = PRB == 1 ? fmaf(p0[r], C, mnC) : __builtin_amdgcn_exp2f(fmaf(p0[r], C, mnC)); ps += p0[r]; }
#pragma unroll
            for (int r = 0; r < 16; ++r) { p1[r] = PRB == 1 ? fmaf(p1[r], C, mnC) : __builtin_amdgcn_exp2f(fmaf(p1[r], C, mnC)); ps += p1[r]; }
            { auto rr = __builtin_amdgcn_permlane32_swap(__float_as_uint(ps), __float_as_uint(ps), false, false);
              ps = __uint_as_float(rr[0]) + __uint_as_float(rr[1]); }
            l_reg = l_reg * alpha + ps;
            if (__any(alpha < 1.f)) {
                if (hi == 0) al[r32] = alpha;
                asm volatile("s_waitcnt lgkmcnt(0)" ::: "memory");
#pragma unroll
                for (int r = 0; r < 16; ++r) { const float a_ = al[crow(r, hi)];
#pragma unroll
                    for (int d = 0; d < 4; ++d) o[d][r] *= a_; }
            }
            AT_PK4(p0, 0, pa0); AT_PK4(p0, 8, pa1); AT_PK4(p1, 0, pa2); AT_PK4(p1, 8, pa3);
        }
        MLA_BAR(MLA_NY(j));
    }
    MLA_PVALL(Vb + ((NT - 1) % 3) * VB);
    if (!grpB) MLA_BAR(0);
    if (hi == 0) al[32 + r32] = l_reg;
    asm volatile("s_waitcnt lgkmcnt(0)" ::: "memory");
#pragma unroll
    for (int r = 0; r < 16; ++r) {
        const int orow_ = crow(r, hi);
        const float li = 1.0f / al[32 + orow_];
        bf16_t* op = op0 + (size_t)(32 * wave + orow_) * LDO;
#pragma unroll
        for (int d = 0; d < 4; ++d) op[d * 32 + r32] = (bf16_t)(cvt_pk(o[d][r] * li, 0.f) & 0xffffu);
    }
    __syncthreads();
#undef MLA_STAGE
#undef MLA_BAR
#undef MLA_NY
#undef MLA_PVALL
}
}
namespace at {
typedef int v8i __attribute__((ext_vector_type(8)));
DI f32x16 mfma8(v8i a, v8i b, f32x16 c, int sa, int sb) { return __builtin_amdgcn_mfma_scale_f32_32x32x64_f8f6f4(a, b, c, 0, 0, 0, sa, 0, sb); }
DI v8i ld_frag(const char* p0, const char* p1) { const u32x4 a = *(const u32x4*)p0, b = *(const u32x4*)p1; return (v8i){(int)a.x, (int)a.y, (int)a.z, (int)a.w, (int)b.x, (int)b.y, (int)b.z, (int)b.w}; }
template <int PRB>
DI void mla_attn_unit_fp8(const unsigned char* __restrict__ qp0, const unsigned char* __restrict__ kp0, const unsigned char* __restrict__ vp0, bf16_t* __restrict__ op0, const int NT, char* lds) {
    constexpr int KB8 = 64 * 256, VB8 = 128 * 64, LDK = 1536, LDO = 1024;
    int tid = threadIdx.x; asm volatile("" : "+v"(tid));
    const int lane = tid & 63, r32 = lane & 31, hi = lane >> 5;
    const int wave = __builtin_amdgcn_readfirstlane(tid >> 6);
    const bool grpB = wave >= 4;
    char* const Kb = lds; char* const Vb = lds + 3 * KB8;
    float* al = (float*)(lds + 3 * KB8 + 3 * VB8) + wave * 64;
    const float C = 0.07216878364870322f * 1.4426950408889634f;
    v8i qf[3];
    { const unsigned char* qp = qp0 + (size_t)(32 * wave + r32) * LDK + 32 * hi;
#pragma unroll
      for (int c = 0; c < 3; ++c) qf[c] = ld_frag((const char*)qp + 64 * c, (const char*)qp + 64 * c + 16); }
    f32x16 o[4];
#pragma unroll
    for (int d = 0; d < 4; ++d)
#pragma unroll
        for (int r = 0; r < 16; ++r) o[d][r] = 0.f;
    float m_reg = -1e28f, l_reg = 0.f;
    int s1 = 0x7f7f7f7f; asm volatile("" : "+v"(s1)); const int sp = s1 & 0x7b7b7b7b;
    unsigned kg0, kg1, vg0;
    { const int pa_ = wave * 64 + lane, pb_ = pa_ + 512;
      const int ra = pa_ >> 4, qa = (pa_ & 15) ^ (2 * (ra & 7) + ((ra >> 3) & 1)), rb = pb_ >> 4, qb = (pb_ & 15) ^ (2 * (rb & 7) + ((rb >> 3) & 1));
      kg0 = (unsigned)(ra * LDK + (qa < 12 ? qa * 16 : 0)); kg1 = (unsigned)(rb * LDK + (qb < 12 ? qb * 16 : 0));
      const int vr = pa_ >> 2, vq = (pa_ & 3) ^ (2 * ((vr >> 2) & 1) + ((vr >> 3) & 1));
      vg0 = (unsigned)((size_t)vr * T + vq * 16); }
    const int wdst = wave * 1024;
    const int hs = (r32 >> 3) & 1, hdl = 16 - 32 * hs;
    int kxa[3];
#pragma unroll
    for (int c = 0; c < 3; ++c) kxa[c] = r32 * 256 + (((2 * c + hi) ^ (r32 & 7)) * 32) + 16 * hs;
    const int vxa = r32 * 64 + ((hi ^ ((r32 >> 2) & 1)) * 32) + 16 * hs;
#define M8_STAGE(t) do { const int t_ = (t); \
    if (t_ < NT) { const char* kb_ = (const char*)kp0 + (size_t)t_ * (64 * LDK); char* kd_ = Kb + (t_ % 3) * KB8 + wdst; \
        __builtin_amdgcn_global_load_lds((const unsigned*)(kb_ + kg0), (unsigned*)(kd_), 16, 0, 0); \
        __builtin_amdgcn_global_load_lds((const unsigned*)(kb_ + kg1), (unsigned*)(kd_ + 8192), 16, 0, 0); } \
    if (t_ >= 1) { const char* vb_ = (const char*)vp0 + (size_t)(t_ - 1) * 64; \
        __builtin_amdgcn_global_load_lds((const unsigned*)(vb_ + vg0), (unsigned*)(Vb + ((t_ - 1) % 3) * VB8 + wdst), 16, 0, 0); } } while (0)
#define M8_BAR(ny) do { const int ny_ = (ny); if (ny_ >= 3) asm volatile("s_waitcnt vmcnt(3)" ::: "memory"); else if (ny_ >= 1) asm volatile("s_waitcnt vmcnt(1)" ::: "memory"); \
    else asm volatile("s_waitcnt vmcnt(0)" ::: "memory"); \
    asm volatile("s_waitcnt lgkmcnt(0)" ::: "memory"); __builtin_amdgcn_s_barrier(); asm volatile("" ::: "memory"); } while (0)
#define M8_NY(j_) ((j_) + 2 < NT ? 3 : ((j_) + 2 == NT ? 1 : 0))
    f32x16 p0, p1; v8i pf;
#define M8_MMA(acc, a, b, sa, sb) do { if constexpr ((PRB & 2) != 0) asm volatile("" :: "v"(a), "v"(b)); else acc = mfma8(a, b, acc, sa, sb); } while (0)
#define M8_SB() __builtin_amdgcn_sched_barrier(0)
#define M8_KF(c, kb) ((PRB & 4) ? qf[c] : ld_frag(Ks + kxa[c] + (kb) * 32 * 256, Ks + kxa[c] + hdl + (kb) * 32 * 256))
#define M8_VF(d) ((PRB & 4) ? qf[(d) % 3] : ld_frag(Vs + vxa + (d) * 2048, Vs + vxa + hdl + (d) * 2048))
#define M8_X(jj, QK, PV) do { const int j_ = (jj); const char* Ks = Kb + (j_ % 3) * KB8; const char* Vs = Vb + ((j_ + 2) % 3) * VB8; \
        v8i fa, fb, fc, fd; \
        if (QK) { fa = M8_KF(0, 0); fb = M8_KF(0, 1); fc = M8_KF(1, 0); fd = M8_KF(1, 1); } \
        M8_SB(); if (!grpB && j_ + 2 <= NT) M8_STAGE(j_ + 2); M8_SB(); \
        if (QK) { \
            _Pragma("unroll") for (int r = 0; r < 16; ++r) { p0[r] = 0.f; p1[r] = 0.f; } \
            M8_MMA(p0, fa, qf[0], s1, s1); M8_MMA(p1, fb, qf[0], s1, s1); M8_SB(); \
            fa = M8_KF(2, 0); fb = M8_KF(2, 1); M8_SB(); \
            M8_MMA(p0, fc, qf[1], s1, s1); M8_MMA(p1, fd, qf[1], s1, s1); M8_SB(); \
            if (PV) { fc = M8_VF(0); fd = M8_VF(1); } M8_SB(); \
            M8_MMA(p0, fa, qf[2], s1, s1); M8_MMA(p1, fb, qf[2], s1, s1); M8_SB(); \
        } else { fc = M8_VF(0); fd = M8_VF(1); } \
        if (PV) { fa = M8_VF(2); fb = M8_VF(3); M8_SB(); \
            M8_MMA(o[0], pf, fc, sp, s1); M8_MMA(o[1], pf, fd, sp, s1); M8_SB();     \
            M8_MMA(o[2], pf, fa, sp, s1); M8_MMA(o[3], pf, fb, sp, s1); } } while (0)
    bool pend = false;
#define M8_Y(jj) do { const int j_ = (jj); if (grpB && j_ + 3 <= NT) M8_STAGE(j_ + 3); \
        if constexpr ((PRB & 8) == 0) { \
            float pmax = p0[0]; \
            _Pragma("unroll") for (int r = 1; r < 16; ++r) pmax = fmaxf(pmax, p0[r]); \
            _Pragma("unroll") for (int r = 0; r < 16; ++r) pmax = fmaxf(pmax, p1[r]); \
            { auto rr = __builtin_amdgcn_permlane32_swap(__float_as_uint(pmax), __float_as_uint(pmax), false, false); \
              pmax = fmaxf(__uint_as_float(rr[0]), __uint_as_float(rr[1])); } \
            if (__any(pmax - m_reg > 3.0f / 0.07216878364870322f)) { \
                const float mn = fmaxf(m_reg, pmax); \
                const float alpha = __builtin_amdgcn_exp2f((m_reg - mn) * C); \
                m_reg = mn; l_reg *= alpha; \
                if (hi == 0) al[r32] = alpha; \
                pend = true; \
            } \
            const float mnC = 4.0f - m_reg * C;                     \
            float ps = 0.f; \
            _Pragma("unroll") for (int r = 0; r < 16; ++r) { p0[r] = (PRB & 1) ? fmaf(p0[r], C, mnC) : __builtin_amdgcn_exp2f((PRB & 32) ? p0[r] : fmaf(p0[r], C, mnC)); if (!(PRB & 16)) ps += p0[r]; } \
            _Pragma("unroll") for (int r = 0; r < 16; ++r) { p1[r] = (PRB & 1) ? fmaf(p1[r], C, mnC) : __builtin_amdgcn_exp2f((PRB & 32) ? p1[r] : fmaf(p1[r], C, mnC)); if (!(PRB & 16)) ps += p1[r]; } \
            { auto rr = __builtin_amdgcn_permlane32_swap(__float_as_uint(ps), __float_as_uint(ps), false, false); \
              ps = __uint_as_float(rr[0]) + __uint_as_float(rr[1]); } \
            l_reg += ps * (1.0f / 16.0f); \
              \
            _Pragma("unroll") for (int a = 0; a < 4; ++a) { \
                const unsigned w0 = pk4_fp8o(p0[4 * a], p0[4 * a + 1], p0[4 * a + 2], p0[4 * a + 3]), w1 = pk4_fp8o(p1[4 * a], p1[4 * a + 1], p1[4 * a + 2], p1[4 * a + 3]); \
                auto rr = __builtin_amdgcn_permlane32_swap(w0, w1, false, false); \
                pf[2 * a] = (int)rr[0]; pf[2 * a + 1] = (int)rr[1]; \
            } \
        } } while (0)
    M8_STAGE(0); M8_STAGE(1);
    M8_BAR(0);
    if (grpB) { M8_STAGE(2); M8_BAR(NT > 2 ? 3 : 1); }
    M8_X(0, true, false); M8_BAR(M8_NY(0)); M8_Y(0); M8_BAR(M8_NY(0));
    int j = 1;
    for (;;) {
        if (pend) {
            pend = false;
#pragma unroll
            for (int r = 0; r < 16; ++r) { const float a_ = al[crow(r, hi)];
#pragma unroll
                for (int d = 0; d < 4; ++d) o[d][r] *= a_; }
        }
#pragma unroll 1
        for (; j < NT; ++j) {
            M8_X(j, true, true); M8_BAR(M8_NY(j)); M8_Y(j); M8_BAR(M8_NY(j));
            if (pend) { ++j; break; }
        }
        if (!pend) break;
    }
    M8_X(NT, false, true);
#undef M8_KF
#undef M8_VF
#undef M8_X
#undef M8_Y
#undef M8_SB
    if (!grpB) M8_BAR(0);
    if (hi == 0) al[32 + r32] = l_reg;
    asm volatile("s_waitcnt lgkmcnt(0)" ::: "memory");
#pragma unroll
    for (int r = 0; r < 16; ++r) {
        const int orow_ = crow(r, hi);
        const float li = 1.0f / al[32 + orow_];
        bf16_t* op = op0 + (size_t)(32 * wave + orow_) * LDO;
#pragma unroll
        for (int d = 0; d < 4; ++d) { if (WO_FP8) ((unsigned char*)op0)[(size_t)(32 * wave + orow_) * LDO + d * 32 + r32] = fp8_1(o[d][r] * li * 64.f); else op[d * 32 + r32] = (bf16_t)(cvt_pk(o[d][r] * li, 0.f) & 0xffffu); }
    }
    __syncthreads();
#undef M8_STAGE
#undef M8_BAR
#undef M8_NY
#undef M8_MMA
}
}
struct Params { const float* in[31]; float* out; unsigned char* ws; int ph_lo, ph_hi; };
enum { I_X = 0, I_C, I_CTX, I_CCTX, I_MODW, I_MODB, I_N1G, I_N2G, I_DQ, I_GQ, I_UQ, I_DKV, I_GKV, I_UKV, I_MWO, I_FWO, I_FBO, I_NQKV, I_RPB, I_NWO,
       I_SQKV, I_SINK, I_SWO, I_WGRP, I_BGRP, I_WRT, I_BRT, I_WGATE, I_WUP, I_WDOWN, I_FG };
struct Frame {
    const float* const __attribute__((address_space(4)))* in;
    float* out; unsigned char* ws; char* lds;
    int tid, lane, wave, G, vcu;
    DI bf16_t* wt(size_t el) const { return (bf16_t*)(ws + WS_WT) + el; }
    DI bf16_t* scr(size_t byte) const { return (bf16_t*)(ws + WS_SCR + byte); }
    DI float* moda(int layer, int v, int which) const { return (float*)(ws + WS_MODA) + ((size_t)(layer * 3 + v) * 2 + which) * 1024; }
    DI float* modv(int layer, int v, int part) const { return (float*)(ws + WS_MODV) + ((size_t)(layer * 3 + v) * 6 + part) * 1024; }
};
DI int row_batch(int row) { return row >= TB ? 1 : 0; }
DI int row_modv(int row) { const int b = row_batch(row), rr = row - b * TB; return rr < NCTX ? 0 : 1 + b; }
DI int tile_modv(int pm) { const int b = pm / 65; return (pm % 65 == 0) ? 0 : 1 + b; }
DI int swap45(int c) { return ((c & 16) << 1) | ((c & 32) >> 1) | (c & 15); }

DI int dst_row(int kind, int n) {
    if (kind == 1) return n < 256 ? n : 256 + swap45(n - 256);
    if (kind == 2) { const int h = n / 192, c = n - h * 192; return c < 128 ? n : h * 192 + 128 + swap45(c - 128); }
    if (kind == 3) return n < 1280 ? (n & ~63) + swap45(n & 63) : n;
    return n;
}
DI void cvt_tile(const Frame& F, const float* __restrict__ src, int N, bf16_t* __restrict__ dst, int ldd, int k0, int n0, int kind, const float* __restrict__ kscale, bool f8) {
    float* tl = (float*)F.lds;
    const int tid = F.tid;
    { const int kr = tid >> 3, c8 = (tid & 7) * 8;
      const float sc = kscale ? kscale[k0 + kr] : 1.0f;
      const f32x4 a = *(const f32x4*)(src + (size_t)(k0 + kr) * N + n0 + c8), b = *(const f32x4*)(src + (size_t)(k0 + kr) * N + n0 + c8 + 4);
#pragma unroll
      for (int j = 0; j < 4; ++j) { tl[kr * 65 + c8 + j] = a[j] * sc; tl[kr * 65 + c8 + 4 + j] = b[j] * sc; } }
    __syncthreads();
    { const int nr = tid >> 3, k8 = (tid & 7) * 8;
      float v[8];
#pragma unroll
      for (int j = 0; j < 8; ++j) v[j] = tl[(k8 + j) * 65 + nr];
      if (f8) { u32x2 w; w.x = pk4_fp8(v[0] * 64.f, v[1] * 64.f, v[2] * 64.f, v[3] * 64.f); w.y = pk4_fp8(v[4] * 64.f, v[5] * 64.f, v[6] * 64.f, v[7] * 64.f);
          *(u32x2*)((unsigned char*)dst + (size_t)dst_row(kind, n0 + nr) * ldd + k0 + k8) = w; }
      else { u32x4 w; w.x = cvt_pk(v[0], v[1]); w.y = cvt_pk(v[2], v[3]); w.z = cvt_pk(v[4], v[5]); w.w = cvt_pk(v[6], v[7]);
          *(u32x4*)(dst + (size_t)dst_row(kind, n0 + nr) * ldd + k0 + k8) = w; } }
    __syncthreads();
}
DI void cvt_tile4(const Frame& F, const float* __restrict__ src, int N, unsigned char* __restrict__ dst, int ldd, int k0, int n0) {
    float* tl = (float*)F.lds;
    int tid = threadIdx.x; asm volatile("" : "+v"(tid));
    { const int kr = tid >> 3, c8 = (tid & 7) * 8;
      f32x4 a[4], b[4];
#pragma unroll
      for (int q = 0; q < 4; ++q) { a[q] = __builtin_nontemporal_load((const f32x4*)(src + (size_t)(k0 + kr) * N + n0 + 64 * q + c8)); b[q] = __builtin_nontemporal_load((const f32x4*)(src + (size_t)(k0 + kr) * N + n0 + 64 * q + c8 + 4)); }
#pragma unroll
      for (int q = 0; q < 4; ++q)
#pragma unroll
          for (int j = 0; j < 4; ++j) { tl[q * 4160 + kr * 65 + c8 + j] = a[q][j]; tl[q * 4160 + kr * 65 + c8 + 4 + j] = b[q][j]; } }
    __syncthreads();
    { const int nr = tid >> 3, k8 = (tid & 7) * 8;
#pragma unroll
      for (int q = 0; q < 4; ++q) {
          float v[8];
#pragma unroll
          for (int j = 0; j < 8; ++j) v[j] = tl[q * 4160 + (k8 + j) * 65 + nr] * 64.0f;
          u32x2 w; w.x = pk4_fp8(v[0], v[1], v[2], v[3]); w.y = pk4_fp8(v[4], v[5], v[6], v[7]);
          *(u32x2*)(dst + (size_t)(n0 + 64 * q + nr) * ldd + k0 + k8) = w; } }
    __syncthreads();
}
DI void cvt_moe_range(const Frame& F, int layer, int b0, int b1, int rank, int nr) {
    unsigned char* mw = F.ws + WS_MOEW;
    const float* wg = F.in[I_WGATE] + (size_t)layer * 32 * 1024 * 512;
    const float* wu = F.in[I_WUP] + (size_t)layer * 32 * 1024 * 512;
    const float* wd = F.in[I_WDOWN] + (size_t)layer * 32 * 512 * 1024;
    for (int u = b0 + rank; u < b1; u += nr) {
        const int mat = u / 32, tl = u % 32, which = mat / 32, e = mat % 32;
        if (which < 2) { const int kt = tl / 2, nq = tl % 2;
            cvt_tile4(F, (which ? wu : wg) + (size_t)e * 1024 * 512, 512, mw + (which ? MOEW_U : MOEW_G) + (size_t)e * 512 * 1024, 1024, kt * 64, nq * 256);
        } else { const int kt = tl / 4, nq = tl % 4;
            cvt_tile4(F, wd + (size_t)e * 512 * 1024, 1024, mw + MOEW_D + (size_t)e * 1024 * 512, 512, kt * 64, nq * 256);
        }
    }
}
DI void tail_cvt(const Frame& F, int NU, int layer, int b0, int b1) {
    const int rem = NU % F.G;
    if (rem == 0) { cvt_moe_range(F, layer, b0, b1, F.vcu, F.G); return; }
    if (F.vcu < rem) return;
    cvt_moe_range(F, layer, b0, b1, F.vcu - rem, F.G - rem);
}
struct CvtJob { const float* src; const float* ks; bf16_t* dst; int K, N, ldd, kind; bool f8; };
DI CvtJob cvt_job(const Frame& F, int j) {
    CvtJob J; J.ks = nullptr; J.kind = 0; J.f8 = false;
    switch (j) {
        case 0: J.src = F.in[I_DQ]; J.K = 1024; J.N = 512; J.dst = F.wt(WT_P1); J.ldd = 1024; J.f8 = GEMM_FP8; break;
        case 1: J.src = F.in[I_DKV]; J.K = 1024; J.N = 320; J.dst = GEMM_FP8 ? (bf16_t*)((unsigned char*)F.wt(WT_P1) + (size_t)512 * 1024) : F.wt(WT_P1 + (size_t)512 * 1024); J.ldd = 1024; J.kind = 1; J.f8 = GEMM_FP8; break;
        case 2: J.src = F.in[I_UQ]; J.K = 512; J.N = 1536; J.dst = F.wt(WT_UQ); J.ldd = 512; J.kind = 2; J.ks = F.in[I_GQ]; break;
        case 3: J.src = F.in[I_UKV]; J.K = 256; J.N = 2048; J.dst = F.wt(WT_UKV); J.ldd = 256; J.ks = F.in[I_GKV]; break;
        case 4: J.src = F.in[I_MWO]; J.K = 1024; J.N = 1024; J.dst = F.wt(WT_WO0); J.ldd = 1024; J.f8 = WO_FP8; break;
        case 5: J.src = F.in[I_FWO]; J.K = 1024; J.N = 1024; J.dst = F.wt(WT_WO1); J.ldd = 1024; break;
        case 6: J.src = F.in[I_NQKV]; J.K = 1024; J.N = 3072; J.dst = F.wt(WT_NAQKV); J.ldd = 1024; J.f8 = GEMM_FP8; break;
        case 7: J.src = F.in[I_NWO]; J.K = 1024; J.N = 1024; J.dst = F.wt(WT_WO2); J.ldd = 1024; J.f8 = WO_FP8; break;
        case 8: J.src = F.in[I_SQKV]; J.K = 1024; J.N = 1536; J.dst = F.wt(WT_SWQKV); J.ldd = 1024; J.kind = 3; J.f8 = GEMM_FP8; break;
        default: J.src = F.in[I_SWO]; J.K = 1024; J.N = 1024; J.dst = F.wt(WT_WO3); J.ldd = 1024; J.f8 = WO_FP8; break;
    }
    return J;
}

DI void ph_prologue(const Frame& F) {
    for (int u = F.vcu; u < 256; u += F.G) {
        const int layer = u >> 6, kc = (u >> 2) & 15, nq = u & 3;
        const float* mw = F.in[I_MODW] + ((size_t)layer * 1024 + kc * 64) * 6144 + nq * 1536 + F.tid;
        float acc[3][3];
#pragma unroll
        for (int j = 0; j < 3; ++j) { acc[j][0] = 0.f; acc[j][1] = 0.f; acc[j][2] = 0.f; }
#pragma unroll 8
        for (int k = 0; k < 64; ++k) {
            const int kk = kc * 64 + k;
            const float a0 = silu_f(F.in[I_CCTX][kk]), a1 = silu_f(F.in[I_C][kk]), a2 = silu_f(F.in[I_C][1024 + kk]);
#pragma unroll
            for (int j = 0; j < 3; ++j) { const float w = mw[(size_t)k * 6144 + j * 512]; acc[j][0] += a0 * w; acc[j][1] += a1 * w; acc[j][2] += a2 * w; }
        }
        float* mp = (float*)(F.ws + WS_MODP) + ((size_t)(kc * 4 + layer) * 3) * 6144 + nq * 1536 + F.tid;
#pragma unroll
        for (int j = 0; j < 3; ++j) { mp[j * 512] = acc[j][0]; mp[6144 + j * 512] = acc[j][1]; mp[2 * 6144 + j * 512] = acc[j][2]; }
    }
    {
        const int ntile[10] = {128, 80, 192, 128, 256, 256, 768, 256, 384, 256};
        int total = 0;
#pragma unroll
        for (int j = 0; j < 10; ++j) total += ntile[j];
        for (int u = F.vcu; u < total; u += F.G) {
            int j = 0, rem = u;
#pragma unroll
            for (int q = 0; q < 9; ++q) { if (j == q && rem >= ntile[q]) { rem -= ntile[q]; j = q + 1; } }
            const CvtJob J = cvt_job(F, j);
            const int nn = J.N / 64, kt = rem / nn, nt = rem % nn;
            cvt_tile(F, J.src, J.N, J.dst, J.ldd, kt * 64, nt * 64, J.kind, J.ks, J.f8);
        }
    }
    {
        const int gt = F.vcu * NTHR + F.tid, gs = F.G * NTHR;
        bf16_t* A = F.wt(WT_DFTA); bf16_t* D1 = F.wt(WT_DFT1); bf16_t* D2 = F.wt(WT_DFT2); bf16_t* DC = F.wt(WT_DFTC);
        for (int i = gt; i < 512 * 256; i += gs) {
            const int r = i >> 8, c = i & 255, kc = r & 255, ph = (c * kc) & 255; const float x = (float)ph * (1.0f / 128.0f);
            const float v = (r < 256 ? cospif(x) : -sinpif(x)) * 0.0625f;
            A[i] = (bf16_t)(cvt_pk(v, 0.f) & 0xffffu);
        }
        const float s128 = 0.08838834764831845f;
        for (int i = gt; i < 256 * 256; i += gs) {
            const int r = i >> 8, c = i & 255, kb = r & 127, n1 = c & 127, ph = (kb * n1) & 127; const float x = (float)ph * (1.0f / 64.0f);
            const float cs = cospif(x) * s128, sn = sinpif(x) * s128;
            const float v1 = (r < 128) ? (c < 128 ? cs : sn) : (c < 128 ? -sn : cs);
            D1[i] = (bf16_t)(cvt_pk(v1, 0.f) & 0xffffu);
            const float v2 = (r < 128) ? (c < 128 ? cs : sn) : 0.f;
            D2[i] = (bf16_t)(cvt_pk(v2, 0.f) & 0xffffu);
        }
        for (int i = gt; i < 256 * 512; i += gs) {
            const int r = i >> 9, c = i & 511, n = c & 255, ph = (r * n) & 255; const float x = (float)ph * (1.0f / 128.0f);
            const float v = (c < 256 ? cospif(x) : sinpif(x)) * 0.0625f;
            DC[i] = (bf16_t)(cvt_pk(v, 0.f) & 0xffffu);
        }
        float* rope = (float*)(F.ws + WS_ROPE);
        for (int i = gt; i < 256 * 16; i += gs) {
            const int v = i >> 4, m = i & 15;
            const float inv = powf(10000.0f, -(float)m / 16.0f);
            const float ang = (float)v * inv;
            rope[2 * i] = cosf(ang); rope[2 * i + 1] = sinf(ang);
        }
    }
    {
        for (int i = F.vcu * NTHR + F.tid; i < 4 * 36 * 1024; i += F.G * NTHR) {
            const int layer = i / (36 * 1024), r = i % (36 * 1024), n = r >> 10, k = r & 1023;
            const float w = n < 32 ? F.in[I_WRT][((size_t)layer * 1024 + k) * 32 + n] : F.in[I_WGRP][((size_t)layer * 1024 + k) * 4 + (n - 32)];
            const unsigned hi = cvt_pk(w, 0.f) & 0xffffu; const float lo = w - bflo(hi);
            unsigned char* img = F.ws + WS_RW + (size_t)layer * 2 * RW_HALF + (size_t)n * RW_PITCH + 2 * k;
            *(bf16_t*)img = (bf16_t)hi; *(bf16_t*)(img + RW_HALF) = (bf16_t)(cvt_pk(lo, 0.f) & 0xffffu);
        }
    }
}
DI void ph_modreduce(const Frame& F) {
    for (int i = F.vcu * NTHR + F.tid; i < 4 * 3 * 6144; i += F.G * NTHR) {
        const int layer = i / (3 * 6144), r = i % (3 * 6144), v = r / 6144, n = r % 6144;
        const float* mp = (const float*)(F.ws + WS_MODP) + (size_t)layer * 3 * 6144 + r;
        float s = F.in[I_MODB][layer * 6144 + n];
#pragma unroll
        for (int kc = 0; kc < 16; ++kc) s += mp[(size_t)kc * 4 * 3 * 6144];
        ((float*)(F.ws + WS_MODV))[i] = s;
        const int part = n >> 10, col = n & 1023;
        if (part == 1) F.moda(layer, v, 0)[col] = F.in[I_N1G][layer * D + col] * (1.0f + s);
        if (part == 4) F.moda(layer, v, 1)[col] = F.in[I_N2G][layer * D + col] * (1.0f + s);
    }
}

template <int LAYER>
DI void ph_norm1(const Frame& F, bool dry = false) {
    bf16_t* xres = (bf16_t*)(F.ws + WS_XRES);
    bf16_t* xdst = dry ? (bf16_t*)(F.ws + WS_END) : xres;
    bf16_t* hb = dry ? (bf16_t*)(F.ws + WS_END + (size_t)T * D * 4) : (bf16_t*)(F.ws + WS_H);
    const int* slot = (const int*)(F.ws + WS_SLOT);
    const float* gw = (const float*)(F.ws + WS_GW);
    const bf16_t* yb = F.scr(SM_Y);
    const int c0 = 4 * F.lane;
    const int step = F.G * 8;
    u32x2 nxa[4], nya[4], nyc[4]; float ng0 = 0.f, ng1 = 0.f;
    int ps0 = 0, ps1 = 0; float pg0 = 0.f, pg1 = 0.f;
    auto valid = [&](int r) { return r < T && !(LAYER == 4 && (r - row_batch(r) * TB) < NCTX); };
    auto fetch_sg = [&](int r) { if (LAYER != 0 && valid(r)) { ps0 = slot[2 * r]; ps1 = slot[2 * r + 1]; pg0 = gw[2 * r]; pg1 = gw[2 * r + 1]; } };
    auto issue = [&](int r) { if (LAYER != 0 && valid(r)) { const bf16_t* src = xres + (size_t)r * D; ng0 = pg0; ng1 = pg1;
#pragma unroll
            for (int i = 0; i < 4; ++i) { nxa[i] = *(const u32x2*)(src + c0 + 256 * i); nya[i] = __builtin_nontemporal_load((const u32x2*)(yb + (size_t)ps0 * D + c0 + 256 * i)); nyc[i] = __builtin_nontemporal_load((const u32x2*)(yb + (size_t)ps1 * D + c0 + 256 * i)); } } };
    f32x4 nx0[4];
    auto issue0 = [&](int r) { if (LAYER == 0 && r < T) { const int b_ = row_batch(r), rr_ = r - b_ * TB;
            const float* src = rr_ < NCTX ? F.in[I_CTX] + ((size_t)b_ * NCTX + rr_) * D : F.in[I_X] + ((size_t)b_ * SEQ + (rr_ - NCTX)) * D;
#pragma unroll
            for (int i = 0; i < 4; ++i) nx0[i] = *(const f32x4*)(src + c0 + 256 * i); } };
    { const int r0 = F.vcu * 8 + F.wave; fetch_sg(r0); issue(r0); fetch_sg(r0 + step); issue0(r0); }
    for (int row = F.vcu * 8 + F.wave; row < T; row += step) {
        const int b = row_batch(row), rr = row - b * TB, v = rr < NCTX ? 0 : 1 + b;
        u32x2 xa[4], ya[4], yc[4]; const float g0 = ng0, g1 = ng1;
        if (LAYER != 0) {
#pragma unroll
            for (int i = 0; i < 4; ++i) { xa[i] = nxa[i]; ya[i] = nya[i]; yc[i] = nyc[i]; }
            issue(row + step); fetch_sg(row + 2 * step);
        }
        if (LAYER == 4 && rr < NCTX) continue;
        f32x4 x[4];
        if (LAYER == 0) {
#pragma unroll
            for (int i = 0; i < 4; ++i) x[i] = nx0[i];
            issue0(row + step);
        } else {
            const float* g2 = F.modv(LAYER - 1, v, 5);
#pragma unroll
            for (int i = 0; i < 4; ++i) {
                const f32x4 gg = *(const f32x4*)(g2 + c0 + 256 * i);
                x[i][0] = bflo(xa[i].x) + gg[0] * (g0 * bflo(ya[i].x) + g1 * bflo(yc[i].x)); x[i][1] = bfhi(xa[i].x) + gg[1] * (g0 * bfhi(ya[i].x) + g1 * bfhi(yc[i].x));
                x[i][2] = bflo(xa[i].y) + gg[2] * (g0 * bflo(ya[i].y) + g1 * bflo(yc[i].y)); x[i][3] = bfhi(xa[i].y) + gg[3] * (g0 * bfhi(ya[i].y) + g1 * bfhi(yc[i].y));
            }
        }
        float ss = 0.f;
#pragma unroll
        for (int i = 0; i < 4; ++i) ss += x[i][0] * x[i][0] + x[i][1] * x[i][1] + x[i][2] * x[i][2] + x[i][3] * x[i][3];
        ss = wave_sum(ss);
        const float rstd = rsqrtf(ss * (1.0f / D) + EPS);
        if (LAYER == 4) {
            float* op = (dry ? (float*)(F.ws + WS_END) : F.out) + ((size_t)b * SEQ + (rr - NCTX)) * D;
#pragma unroll
            for (int i = 0; i < 4; ++i) { const f32x4 g = *(const f32x4*)(F.in[I_FG] + c0 + 256 * i); f32x4 y;
#pragma unroll
                for (int j = 0; j < 4; ++j) y[j] = x[i][j] * rstd * g[j];
#ifdef MLA_CHECK
                { const float* chk = (const float*)(F.ws + WS_CTL + 32768); if (!(chk[1] > 0.f && chk[0] > 0.f && chk[0] <= MLA_CHECK_TOL * chk[1])) { y[0] = y[1] = y[2] = y[3] = __builtin_nanf(""); } }
#endif
                __builtin_nontemporal_store(y, (f32x4*)(op + c0 + 256 * i)); }
        } else {
            constexpr int LY = LAYER < 4 ? LAYER : 0;
            const float* na = F.moda(LY, v, 0); const float* sh = F.modv(LY, v, 0);
            bf16_t* xo = xdst + (size_t)row * D; bf16_t* ho = hb + (size_t)row * D;
#pragma unroll
            for (int i = 0; i < 4; ++i) {
                const f32x4 g = *(const f32x4*)(na + c0 + 256 * i), s0v = *(const f32x4*)(sh + c0 + 256 * i);
                f32x4 y;
#pragma unroll
                for (int j = 0; j < 4; ++j) y[j] = x[i][j] * rstd * g[j] + s0v[j];
                st_bf4(xo + c0 + 256 * i, x[i]);
                if (GEMM_FP8 && LAYER != 1) st_fp8x4((unsigned char*)hb + (size_t)row * D + c0 + 256 * i, y); else st_bf4(ho + c0 + 256 * i, y);
            }
        }
    }
}

template <int LAYER>
DI void ph_norm2_router(const Frame& F, bool dry = false) {
    if (!dry) { if (LAYER == 0) cvt_moe_range(F, 0, 2960, 3072, F.vcu, F.G); if (LAYER == 3) cvt_moe_range(F, 3, 1952, 3072, F.vcu, F.G); }
    char* Wl = F.lds;
    int* hist = (int*)(F.lds + LDS_MISC + 64);
    int* basee = hist + 32;
    { const u32x4* src = (const u32x4*)(F.ws + WS_RW + (size_t)LAYER * 2 * RW_HALF); u32x4* dst = (u32x4*)Wl;
      constexpr int NCH = 2 * RW_HALF / 16, NIT = (NCH + NTHR - 1) / NTHR;
      u32x4 tmp[NIT];
#pragma unroll
      for (int k = 0; k < NIT; ++k) { const int i = F.tid + k * NTHR; if (i < NCH) tmp[k] = src[i]; }
#pragma unroll
      for (int k = 0; k < NIT; ++k) { const int i = F.tid + k * NTHR; if (i < NCH) dst[i] = tmp[k]; } }
    if (F.tid < 32) hist[F.tid] = 0;
    __syncthreads();
    const bf16_t* xres = (const bf16_t*)(F.ws + WS_XRES);
    bf16_t* hb = (bf16_t*)(F.ws + WS_H);
    const size_t dofs = dry ? (WS_END - WS_EID) : 0;
    int* eid = (int*)(F.ws + WS_EID + dofs); float* gw = (float*)(F.ws + WS_GW + dofs); int* pos = (int*)(F.ws + WS_POS + dofs);
    const float* bg = F.in[I_BGRP] + LAYER * 4; const float* br = F.in[I_BRT] + LAYER * 32;
    const int fr = F.lane & 15, fq = F.lane >> 4;
    const char* w0 = Wl + fr * RW_PITCH + 16 * fq;
    const char* w1 = w0 + 16 * RW_PITCH;
    const char* w2 = Wl + (32 + (fr & 3)) * RW_PITCH + 16 * fq;
    auto run = [&](const int g16, const int s0, const bool whole, f32x4& acc0, f32x4& acc1, f32x4& acc2) __attribute__((always_inline)) {
        const int row = 16 * g16 + fr, v = row_modv(16 * g16);
        const bf16_t* __restrict__ xp = xres + (size_t)row * D + 8 * fq;
        float ss;
        { const f32x4 q4 = *(const f32x4*)((const float*)(F.ws + WS_SQX) + (size_t)row * 4); ss = q4[0] + q4[1] + q4[2] + q4[3]; }
        const float rstd = rsqrtf(ss * (1.0f / D) + EPS);
        const float* __restrict__ na = F.moda(LAYER, v, 1) + 8 * fq; const float* __restrict__ sh = F.modv(LAYER, v, 3) + 8 * fq;
        unsigned char* __restrict__ h8 = (unsigned char*)hb + (size_t)row * D + 8 * fq;

        if (whole) {
            struct StepIn { u32x4 xw; f32x4 ga, gb, ha, hb_; };
            auto ld = [&](const int s, StepIn& I) __attribute__((always_inline)) { I.xw = *(const u32x4*)(xp + 32 * s); I.ga = *(const f32x4*)(na + 32 * s); I.gb = *(const f32x4*)(na + 32 * s + 4); I.ha = *(const f32x4*)(sh + 32 * s); I.hb_ = *(const f32x4*)(sh + 32 * s + 4); };
            auto stp = [&](const int s, const StepIn& I) __attribute__((always_inline)) {
            float h[8];
            { const u32x4 xw = I.xw;
              const f32x4 a = {bflo(xw.x), bfhi(xw.x), bflo(xw.y), bfhi(xw.y)}, b = {bflo(xw.z), bfhi(xw.z), bflo(xw.w), bfhi(xw.w)};
              const f32x4 ga = I.ga, gb = I.gb;
              const f32x4 ha = I.ha, hbv = I.hb_;
#pragma unroll
              for (int j = 0; j < 4; ++j) { h[j] = a[j] * rstd * ga[j] + ha[j]; h[4 + j] = b[j] * rstd * gb[j] + hbv[j]; } }
            u32x4 hi, lo;
            hi.x = cvt_pk(h[0], h[1]); hi.y = cvt_pk(h[2], h[3]); hi.z = cvt_pk(h[4], h[5]); hi.w = cvt_pk(h[6], h[7]);
            { u32x2 w8; w8.x = pk4_fp8(h[0], h[1], h[2], h[3]); w8.y = pk4_fp8(h[4], h[5], h[6], h[7]); *(u32x2*)(h8 + 32 * s) = w8; }
            lo.x = cvt_pk(h[0] - bflo(hi.x), h[1] - bfhi(hi.x)); lo.y = cvt_pk(h[2] - bflo(hi.y), h[3] - bfhi(hi.y));
            lo.z = cvt_pk(h[4] - bflo(hi.z), h[5] - bfhi(hi.z)); lo.w = cvt_pk(h[6] - bflo(hi.w), h[7] - bfhi(hi.w));
            const bf16x8 ah = __builtin_bit_cast(bf16x8, hi), alo = __builtin_bit_cast(bf16x8, lo);
            const bf16x8 w0h = *(const bf16x8*)(w0 + 64 * s), w0l = *(const bf16x8*)(w0 + RW_HALF + 64 * s);
            const bf16x8 w1h = *(const bf16x8*)(w1 + 64 * s), w1l = *(const bf16x8*)(w1 + RW_HALF + 64 * s);
            const bf16x8 w2h = *(const bf16x8*)(w2 + 64 * s), w2l = *(const bf16x8*)(w2 + RW_HALF + 64 * s);
            acc0 = __builtin_amdgcn_mfma_f32_16x16x32_bf16(w0h, ah, acc0, 0, 0, 0); acc0 = __builtin_amdgcn_mfma_f32_16x16x32_bf16(w0h, alo, acc0, 0, 0, 0); acc0 = __builtin_amdgcn_mfma_f32_16x16x32_bf16(w0l, ah, acc0, 0, 0, 0);
            acc1 = __builtin_amdgcn_mfma_f32_16x16x32_bf16(w1h, ah, acc1, 0, 0, 0); acc1 = __builtin_amdgcn_mfma_f32_16x16x32_bf16(w1h, alo, acc1, 0, 0, 0); acc1 = __builtin_amdgcn_mfma_f32_16x16x32_bf16(w1l, ah, acc1, 0, 0, 0);
            acc2 = __builtin_amdgcn_mfma_f32_16x16x32_bf16(w2h, ah, acc2, 0, 0, 0); acc2 = __builtin_amdgcn_mfma_f32_16x16x32_bf16(w2h, alo, acc2, 0, 0, 0); acc2 = __builtin_amdgcn_mfma_f32_16x16x32_bf16(w2l, ah, acc2, 0, 0, 0);
            };
            StepIn ba[4], bb[4];
#pragma unroll
            for (int k_ = 0; k_ < 4; ++k_) ld(k_, ba[k_]);
#pragma unroll 1
            for (int sb = 0; sb < 32; sb += 8) {
#pragma unroll
                for (int k_ = 0; k_ < 4; ++k_) ld(sb + 4 + k_, bb[k_]);
#pragma unroll
                for (int k_ = 0; k_ < 4; ++k_) stp(sb + k_, ba[k_]);
                if (sb + 8 < 32) {
#pragma unroll
                    for (int k_ = 0; k_ < 4; ++k_) ld(sb + 8 + k_, ba[k_]);
                }
#pragma unroll
                for (int k_ = 0; k_ < 4; ++k_) stp(sb + 4 + k_, bb[k_]);
            }
        } else {
#pragma unroll
            for (int k_ = 0; k_ < 4; ++k_) { const int s = s0 + k_;
            float h[8];
            { const u32x4 xw = *(const u32x4*)(xp + 32 * s);
              const f32x4 a = {bflo(xw.x), bfhi(xw.x), bflo(xw.y), bfhi(xw.y)}, b = {bflo(xw.z), bfhi(xw.z), bflo(xw.w), bfhi(xw.w)};
              const f32x4 ga = *(const f32x4*)(na + 32 * s), gb = *(const f32x4*)(na + 32 * s + 4);
              const f32x4 ha = *(const f32x4*)(sh + 32 * s), hbv = *(const f32x4*)(sh + 32 * s + 4);
#pragma unroll
              for (int j = 0; j < 4; ++j) { h[j] = a[j] * rstd * ga[j] + ha[j]; h[4 + j] = b[j] * rstd * gb[j] + hbv[j]; } }
            u32x4 hi, lo;
            hi.x = cvt_pk(h[0], h[1]); hi.y = cvt_pk(h[2], h[3]); hi.z = cvt_pk(h[4], h[5]); hi.w = cvt_pk(h[6], h[7]);
            { u32x2 w8; w8.x = pk4_fp8(h[0], h[1], h[2], h[3]); w8.y = pk4_fp8(h[4], h[5], h[6], h[7]); *(u32x2*)(h8 + 32 * s) = w8; }
            lo.x = cvt_pk(h[0] - bflo(hi.x), h[1] - bfhi(hi.x)); lo.y = cvt_pk(h[2] - bflo(hi.y), h[3] - bfhi(hi.y));
            lo.z = cvt_pk(h[4] - bflo(hi.z), h[5] - bfhi(hi.z)); lo.w = cvt_pk(h[6] - bflo(hi.w), h[7] - bfhi(hi.w));
            const bf16x8 ah = __builtin_bit_cast(bf16x8, hi), alo = __builtin_bit_cast(bf16x8, lo);
            const bf16x8 w0h = *(const bf16x8*)(w0 + 64 * s), w0l = *(const bf16x8*)(w0 + RW_HALF + 64 * s);
            const bf16x8 w1h = *(const bf16x8*)(w1 + 64 * s), w1l = *(const bf16x8*)(w1 + RW_HALF + 64 * s);
            const bf16x8 w2h = *(const bf16x8*)(w2 + 64 * s), w2l = *(const bf16x8*)(w2 + RW_HALF + 64 * s);
            acc0 = __builtin_amdgcn_mfma_f32_16x16x32_bf16(w0h, ah, acc0, 0, 0, 0); acc0 = __builtin_amdgcn_mfma_f32_16x16x32_bf16(w0h, alo, acc0, 0, 0, 0); acc0 = __builtin_amdgcn_mfma_f32_16x16x32_bf16(w0l, ah, acc0, 0, 0, 0);
            acc1 = __builtin_amdgcn_mfma_f32_16x16x32_bf16(w1h, ah, acc1, 0, 0, 0); acc1 = __builtin_amdgcn_mfma_f32_16x16x32_bf16(w1h, alo, acc1, 0, 0, 0); acc1 = __builtin_amdgcn_mfma_f32_16x16x32_bf16(w1l, ah, acc1, 0, 0, 0);
            acc2 = __builtin_amdgcn_mfma_f32_16x16x32_bf16(w2h, ah, acc2, 0, 0, 0); acc2 = __builtin_amdgcn_mfma_f32_16x16x32_bf16(w2h, alo, acc2, 0, 0, 0); acc2 = __builtin_amdgcn_mfma_f32_16x16x32_bf16(w2l, ah, acc2, 0, 0, 0);
            }
        }
    };
    auto decide = [&](const int g16, const f32x4 acc0, const f32x4 acc1, const f32x4 acc2) __attribute__((always_inline)) {
        const int row = 16 * g16 + fr;
        const float l0 = acc2[0] + bg[0], l1 = acc2[1] + bg[1], l2 = acc2[2] + bg[2], l3 = acc2[3] + bg[3];
        int g = 0; float gm = l0;
        if (l1 > gm) { gm = l1; g = 1; }
        if (l2 > gm) { gm = l2; g = 2; }
        if (l3 > gm) { gm = l3; g = 3; }
        const float wgp = 1.0f / (__expf(l0 - gm) + __expf(l1 - gm) + __expf(l2 - gm) + __expf(l3 - gm));
        const f32x4 cnd = (g >> 1) ? acc1 : acc0;
        const int srcl = fr + 32 * (g & 1);
        float le[8];
#pragma unroll
        for (int j = 0; j < 8; ++j) le[j] = __shfl(cnd[j & 3], srcl + 16 * (j >> 2));
        { const f32x4 ba = *(const f32x4*)(br + 8 * g), bb = *(const f32x4*)(br + 8 * g + 4);
#pragma unroll
          for (int j = 0; j < 4; ++j) { le[j] += ba[j]; le[4 + j] += bb[j]; } }
        int e1 = 0; float m1 = le[0];
#pragma unroll
        for (int j = 1; j < 8; ++j) if (le[j] > m1) { m1 = le[j]; e1 = j; }
        int e2 = -1; float m2 = -3.0e38f;
#pragma unroll
        for (int j = 0; j < 8; ++j) if (j != e1 && le[j] > m2) { m2 = le[j]; e2 = j; }
        const float w1g = 1.0f / (1.0f + __expf(m2 - m1)), w2g = 1.0f - w1g;
        if (fq == 0) {
            const int ea = g * 8 + e1, eb = g * 8 + e2;
            eid[2 * row] = ea; eid[2 * row + 1] = eb;
            gw[2 * row] = wgp * w1g; gw[2 * row + 1] = wgp * w2g;
            pos[2 * row] = atomicAdd(&hist[ea], 1); pos[2 * row + 1] = atomicAdd(&hist[eb], 1);
        }
    };
    const int wi = F.vcu * 8 + F.wave;
    const int gmain = LAYER == 3 ? (wi < 1024 ? 16 + wi : 1056 + (wi - 1024)) : wi;
    { f32x4 a0 = {0.f, 0.f, 0.f, 0.f}, a1 = a0, a2 = a0; run(gmain, 0, true, a0, a1, a2); decide(gmain, a0, a1, a2); }
    const bool coop = LAYER != 3 && (F.vcu & 7) == 0;
    const int gextra = 2048 + (F.vcu >> 3);
    if (coop) {
        f32x4 a0 = {0.f, 0.f, 0.f, 0.f}, a1 = a0, a2 = a0; run(gextra, 4 * F.wave, false, a0, a1, a2);
        float* xb = (float*)F.scr(SM_Y) + (dry ? ((size_t)1 << 20) : 0) + (size_t)(F.vcu >> 3) * (8 * 64 * 12);
        if (F.wave != 0) { float* q = xb + (F.wave * 64 + F.lane) * 12; *(f32x4*)q = a0; *(f32x4*)(q + 4) = a1; *(f32x4*)(q + 8) = a2; }
        __builtin_amdgcn_fence(__ATOMIC_RELEASE, "agent");
        __syncthreads();
        if (F.wave == 0) {
            __builtin_amdgcn_fence(__ATOMIC_ACQUIRE, "agent");
            for (int w = 1; w < 8; ++w) { const float* q = xb + (w * 64 + F.lane) * 12; a0 += *(const f32x4*)q; a1 += *(const f32x4*)(q + 4); a2 += *(const f32x4*)(q + 8); }
            decide(gextra, a0, a1, a2);
        }
    }
    __syncthreads();
    unsigned* counts = (unsigned*)(F.ws + WS_CTL + CTL_COUNTS) + (LAYER + (dry ? 4 : 0)) * 32;
    int t2 = threadIdx.x; asm volatile("" : "+v"(t2));
    if (t2 < 32) basee[t2] = (int)atomicAdd(&counts[t2], (unsigned)hist[t2]);
    __syncthreads();
    if ((t2 & 63) < 16) {
        const int wi2 = F.vcu * 8 + (t2 >> 6), gm2 = LAYER == 3 ? (wi2 < 1024 ? 16 + wi2 : 1056 + (wi2 - 1024)) : wi2;
        { const int row = 16 * gm2 + (t2 & 15); pos[2 * row] += basee[eid[2 * row]]; pos[2 * row + 1] += basee[eid[2 * row + 1]]; }
        if (LAYER != 3 && (F.vcu & 7) == 0 && (t2 >> 6) == 0) { const int row = 16 * (2048 + (F.vcu >> 3)) + (t2 & 15); pos[2 * row] += basee[eid[2 * row]]; pos[2 * row + 1] += basee[eid[2 * row + 1]]; }
    }
    __syncthreads();
}
DI void moe_pstart(const Frame& F, int layer, int* pst) {
    const unsigned* counts = (const unsigned*)(F.ws + WS_CTL + CTL_COUNTS) + layer * 32;
    if (F.tid == 0) { int a = 0; for (int e = 0; e < 32; ++e) { pst[e] = a; a += ((int)counts[e] + 255) / 256 * 256; } pst[32] = a; }
    __syncthreads();
}
template <int LAYER>
DI void ph_scatter(const Frame& F) {
    int* pst = (int*)(F.lds + LDS_MISC + 512);
    moe_pstart(F, LAYER, pst);
    const int* eid = (const int*)(F.ws + WS_EID); const int* pos = (const int*)(F.ws + WS_POS);
    int* slot = (int*)(F.ws + WS_SLOT); int* btok = (int*)(F.ws + WS_BTOK);
    for (int i = F.vcu * NTHR + F.tid; i < 2 * T; i += F.G * NTHR) {
        if (LAYER == 3 && row_modv(i >> 1) == 0) continue;
        const int s = pst[eid[i]] + pos[i];
        slot[i] = s; btok[s] = i >> 1;
    }
    const unsigned* counts = (const unsigned*)(F.ws + WS_CTL + CTL_COUNTS) + LAYER * 32;
    for (int e = F.vcu; e < 32; e += F.G) {
        const int c = (int)counts[e], pc = pst[e + 1] - pst[e];
        for (int p = c + F.tid; p < pc; p += NTHR) btok[pst[e] + p] = 0;
    }
    __syncthreads();
}
DI void tile_rowsumsq(const g8::Acc& acc, const LaneC& L, char* lds, float* out, int stride) {
    float* tb = (float*)lds;
#pragma unroll
    for (int ai = 0; ai < 2; ++ai)
#pragma unroll
        for (int m = 0; m < 4; ++m) {
            float s = 0.f;
#pragma unroll
            for (int bj = 0; bj < 2; ++bj)
#pragma unroll
                for (int n = 0; n < 2; ++n) { const f32x4 v = acc[ai][bj][m][n]; s += v[0] * v[0] + v[1] * v[1] + v[2] * v[2] + v[3] * v[3]; }
            s += __shfl_xor(s, 16); s += __shfl_xor(s, 32);
            if (L.fq == 0) tb[EPI_R(ai, m) * 4 + L.wc] = s;
        }
    __syncthreads();
    int t_ = threadIdx.x; asm volatile("" : "+v"(t_));
    if (t_ < 256) { const f32x4 v = *(const f32x4*)(tb + t_ * 4); out[(size_t)t_ * stride] = v[0] + v[1] + v[2] + v[3]; }
    __syncthreads();
}
DI void rope_cs(const float* rope, int row, int g, int fq, f32x4& c, f32x4& s) {
    const int b = row_batch(row), rr = row - b * TB;
    if (rr < NCTX) { c = (f32x4){1.f, 1.f, 1.f, 1.f}; s = (f32x4){0.f, 0.f, 0.f, 0.f}; return; }
    const int p = rr - NCTX, v = g == 0 ? (p >> 6) : (p & 63);
    const f32x4 a = *(const f32x4*)(rope + (v * 16 + 4 * fq) * 2), bq = *(const f32x4*)(rope + (v * 16 + 4 * fq) * 2 + 4);
    c = (f32x4){a[0], a[2], bq[0], bq[2]}; s = (f32x4){a[1], a[3], bq[1], bq[3]};
}

template <bool KROPE>
DI void ph_mla_proj1(const Frame& F) {
    const bf16_t* hb = (const bf16_t*)(F.ws + WS_H); const bf16_t* W = F.wt(WT_P1);
    bf16_t* cq = F.scr(SC_CQ); bf16_t* ckv = F.scr(SC_CKV); bf16_t* Kb = F.scr(SC_K);
    float* sqq = (float*)(F.ws + WS_SQQ); float* sqkv = (float*)(F.ws + WS_SQKV);
    const float* rope = (const float*)(F.ws + WS_ROPE);
    for (int u = F.vcu; u < 130 * (KROPE ? 1 : 3); u += F.G) {
        const int pm = KROPE ? u : u / 3, pn = KROPE ? 3 : u % 3, R0 = pm * 256;
        g8::Acc acc;
#if GEMM_FP8
        g8::gemm_unit<false, false, true, 124>(g8::opnd(as_h((const unsigned char*)hb + (size_t)R0 * 1024), 512), g8::opnd(as_h((const unsigned char*)W + (size_t)pn * 256 * 1024), 512), 512, F.lds, acc);
#else
        g8::gemm_unit<false>(g8::opnd(hb + (size_t)R0 * 1024, 1024), g8::opnd(W + (size_t)pn * 256 * 1024, 1024), 1024, F.lds, acc);
#endif
        const LaneC L = lane_coords();
        if (pn < 3) {
            bf16_t* dst = pn < 2 ? cq + (size_t)R0 * 512 + pn * 256 : ckv + (size_t)R0 * 256;
            const int ldd = pn < 2 ? 512 : 256;
#pragma unroll
            for (int ai = 0; ai < 2; ++ai)
#pragma unroll
                for (int m = 0; m < 4; ++m)
#pragma unroll
                    for (int bj = 0; bj < 2; ++bj)
#pragma unroll
                        for (int n = 0; n < 2; ++n) { st_bf4(dst + (size_t)EPI_R(ai, m) * ldd + EPI_S(bj, n), acc[ai][bj][m][n]); if (n == 1 && bj == 1) __builtin_amdgcn_sched_barrier(0); }
            if (pn < 2) tile_rowsumsq(acc, L, F.lds, sqq + (size_t)R0 * 2 + pn, 2);
            else tile_rowsumsq(acc, L, F.lds, sqkv + R0, 1);
        } else if (L.wc < 2) {
#pragma unroll
            for (int ai = 0; ai < 2; ++ai)
#pragma unroll
                for (int m = 0; m < 4; ++m) {
                    const int row = R0 + EPI_R(ai, m);
                    f32x4 c, s; rope_cs(rope, row, L.wc & 1, L.fq, c, s);
                    const f32x4 x1 = acc[ai][0][m][0], x2 = acc[ai][0][m][1];
                    const f32x4 o1 = x1 * c - x2 * s, o2 = x1 * s + x2 * c;
#if MLA_KEEP_BF16
                    bf16_t* kp = Kb + (size_t)row * 1536 + 128 + 16 * (L.wc & 1) + 4 * L.fq;
#pragma unroll
                    for (int hh = 0; hh < 8; ++hh) { st_bf4(kp + hh * 192, o1); st_bf4(kp + hh * 192 + 32, o2); }
#endif
#if MLA_FP8
                    { unsigned char* k8 = (unsigned char*)F.scr(SC_K8) + (size_t)row * 1536 + 128 + 16 * (L.wc & 1) + 4 * L.fq;
                      const unsigned w1 = pk4_fp8(o1[0], o1[1], o1[2], o1[3]), w2 = pk4_fp8(o2[0], o2[1], o2[2], o2[3]);
#pragma unroll
                      for (int hh = 0; hh < 8; ++hh) { *(unsigned*)(k8 + hh * 192) = w1; *(unsigned*)(k8 + hh * 192 + 32) = w2; } }
#endif
                }
        }
    }
    if (!KROPE) tail_cvt(F, 390, 0, 0, 976);
}
DI void ph_mla_proj2(const Frame& F) {
    ph_mla_proj1<true>(F);
    const bf16_t* cq = F.scr(SC_CQ); const bf16_t* ckv = F.scr(SC_CKV);
    bf16_t* Qb = F.scr(SC_Q); bf16_t* Kb = F.scr(SC_K); bf16_t* Vb = F.scr(SC_V);
    unsigned char* Q8 = (unsigned char*)F.scr(SC_Q8); unsigned char* K8 = (unsigned char*)F.scr(SC_K8); unsigned char* V8T = (unsigned char*)F.scr(SC_V8T);
    const float* sqq = (const float*)(F.ws + WS_SQQ); const float* sqkv = (const float*)(F.ws + WS_SQKV);
    const float* rope = (const float*)(F.ws + WS_ROPE);
    for (int u0 = F.vcu; u0 < 130 * 14 + 130; u0 += F.G) {
        const int u = u0 - 130;
        if (u < 0) continue;
        const int pm = u / 14, pq = u % 14, R0 = pm * 256;
        g8::Acc acc;
        if (pq < 6) {
            const int pn = pq;
            g8::gemm_unit<false>(g8::opnd(cq + (size_t)R0 * 512, 512), g8::opnd(F.wt(WT_UQ) + (size_t)pn * 256 * 512, 512), 512, F.lds, acc); const LaneC L = lane_coords();
#pragma unroll
            for (int ai = 0; ai < 2; ++ai)
#pragma unroll
                for (int m = 0; m < 4; ++m) {
                    const int row = R0 + EPI_R(ai, m);
                    const float rs = rsqrtf((sqq[2 * row] + sqq[2 * row + 1]) * (1.0f / 512.0f) + EPS);
                    bf16_t* qp = Qb + (size_t)row * 1536 + pn * 256; unsigned char* q8 = Q8 + (size_t)row * 1536 + pn * 256;
#pragma unroll
                    for (int bj = 0; bj < 2; ++bj) {
                        const int seg = 4 * pn + 2 * bj + (L.wc >> 1);
                        if (seg % 3 == 2) {
                            f32x4 c, s; rope_cs(rope, row, L.wc & 1, L.fq, c, s);
                            const f32x4 x1 = acc[ai][bj][m][0] * rs, x2 = acc[ai][bj][m][1] * rs;
                            const int co = bj * 128 + (L.wc >> 1) * 64 + 16 * (L.wc & 1) + 4 * L.fq;
                            const f32x4 y1 = x1 * c - x2 * s, y2 = x1 * s + x2 * c;
#if MLA_KEEP_BF16
                            st_bf4(qp + co, y1); st_bf4(qp + co + 32, y2);
#endif
#if MLA_FP8
                            st_fp8x4(q8 + co, y1); st_fp8x4(q8 + co + 32, y2);
#endif
                        } else {
#pragma unroll
                            for (int n = 0; n < 2; ++n) {
#if MLA_KEEP_BF16
                                st_bf4(qp + EPI_S(bj, n), acc[ai][bj][m][n] * rs);
#endif
#if MLA_FP8
                                st_fp8x4(q8 + EPI_S(bj, n), acc[ai][bj][m][n] * rs);
#endif
                            }
                        }
                    }
                }
        } else if (pq < 10) {
            const int hp = pq - 6;
            const bf16_t* w0 = F.wt(WT_UKV) + (size_t)(2 * hp) * 256 * 256;
            g8::gemm_unit<false>(g8::opnd(ckv + (size_t)R0 * 256, 256), g8::opnd(w0, w0 + 256 * 256, 256), 256, F.lds, acc); const LaneC L = lane_coords();
#pragma unroll
            for (int ai = 0; ai < 2; ++ai)
#pragma unroll
                for (int m = 0; m < 4; ++m) {
                    const int row = R0 + EPI_R(ai, m);
                    const float rs = rsqrtf(sqkv[row] * (1.0f / 256.0f) + EPS);
#pragma unroll
                    for (int bj = 0; bj < 2; ++bj)
#pragma unroll
                        for (int n = 0; n < 2; ++n) {
                            const int co = (2 * hp + bj) * 192 + EPI_S(0, n);
#if MLA_KEEP_BF16
                            st_bf4(Kb + (size_t)row * 1536 + co, acc[ai][bj][m][n] * rs);
#endif
#if MLA_FP8
                            st_fp8x4(K8 + (size_t)row * 1536 + co, acc[ai][bj][m][n] * rs);
#endif
                        }
                }
        } else {
            const int hp = pq - 10;
            const bf16_t* w0 = F.wt(WT_UKV) + ((size_t)(2 * hp) * 256 + 128) * 256;
            g8::gemm_unit<false>(g8::opnd(w0, w0 + 256 * 256, 256), g8::opnd(ckv + (size_t)R0 * 256, 256), 256, F.lds, acc); const LaneC L = lane_coords();
#pragma unroll
            for (int bj = 0; bj < 2; ++bj)
#pragma unroll
                for (int n = 0; n < 2; ++n) {
                    const int s = EPI_S(bj, n), tok = R0 + s;
                    const f32x4 q4 = *(const f32x4*)(sqkv + tok);
                    f32x4 rs;
#pragma unroll
                    for (int j = 0; j < 4; ++j) rs[j] = rsqrtf(q4[j] * (1.0f / 256.0f) + EPS);
#pragma unroll
                    for (int ai = 0; ai < 2; ++ai)
#pragma unroll
                        for (int m = 0; m < 4; ++m) {
                            const int hd = 2 * hp + ai, dv = L.wr * 64 + m * 16 + L.fr;
                            const f32x4 v = acc[ai][bj][m][n] * rs;
#if MLA_FP8
                            st_fp8x4(V8T + (size_t)(hd * 128 + dv) * T + tok, v);
#endif
#if MLA_KEEP_BF16
#pragma unroll
                            for (int j = 0; j < 4; ++j) Vb[(size_t)(tok + j) * 1024 + hd * 128 + dv] = (bf16_t)(cvt_pk(v[j], 0.f) & 0xffffu);
#endif
                        }
                }
        }
    }
}
template <bool F8>
DI void ph_wo(const Frame& F, const bf16_t* A, const bf16_t* W, const float* bias, int layer, bool dry = false) {
    bf16_t* xres = (bf16_t*)(F.ws + WS_XRES);
    bf16_t* xdst = dry ? (bf16_t*)(F.ws + WS_END) : xres;
    const int ntm = layer == 3 ? 128 : 130;
    for (int u = F.vcu; u < ntm * 4; u += F.G) {
        int pm = u >> 2; const int pn = u & 3;
        if (layer == 3) pm = pm + 1 + (pm >= 64 ? 1 : 0);
        const int R0 = pm * 256;
        g8::Acc acc;
        if (F8) g8::gemm_unit<false, false, true, 121>(g8::opnd(as_h((const unsigned char*)A + (size_t)R0 * 1024), 512), g8::opnd(as_h((const unsigned char*)W + (size_t)pn * 256 * 1024), 512), 512, F.lds, acc);
        else g8::gemm_unit<false>(g8::opnd(A + (size_t)R0 * 1024, 1024), g8::opnd(W + (size_t)pn * 256 * 1024, 1024), 1024, F.lds, acc);
        const LaneC L = lane_coords();
        const float* g1 = F.modv(layer, tile_modv(pm), 2) + pn * 256;
        float ssq[2][4];
#pragma unroll
        for (int ai = 0; ai < 2; ++ai)
#pragma unroll
            for (int m = 0; m < 4; ++m) ssq[ai][m] = 0.f;
#pragma unroll
        for (int bj = 0; bj < 2; ++bj)
#pragma unroll
            for (int n = 0; n < 2; ++n) {
                const int s = EPI_S(bj, n);
                const f32x4 g = *(const f32x4*)(g1 + s);
                f32x4 bv = (f32x4){0.f, 0.f, 0.f, 0.f};
                if (bias) bv = *(const f32x4*)(bias + pn * 256 + s);
#pragma unroll
                for (int ai = 0; ai < 2; ++ai)
#pragma unroll
                    for (int m = 0; m < 4; ++m) {
                        bf16_t* xp = xres + (size_t)(R0 + EPI_R(ai, m)) * D + pn * 256 + s;
                        const u32x2 xw = *(const u32x2*)xp;
                        f32x4 x = {bflo(xw.x), bfhi(xw.x), bflo(xw.y), bfhi(xw.y)};
                        x += g * (acc[ai][bj][m][n] + bv);
                        st_bf4(xdst + (xp - xres), x);
                        ssq[ai][m] += x[0] * x[0] + x[1] * x[1] + x[2] * x[2] + x[3] * x[3];
                    }
                __builtin_amdgcn_sched_barrier(0);
            }
        {
            float* tb = (float*)F.lds;
#pragma unroll
            for (int ai = 0; ai < 2; ++ai)
#pragma unroll
                for (int m = 0; m < 4; ++m) {
                    float s = ssq[ai][m];
                    s += __shfl_xor(s, 16); s += __shfl_xor(s, 32);
                    if (L.fq == 0) tb[EPI_R(ai, m) * 4 + L.wc] = s;
                }
            __syncthreads();
            int t_ = threadIdx.x; asm volatile("" : "+v"(t_));
            if (t_ < 256) { const f32x4 v = *(const f32x4*)(tb + t_ * 4);
                ((float*)(F.ws + WS_SQX))[(size_t)(R0 + t_) * 4 + pn] = v[0] + v[1] + v[2] + v[3]; }
            __syncthreads();
        }
    }
    if (!dry) {
        if (layer == 0) tail_cvt(F, 520, 0, 976, 2960);
        if (layer == 1) tail_cvt(F, 520, 1, 1464, 3072);
        if (layer == 2) tail_cvt(F, 520, 2, 1500, 3072);
    }
}
DI void ph_na_qkv(const Frame& F) {
    const bf16_t* hb = (const bf16_t*)(F.ws + WS_H);
    for (int u = F.vcu; u < 130 * 12; u += F.G) {
        const int pm = u / 12, pn = u % 12, R0 = pm * 256;
        g8::Acc acc;
#if GEMM_FP8
        g8::gemm_unit<false, false, true, 124>(g8::opnd(as_h((const unsigned char*)hb + (size_t)R0 * 1024), 512), g8::opnd(as_h((const unsigned char*)F.wt(WT_NAQKV) + (size_t)pn * 256 * 1024), 512), 512, F.lds, acc);
#else
        g8::gemm_unit<false>(g8::opnd(hb + (size_t)R0 * 1024, 1024), g8::opnd(F.wt(WT_NAQKV) + (size_t)pn * 256 * 1024, 1024), 1024, F.lds, acc);
#endif
        const LaneC L = lane_coords();
        bf16_t* dst = F.scr(pn < 4 ? SN_Q : (pn < 8 ? SN_K : SN_V)) + (size_t)R0 * 1024 + (pn & 3) * 256;
#pragma unroll
        for (int ai = 0; ai < 2; ++ai)
#pragma unroll
            for (int m = 0; m < 4; ++m)
#pragma unroll
                for (int bj = 0; bj < 2; ++bj)
#pragma unroll
                    for (int n = 0; n < 2; ++n) st_bf4(dst + (size_t)EPI_R(ai, m) * 1024 + EPI_S(bj, n), acc[ai][bj][m][n]);
    }
    tail_cvt(F, 130 * 12, 2, 0, 1500);
}
DI void ph_swa_qkv(const Frame& F) {
    const bf16_t* hb = (const bf16_t*)(F.ws + WS_H);
    const float* rope = (const float*)(F.ws + WS_ROPE);
    for (int u = F.vcu; u < 130 * 6; u += F.G) {
        const int pm = u / 6, pn = u % 6, R0 = pm * 256;
        g8::Acc acc;
#if GEMM_FP8
        g8::gemm_unit<false, false, true, 124>(g8::opnd(as_h((const unsigned char*)hb + (size_t)R0 * 1024), 512), g8::opnd(as_h((const unsigned char*)F.wt(WT_SWQKV) + (size_t)pn * 256 * 1024), 512), 512, F.lds, acc);
#else
        g8::gemm_unit<false>(g8::opnd(hb + (size_t)R0 * 1024, 1024), g8::opnd(F.wt(WT_SWQKV) + (size_t)pn * 256 * 1024, 1024), 1024, F.lds, acc);
#endif
        const LaneC L = lane_coords();
        if (pn < 5) {
            bf16_t* dst = pn < 4 ? F.scr(SS_Q) + (size_t)R0 * 1024 + pn * 256 : F.scr(SS_K) + (size_t)R0 * 256;
            const int ldd = pn < 4 ? 1024 : 256;
#pragma unroll
            for (int ai = 0; ai < 2; ++ai)
#pragma unroll
                for (int m = 0; m < 4; ++m) {
                    const int rl = EPI_R(ai, m);
                    f32x4 c, s; rope_cs(rope, R0 + rl, L.wc & 1, L.fq, c, s);
#pragma unroll
                    for (int bj = 0; bj < 2; ++bj) {
                        const f32x4 x1 = acc[ai][bj][m][0], x2 = acc[ai][bj][m][1];
                        bf16_t* p = dst + (size_t)rl * ldd + bj * 128 + (L.wc >> 1) * 64 + 16 * (L.wc & 1) + 4 * L.fq;
                        st_bf4(p, x1 * c - x2 * s); st_bf4(p + 32, x1 * s + x2 * c);
                    }
                }
        } else {
            bf16_t* dst = F.scr(SS_V) + (size_t)R0 * 256;
#pragma unroll
            for (int ai = 0; ai < 2; ++ai)
#pragma unroll
                for (int m = 0; m < 4; ++m)
#pragma unroll
                    for (int bj = 0; bj < 2; ++bj)
#pragma unroll
                        for (int n = 0; n < 2; ++n) st_bf4(dst + (size_t)EPI_R(ai, m) * 256 + EPI_S(bj, n), acc[ai][bj][m][n]);
        }
    }
    tail_cvt(F, 130 * 6, 3, 0, 1952);
}
DI int moe_expert_of(const int* pst, int slot0) { int e = 0;
#pragma unroll 1
    for (int q = 1; q < 32; ++q) if (pst[q] <= slot0) e = q; return e; }
constexpr int MOE_WS = 124;
template <int LAYER>
DI void ph_moe1(const Frame& F) {
    int* pst = (int*)(F.lds + LDS_MISC + 512);
    moe_pstart(F, LAYER, pst);
    const int MT = pst[32] >> 8, NU = MT * 4, NFULL = (NU / F.G) * F.G, NH = 2 * (NU - NFULL);
    const unsigned char* h8 = F.ws + WS_H; const unsigned char* mw = F.ws + WS_MOEW;
    const int* btok = (const int*)(F.ws + WS_BTOK);
    unsigned char* act = (unsigned char*)F.scr(SM_ACT);
    for (int u = F.vcu; u < NFULL; u += F.G) {
        const int mt = u >> 2, pn = u & 3, e = moe_expert_of(pst, mt * 256);
        g8::Acc acc;
        g8::gemm_unit<true, false, true, MOE_WS>(g8::Opnd{as_h(h8), as_h(h8), 512, btok + mt * 256},
                      g8::opnd(as_h(mw + MOEW_G + (size_t)(e * 512 + pn * 128) * 1024), as_h(mw + MOEW_U + (size_t)(e * 512 + pn * 128) * 1024), 512), 512, F.lds, acc); const LaneC L = lane_coords();
#pragma unroll
        for (int ai = 0; ai < 2; ++ai)
#pragma unroll
            for (int m = 0; m < 4; ++m)
#pragma unroll
                for (int n = 0; n < 2; ++n) {
                    const f32x4 g = acc[ai][0][m][n], up = acc[ai][1][m][n];
                    f32x4 r;
#pragma unroll
                    for (int j = 0; j < 4; ++j) r[j] = silu_f(g[j]) * up[j];
                    st_fp8x4(act + (size_t)(mt * 256 + EPI_R(ai, m)) * 512 + pn * 128 + EPI_S(0, n), r);
                }
    }
    for (int hu = F.vcu; hu < NH; hu += F.G) {
        const int u = NFULL + (hu >> 1), half = hu & 1, mt = u >> 2, pn = u & 3, e = moe_expert_of(pst, mt * 256);
        g8::Acc acc;
        g8::gemm_unit<true, true, true, MOE_WS>(g8::Opnd{as_h(h8), as_h(h8), 512, btok + mt * 256 + 128 * half},
                      g8::opnd(as_h(mw + MOEW_G + (size_t)(e * 512 + pn * 128) * 1024), as_h(mw + MOEW_U + (size_t)(e * 512 + pn * 128) * 1024), 512), 512, F.lds, acc); const LaneC L = lane_coords();
#pragma unroll
        for (int m = 0; m < 4; ++m)
#pragma unroll
            for (int n = 0; n < 2; ++n) {
                const f32x4 g = acc[0][0][m][n], up = acc[0][1][m][n];
                f32x4 r;
#pragma unroll
                for (int j = 0; j < 4; ++j) r[j] = silu_f(g[j]) * up[j];
                st_fp8x4(act + (size_t)(mt * 256 + 128 * half + EPI_R(0, m)) * 512 + pn * 128 + EPI_S(0, n), r);
            }
    }
}
template <bool HALFX>
DI void epi_tile_bf16(g8::Acc& acc, char* lds, bf16_t* __restrict__ dst, const int ldd) {
    constexpr int P = 528, NR = HALFX ? 128 : 256;
    { const LaneC L = lane_coords();
#pragma unroll
      for (int ai = 0; ai < (HALFX ? 1 : 2); ++ai)
#pragma unroll
        for (int m = 0; m < 4; ++m)
#pragma unroll
            for (int bj = 0; bj < 2; ++bj)
#pragma unroll
                for (int n = 0; n < 2; ++n) { const f32x4 v = acc[ai][bj][m][n]; u32x2 w; w.x = cvt_pk(v[0], v[1]); w.y = cvt_pk(v[2], v[3]);
                    *reinterpret_cast<u32x2*>(lds + EPI_R(ai, m) * P + EPI_S(bj, n) * 2) = w; } }
    __syncthreads();
    { int tid = threadIdx.x; asm volatile("" : "+v"(tid));
      const int wave = tid >> 6, lane = tid & 63, sub = lane >> 5, c16 = lane & 31;
#pragma unroll
      for (int i = 0; i < NR / 16; ++i) { const int row = wave * (NR / 8) + 2 * i + sub;
          const u32x4 v = *reinterpret_cast<const u32x4*>(lds + row * P + c16 * 16);
          __builtin_nontemporal_store(v, reinterpret_cast<u32x4*>(dst + (size_t)row * ldd + c16 * 8)); } }
    __syncthreads();
}
template <int LAYER>
DI void ph_moe2(const Frame& F) {
    int* pst = (int*)(F.lds + LDS_MISC + 512);
    moe_pstart(F, LAYER, pst);
    const int MT = pst[32] >> 8, NU = MT * 4, NFULL = (NU / F.G) * F.G, NH = 2 * (NU - NFULL);
    const unsigned char* mw = F.ws + WS_MOEW;
    const unsigned char* act = (const unsigned char*)F.scr(SM_ACT); bf16_t* yb = F.scr(SM_Y);
    for (int u = F.vcu; u < NFULL; u += F.G) {
        const int mt = u >> 2, pn = u & 3, e = moe_expert_of(pst, mt * 256);
        g8::Acc acc;
        g8::gemm_unit<false, false, true, MOE_WS, true, false>(g8::opnd(as_h(act + (size_t)mt * 256 * 512), 256), g8::opnd(as_h(mw + MOEW_D + (size_t)(e * 1024 + pn * 256) * 512), 256), 256, F.lds, acc);
        epi_tile_bf16<false>(acc, F.lds, yb + (size_t)(mt * 256) * D + pn * 256, D);
    }
    for (int hu = F.vcu; hu < NH; hu += F.G) {
        const int u = NFULL + (hu >> 1), half = hu & 1, mt = u >> 2, pn = u & 3, e = moe_expert_of(pst, mt * 256);
        g8::Acc acc;
        const bf16_t* xa = as_h(act + (size_t)(mt * 256 + 128 * half) * 512);
        g8::gemm_unit<false, true, true, MOE_WS, true, false>(g8::opnd(xa, xa, 256), g8::opnd(as_h(mw + MOEW_D + (size_t)(e * 1024 + pn * 256) * 512), 256), 256, F.lds, acc);
        epi_tile_bf16<true>(acc, F.lds, yb + (size_t)(mt * 256 + 128 * half) * D + pn * 256, D);
    }
}
DI void ph_dft_a(const Frame& F) {
    const bf16_t* hb = (const bf16_t*)(F.ws + WS_H);
    bf16_t* Z = F.scr(SF_Z); bf16_t* Zc = F.scr(SF_ZC);
    for (int u = F.vcu; u < 1024 + 16; u += F.G) {
        g8::Acc acc;
        if (u < 1024) {
            const int st = u & 63, rt = (u >> 6) & 1, g = (u >> 7) & 3, b = u >> 9, bg = b * 4 + g;
            { const bf16_t* yb0 = hb + (size_t)(b * TB + NCTX + 2 * st) * 1024 + g * 256;
              g8::gemm_unit<false>(g8::opnd(F.wt(WT_DFTA) + (size_t)rt * 256 * 256, 256), g8::opnd(yb0, yb0 + 1024, 128 * 1024), 256, F.lds, acc); }
            const LaneC L = lane_coords();
#pragma unroll
            for (int ai = 0; ai < 2; ++ai)
#pragma unroll
                for (int m = 0; m < 4; ++m)
#pragma unroll
                    for (int bj = 0; bj < 2; ++bj)
#pragma unroll
                        for (int n = 0; n < 2; ++n) {
                            const int kc = EPI_R(ai, m), n2 = 2 * st + bj, n1 = L.wc * 32 + n * 16 + 4 * L.fq;
                            st_bf4(Z + ((((size_t)bg * 256 + kc) * 128 + n2) * 2 + rt) * 128 + n1, acc[ai][bj][m][n]);
                        }
        } else {
            const int q = u - 1024, rt = q & 1, g = (q >> 1) & 3, b = q >> 3, bg = b * 4 + g;
            g8::gemm_unit<false>(g8::opnd(F.wt(WT_DFTA) + (size_t)rt * 256 * 256, 256), g8::opnd(hb + (size_t)b * TB * 1024 + g * 256, 1024), 256, F.lds, acc); const LaneC L = lane_coords();
#pragma unroll
            for (int ai = 0; ai < 2; ++ai)
#pragma unroll
                for (int m = 0; m < 4; ++m)
#pragma unroll
                    for (int bj = 0; bj < 2; ++bj)
#pragma unroll
                        for (int n = 0; n < 2; ++n)
                            st_bf4(Zc + (((size_t)bg * 256 + EPI_R(ai, m)) * 2 + rt) * 256 + EPI_S(bj, n), acc[ai][bj][m][n]);
        }
    }
    tail_cvt(F, 1040, 1, 0, 720);
}
DI void ph_dft_1(const Frame& F) {
    const bf16_t* Z = F.scr(SF_Z); const bf16_t* Zc = F.scr(SF_ZC); bf16_t* A1 = F.scr(SF_A1); bf16_t* YF = F.scr(SF_YF);
    for (int u = F.vcu; u < 1024 + 8; u += F.G) {
        g8::Acc acc;
        if (u < 1024) {
            g8::gemm_unit<false>(g8::opnd(F.wt(WT_DFT1), 256), g8::opnd(Z + (size_t)u * 256 * 256, 256), 256, F.lds, acc); const LaneC L = lane_coords();
#pragma unroll
            for (int m = 0; m < 4; ++m) {
                const int kb = L.wr * 64 + m * 16 + L.fr;
#pragma unroll
                for (int bj = 0; bj < 2; ++bj)
#pragma unroll
                    for (int n = 0; n < 2; ++n) {
                        const int n2 = L.wc * 32 + n * 16 + 4 * L.fq, bgkc = 2 * u + bj;
                        const f32x4 re = acc[0][bj][m][n], im = acc[1][bj][m][n];
                        f32x4 ro, io;
#pragma unroll
                        for (int j = 0; j < 4; ++j) {
                            const float th = (float)((n2 + j) * kb) * (1.0f / 16384.0f);
                            const float c = __builtin_amdgcn_cosf(th), s = __builtin_amdgcn_sinf(th);
                            ro[j] = re[j] * c + im[j] * s; io[j] = im[j] * c - re[j] * s;
                        }
                        bf16_t* p = A1 + (((size_t)bgkc * 128 + kb) * 2) * 128 + n2;
                        st_bf4(p, ro); st_bf4(p + 128, io);
                        __builtin_amdgcn_sched_barrier(0);
                    }
            }
        } else {
            const int bg = u - 1024, b = bg >> 2, g = bg & 3;
            g8::gemm_unit<false>(g8::opnd(F.wt(WT_DFTC), 512), g8::opnd(Zc + (size_t)bg * 256 * 512, 512), 512, F.lds, acc); const LaneC L = lane_coords();
#pragma unroll
            for (int ai = 0; ai < 2; ++ai)
#pragma unroll
                for (int m = 0; m < 4; ++m)
#pragma unroll
                    for (int bj = 0; bj < 2; ++bj)
#pragma unroll
                        for (int n = 0; n < 2; ++n)
                            st_bf4(YF + (size_t)(b * TB + EPI_R(ai, m)) * 1024 + g * 256 + EPI_S(bj, n), acc[ai][bj][m][n]);
        }
    }
    tail_cvt(F, 1032, 1, 720, 1464);
}
DI void ph_dft_2(const Frame& F) {
    const bf16_t* A1 = F.scr(SF_A1); bf16_t* YF = F.scr(SF_YF);
    for (int u = F.vcu; u < 1024; u += F.G) {
        const int kb = u & 127, bg = u >> 7, b = bg >> 2, g = bg & 3;
        g8::Acc acc;
        g8::gemm_unit<false>(g8::opnd(F.wt(WT_DFT2), 256), g8::opnd(A1 + ((size_t)bg * 256 * 128 + kb) * 256, 128 * 256), 256, F.lds, acc); const LaneC L = lane_coords();
#pragma unroll
        for (int m = 0; m < 4; ++m) {
            const int ka = L.wr * 64 + m * 16 + L.fr;
#pragma unroll
            for (int bj = 0; bj < 2; ++bj)
#pragma unroll
                for (int n = 0; n < 2; ++n)
                    st_bf4(YF + (size_t)(b * TB + NCTX + 128 * ka + kb) * 1024 + g * 256 + EPI_S(bj, n), acc[0][bj][m][n]);
        }
    }
}
constexpr float LOG2E = 1.4426950408889634f;
struct MlaCfg {
    const bf16_t* Q; const bf16_t* K; const bf16_t* V; bf16_t* O; int qrow0, krow0, nt, head;
    DI const bf16_t* qrow(int w, int r) const { return Q + (size_t)(qrow0 + 32 * w + r) * 1536 + head * 192; }
    DI bf16_t* orow(int w, int r) const { return O + (size_t)(qrow0 + 32 * w + r) * 1024 + head * 128; }
    DI int ntiles() const { return nt; }
    DI const bf16_t* ktile(int t) const { return K + (size_t)(krow0 + 64 * t) * 1536 + head * 192; }
    DI const bf16_t* vtile(int t) const { return V + (size_t)(krow0 + 64 * t) * 1024 + head * 128; }
    DI int ldk() const { return 1536; } DI int ldv() const { return 1024; }
    DI bool active(int, int) const { return true; }
    DI void mask(f32x16&, f32x16&, int, int, int, int, const float*) const {}
    DI void init(f32x16& p0, f32x16& p1, int, int, int, int, const float*) const { _Pragma("unroll") for (int r = 0; r < 16; ++r) { p0[r] = 0.f; p1[r] = 0.f; } }
    DI float m0() const { return -1e28f; } DI float l0() const { return 0.f; }
    DI float cexp() const { return 0.07216878364870322f * LOG2E; }
};
template <int PRB>
DI void ph_mla_attn(const Frame& F) {
    for (int u = F.vcu; u < 1024 + 16; u += F.G) {
        MlaCfg c; c.Q = F.scr(SC_Q); c.K = F.scr(SC_K); c.V = F.scr(SC_V); c.O = PRB ? (bf16_t*)(F.ws + WS_END) : F.scr(SC_O);
        if (u < 1024) { const int b = u >> 9, head = (u >> 6) & 7, qb = u & 63; c.qrow0 = b * TB + NCTX + 256 * qb; c.krow0 = b * TB; c.nt = TB / 64; c.head = head; }
        else { const int q = u - 1024, b = q >> 3; c.head = q & 7; c.qrow0 = b * TB; c.krow0 = b * TB; c.nt = NCTX / 64; }
#if MLA_FP8
        at::mla_attn_unit_fp8<PRB>((const unsigned char*)F.scr(SC_Q8) + (size_t)c.qrow0 * 1536 + c.head * 192, (const unsigned char*)F.scr(SC_K8) + (size_t)c.krow0 * 1536 + c.head * 192,
                              (const unsigned char*)F.scr(SC_V8T) + (size_t)(c.head * 128) * T + c.krow0,
                              WO_FP8 ? (bf16_t*)((unsigned char*)c.O + (size_t)c.qrow0 * 1024 + c.head * 128) : c.O + (size_t)c.qrow0 * 1024 + c.head * 128, c.nt, F.lds);
#else
        at::mla_attn_unit<PRB>(c.Q + (size_t)c.qrow0 * 1536 + c.head * 192, c.K + (size_t)c.krow0 * 1536 + c.head * 192, c.V + (size_t)c.krow0 * 1024 + c.head * 128,
                          c.O + (size_t)c.qrow0 * 1024 + c.head * 128, c.nt, F.lds);
#endif
    }
}
#ifdef MLA_CHECK
DI void ph_mla_attn_ref(const Frame& F) {
    for (int u = F.vcu; u < 1024 + 16; u += F.G) {
        MlaCfg c; c.Q = F.scr(SC_Q); c.K = F.scr(SC_K); c.V = F.scr(SC_V); c.O = (bf16_t*)(F.ws + WS_END);
        if (u < 1024) { const int b = u >> 9, head = (u >> 6) & 7, qb = u & 63; c.qrow0 = b * TB + NCTX + 256 * qb; c.krow0 = b * TB; c.nt = TB / 64; c.head = head; }
        else { const int q = u - 1024, b = q >> 3; c.head = q & 7; c.qrow0 = b * TB; c.krow0 = b * TB; c.nt = NCTX / 64; }
        at::attn_unit<192, 128>(c, F.lds, nullptr);
    }
}
DI void ph_mla_compare(const Frame& F) {
    const bf16_t* a = F.scr(SC_O); const bf16_t* b = (const bf16_t*)(F.ws + WS_END);
    float num = 0.f, den = 0.f;
    for (size_t i = (size_t)F.vcu * NTHR + F.tid; i < (size_t)T * 1024; i += (size_t)F.G * NTHR) { const float x = bf2f(a[i]), y = bf2f(b[i]); num += (x - y) * (x - y); den += y * y; }
    num = wave_sum(num); den = wave_sum(den);
    float* acc = (float*)(F.ws + WS_CTL + 32768);
    if (F.lane == 0) { atomicAdd(acc, num); atomicAdd(acc + 1, den); }
}
#endif
struct NaCfg {
    const bf16_t* Q; const bf16_t* K; const bf16_t* V; bf16_t* O; int qrow0, b, head, rg, rs_lo, nt; bool ctxq;
    DI const bf16_t* qrow(int w, int r) const { return Q + (size_t)(qrow0 + 32 * w + r) * 1024 + head * 64; }
    DI bf16_t* orow(int w, int r) const { return O + (size_t)(qrow0 + 32 * w + r) * 1024 + head * 64; }
    DI int ntiles() const { return nt; }
    DI int krow(int t) const { return t < 4 ? b * TB + 64 * t : b * TB + NCTX + 64 * (rs_lo + t - 4); }
    DI const bf16_t* ktile(int t) const { return K + (size_t)krow(t) * 1024 + head * 64; }
    DI const bf16_t* vtile(int t) const { return V + (size_t)krow(t) * 1024 + head * 64; }
    DI int ldk() const { return 1024; } DI int ldv() const { return 1024; }
    DI static int clampi(int x, int lo, int hi) { return x < lo ? lo : (x > hi ? hi : x); }
    DI bool active(int t, int w) const { if (t < 4) return true; const int qr = 4 * rg + (w >> 1), rs = clampi(qr - 4, 0, 248), kr = rs_lo + t - 4; return kr >= rs && kr < rs + 8; }
    DI void init(f32x16& p0, f32x16& p1, int t, int w, int r32, int hi, const float* tbl) const {
        if (t < 4) {
#pragma unroll
            for (int r = 0; r < 16; ++r) { p0[r] = 0.f; p1[r] = 0.f; }
            return;
        }
        const int qr = 4 * rg + (w >> 1), kr = rs_lo + t - 4, qc = (w & 1) * 32 + r32;
        const float* tb = tbl + (kr - qr + 7) * 31 + 15 - qc;
#pragma unroll
        for (int r = 0; r < 16; ++r) { const int k0 = at::crow(r, hi); p0[r] = tb[k0]; p1[r] = tb[32 + k0]; }
    }
    DI void mask(f32x16& p0, f32x16& p1, int t, int w, int r32, int hi, const float*) const {
        if (t < 4) return;
        const int qc = (w & 1) * 32 + r32, cs = clampi(qc - 8, 0, 48);
#pragma unroll
        for (int r = 0; r < 16; ++r) {
            const int k0 = at::crow(r, hi), k1 = 32 + k0;
            p0[r] = (k0 >= cs && k0 < cs + 16) ? p0[r] : -1e30f;
            p1[r] = (k1 >= cs && k1 < cs + 16) ? p1[r] : -1e30f;
        }
    }
    DI float m0() const { return -1e28f; } DI float l0() const { return 0.f; }
    DI float cexp() const { return 0.125f * LOG2E; }
};
DI void ph_na_attn(const Frame& F) {
    float* tbl = (float*)(F.lds + 24576);
    for (int u = F.vcu; u < 2048 + 32; u += F.G) {
        NaCfg c; c.Q = F.scr(SN_Q); c.K = F.scr(SN_K); c.V = F.scr(SN_V); c.O = F.scr(SN_O);
        if (u < 2048) {
            const int b = u >> 10, head = (u >> 6) & 15, rg = u & 63;
            c.b = b; c.head = head; c.rg = rg; c.qrow0 = b * TB + NCTX + 256 * rg; c.ctxq = false;
            c.rs_lo = NaCfg::clampi(4 * rg - 4, 0, 248);
            const int last = NaCfg::clampi(4 * rg + 3 - 4, 0, 248) + 7;
            c.nt = 4 + last - c.rs_lo + 1;
        } else { const int q = u - 2048; c.b = q >> 4; c.head = q & 15; c.rg = 0; c.rs_lo = 0; c.qrow0 = c.b * TB; c.nt = 4; c.ctxq = true; }
        const float* rpb = F.in[I_RPB] + c.head * 465;
        for (int i = F.tid; i < 465; i += NTHR) tbl[i] = rpb[i] * 8.0f;
        at::attn_unit<64, 64>(c, F.lds, tbl);
    }
}
struct SwaCfg {
    const bf16_t* Q; const bf16_t* K; const bf16_t* V; bf16_t* O; int qrow0, b, head, qb, klo, nt; float sink;
    DI const bf16_t* qrow(int w, int r) const { return Q + (size_t)(qrow0 + 32 * w + r) * 1024 + head * 64; }
    DI bf16_t* orow(int w, int r) const { return O + (size_t)(qrow0 + 32 * w + r) * 1024 + head * 64; }
    DI int ntiles() const { return nt; }
    DI int krow(int t) const { return t < 4 ? b * TB + 64 * t : b * TB + NCTX + 64 * (klo + t - 4); }
    DI const bf16_t* ktile(int t) const { return K + (size_t)krow(t) * 256 + (head >> 2) * 64; }
    DI const bf16_t* vtile(int t) const { return V + (size_t)krow(t) * 256 + (head >> 2) * 64; }
    DI int ldk() const { return 256; } DI int ldv() const { return 256; }
    DI bool active(int t, int w) const { if (t < 4) return true; const int qlo = 256 * qb + 32 * w, k0 = 64 * (klo + t - 4); return k0 + 63 >= qlo - 128 && k0 <= qlo + 31 + 128; }
    DI void mask(f32x16& p0, f32x16& p1, int t, int w, int r32, int hi, const float*) const {
        if (t < 4) return;
        { const int k0 = 64 * (klo + t - 4), qlo = 256 * qb + 32 * w; if (k0 + 63 - qlo <= 128 && qlo + 31 - k0 <= 128) return; }
        const int d0 = 64 * (klo + t - 4) - (256 * qb + 32 * w + r32);
#pragma unroll
        for (int r = 0; r < 16; ++r) {
            const int da = d0 + at::crow(r, hi), db = da + 32;
            p0[r] = (da >= -128 && da <= 128) ? p0[r] : -1e30f;
            p1[r] = (db >= -128 && db <= 128) ? p1[r] : -1e30f;
        }
    }
    DI void init(f32x16& p0, f32x16& p1, int, int, int, int, const float*) const { _Pragma("unroll") for (int r = 0; r < 16; ++r) { p0[r] = 0.f; p1[r] = 0.f; } }
    DI float m0() const { return sink * 8.0f; } DI float l0() const { return 1.f; }
    DI float cexp() const { return 0.125f * LOG2E; }
};
DI void ph_swa_attn(const Frame& F) {
    for (int u = F.vcu; u < 2048; u += F.G) {
        SwaCfg c; c.Q = F.scr(SS_Q); c.K = F.scr(SS_K); c.V = F.scr(SS_V); c.O = F.scr(SS_O);
        const int b = u >> 10, head = (u >> 6) & 15, qb = u & 63;
        c.b = b; c.head = head; c.qb = qb; c.qrow0 = b * TB + NCTX + 256 * qb;
        c.klo = 4 * qb - 2 < 0 ? 0 : 4 * qb - 2;
        const int khi = 4 * qb + 5 > 255 ? 255 : 4 * qb + 5;
        c.nt = 4 + khi - c.klo + 1;
        c.sink = F.in[I_SINK][head];
        at::attn_unit<64, 64>(c, F.lds, nullptr);
    }
}

#ifdef MLA_CHECK
constexpr int N_PHASES = 39;
#else
constexpr int N_PHASES = 37;
#endif
__global__ void __launch_bounds__(NTHR, 2) mk_fwd(Params P) {
    extern __shared__ __attribute__((aligned(16))) char lds[];
    Frame F;
    F.in = (const float* const __attribute__((address_space(4)))*)__builtin_amdgcn_kernarg_segment_ptr(); F.out = P.out; F.ws = P.ws; F.lds = lds;
    F.tid = threadIdx.x; F.lane = F.tid & 63; F.wave = __builtin_amdgcn_readfirstlane(F.tid >> 6);
    F.G = gridDim.x; { const int bx = blockIdx.x; F.vcu = (F.G % 8 == 0) ? (bx % 8) * (F.G / 8) + bx / 8 : bx; }
    const int lo = P.ph_lo, hi = P.ph_hi;
    volatile LAS unsigned* stw = (volatile LAS unsigned*)(lds + LDS_MISC);
    if (F.tid < 4) stw[F.tid] = 0u;
    __syncthreads();
    XcdBarrier bar; bar.bar = (unsigned*)(P.ws + WS_CTL); bar.x = 0; bar.st = stw;
    if (hi - lo > 1) bar = xcd_barrier_post((unsigned*)(P.ws + WS_CTL), stw);
    int ph = 0;
#ifndef REP_MASK
#define REP_MASK 0ull
#endif
#ifndef ONLY_PHASE
#define ONLY_PHASE (-1)
#endif
#define PHASE(body) do { if (lo <= ph && ph < hi && (ONLY_PHASE < 0 || ph == ONLY_PHASE)) { { int t_ = threadIdx.x; asm volatile("" : "+v"(t_)); F.tid = t_; F.lane = t_ & 63; } body; \
    if ((REP_MASK >> ph) & 1ull) { if (hi - lo > 1) xcd_barrier(bar); body; } if (ph + 1 < hi) xcd_barrier(bar); } ++ph; } while (0)
#define PHASE2(body, drybody) do { if (lo <= ph && ph < hi && (ONLY_PHASE < 0 || ph == ONLY_PHASE)) { { int t_ = threadIdx.x; asm volatile("" : "+v"(t_)); F.tid = t_; F.lane = t_ & 63; } body; \
    if ((REP_MASK >> ph) & 1ull) { if (hi - lo > 1) xcd_barrier(bar); drybody; } if (ph + 1 < hi) xcd_barrier(bar); } ++ph; } while (0)
    PHASE(ph_prologue(F));
    PHASE(ph_modreduce(F));
    PHASE2(ph_norm1<0>(F), ph_norm1<0>(F, true));
    PHASE(ph_mla_proj1<false>(F));
    PHASE(ph_mla_proj2(F));
#ifndef MLA_PRB
#define MLA_PRB 0
#endif
    PHASE2(ph_mla_attn<0>(F), ph_mla_attn<MLA_PRB>(F));
#ifdef MLA_CHECK
    PHASE(ph_mla_attn_ref(F));
    PHASE(ph_mla_compare(F));
#endif
    PHASE2(ph_wo<WO_FP8>(F, F.scr(SC_O), F.wt(WT_WO0), nullptr, 0), ph_wo<WO_FP8>(F, F.scr(SC_O), F.wt(WT_WO0), nullptr, 0, true));
    PHASE2(ph_norm2_router<0>(F), ph_norm2_router<0>(F, true));
    PHASE(ph_scatter<0>(F));
    PHASE(ph_moe1<0>(F));
#ifndef MOE2_EPRB
#define MOE2_EPRB 0
#endif
    PHASE(ph_moe2<0>(F));
    PHASE2(ph_norm1<1>(F), ph_norm1<1>(F, true));
    PHASE(ph_dft_a(F));
    PHASE(ph_dft_1(F));
    PHASE(ph_dft_2(F));
    PHASE2(ph_wo<false>(F, F.scr(SF_YF), F.wt(WT_WO1), F.in[I_FBO], 1), ph_wo<false>(F, F.scr(SF_YF), F.wt(WT_WO1), F.in[I_FBO], 1, true));
    PHASE2(ph_norm2_router<1>(F), ph_norm2_router<1>(F, true));
    PHASE(ph_scatter<1>(F));
    PHASE(ph_moe1<1>(F));
    PHASE(ph_moe2<1>(F));
    PHASE2(ph_norm1<2>(F), ph_norm1<2>(F, true));
    PHASE(ph_na_qkv(F));
    PHASE(ph_na_attn(F));
    PHASE2(ph_wo<WO_FP8>(F, F.scr(SN_O), F.wt(WT_WO2), nullptr, 2), ph_wo<WO_FP8>(F, F.scr(SN_O), F.wt(WT_WO2), nullptr, 2, true));
    PHASE2(ph_norm2_router<2>(F), ph_norm2_router<2>(F, true));
    PHASE(ph_scatter<2>(F));
    PHASE(ph_moe1<2>(F));
    PHASE(ph_moe2<2>(F));
    PHASE2(ph_norm1<3>(F), ph_norm1<3>(F, true));
    PHASE(ph_swa_qkv(F));
    PHASE(ph_swa_attn(F));
    PHASE2(ph_wo<WO_FP8>(F, F.scr(SS_O), F.wt(WT_WO3), nullptr, 3), ph_wo<WO_FP8>(F, F.scr(SS_O), F.wt(WT_WO3), nullptr, 3, true));
    PHASE2(ph_norm2_router<3>(F), ph_norm2_router<3>(F, true));
    PHASE(ph_scatter<3>(F));
    PHASE(ph_moe1<3>(F));
    PHASE(ph_moe2<3>(F));
    PHASE2(ph_norm1<4>(F), ph_norm1<4>(F, true));
#undef PHASE
}

extern "C" void kernel_launch(void* const* d_in, const int* in_sizes, int n_in, void* d_out, int out_size, void* d_ws, size_t ws_size, hipStream_t stream) {
    static int grid = 0;
    if (grid == 0) {
        if (n_in != 31 || ws_size < WS_END) { fprintf(stderr, "kernel_launch: n_in %d ws %zu (need %zu)\n", n_in, ws_size, (size_t)WS_END); grid = -1; return; }
        int dev = 0, cus = 0, per_cu = 0;
        if (hipGetDevice(&dev) != hipSuccess || hipDeviceGetAttribute(&cus, hipDeviceAttributeMultiprocessorCount, dev) != hipSuccess) { grid = -1; return; }
        if (hipFuncSetAttribute((const void*)mk_fwd, hipFuncAttributeMaxDynamicSharedMemorySize, LDS_BYTES) != hipSuccess) { fprintf(stderr, "kernel_launch: hipFuncSetAttribute failed\n"); grid = -1; return; }
        if (hipOccupancyMaxActiveBlocksPerMultiprocessor(&per_cu, (const void*)mk_fwd, NTHR, LDS_BYTES) != hipSuccess || per_cu < 1) { fprintf(stderr, "kernel_launch: occupancy query says %d\n", per_cu); (void)hipGetLastError(); per_cu = 1; }
        grid = cus;
    }
    if (grid < 0) return;
    (void)hipMemsetAsync((char*)d_ws + WS_CTL, 0, CTL_BYTES, stream);
    Params p; memset(&p, 0, sizeof(p));
    for (int i = 0; i < 31; ++i) p.in[i] = (const float*)d_in[i];
    p.out = (float*)d_out; p.ws = (unsigned char*)d_ws;
#if MK_ONE_LAUNCH
    p.ph_lo = 0; p.ph_hi = N_PHASES;
    hipLaunchKernelGGL(mk_fwd, dim3(grid), dim3(NTHR), LDS_BYTES, stream, p);
#else
    for (int k = 0; k < N_PHASES; ++k) { p.ph_lo = k; p.ph_hi = k + 1; hipLaunchKernelGGL(mk_fwd, dim3(grid), dim3(NTHR), LDS_BYTES, stream, p); }
#endif
    const hipError_t le = hipPeekAtLastError();
    if (le != hipSuccess) fprintf(stderr, "kernel_launch: launch failed: %s\n", hipGetErrorName(le));
}
```
